# Optimizing an MI355X kernel written in HIP

```python
import math
import jax
import jax.numpy as jnp
from jax import lax
import numpy as np

D_MODEL = 1024
BATCH = 4
SEQ = 4096
DEPTH = 2
DEC_BATCH = 32
DEC_SEQ = 32
PAST_LEN = 2048

CHUNK = 64
N_META = 16
N_MIXERS = 2
N_GLA_LAYERS = (DEPTH + 1) // 2
N_MLA_LAYERS = DEPTH // 2
D_FF = 2816
RMS_EPS = 1e-6
GLA_HEADS = 4
GLA_KEY_DIM = D_MODEL // 2
GLA_VALUE_DIM = D_MODEL
GLA_DK = GLA_KEY_DIM // GLA_HEADS
GLA_DV = GLA_VALUE_DIM // GLA_HEADS
GLA_GATE_RANK = 16
GLA_GATE_NORMALIZER = 16.0
GLA_BLOCK = CHUNK
GLA_IN_DIM = 2 * GLA_KEY_DIM + 2 * GLA_VALUE_DIM + GLA_GATE_RANK
MLA_HEADS = 8
MLA_Q_RANK = 384
MLA_KV_RANK = 256
MLA_NOPE = 128
MLA_ROPE = 64
MLA_V = 128
MLA_DOWN_DIM = MLA_Q_RANK + MLA_KV_RANK + MLA_ROPE
ROPE_THETA = 10000.0
Q_BLOCK = 128

kernel_name = "hybrid_gla_mla_macaron_stream_step"


def rmsnorm(x, w):
    x32 = x.astype(jnp.float32)
    y = x32 * lax.rsqrt(jnp.mean(x32 * x32, axis=-1, keepdims=True) + RMS_EPS)
    return (y * w.astype(jnp.float32)).astype(x.dtype)


def swiglu_half(h, norm_w, w_gate, w_up, w_down):
    hn = rmsnorm(h, norm_w)
    return h + 0.5 * ((jax.nn.silu(hn @ w_gate) * (hn @ w_up)) @ w_down)


def apply_rope(x, pos):
    half = x.shape[-1] // 2
    inv = ROPE_THETA ** (-jnp.arange(half, dtype=jnp.float32) / half)
    ang = pos[:, None] * inv[None, :]
    cos = jnp.cos(ang)[None, :, None, :]
    sin = jnp.sin(ang)[None, :, None, :]
    x32 = x.astype(jnp.float32)
    x1, x2 = x32[..., :half], x32[..., half:]
    return jnp.concatenate([x1 * cos - x2 * sin, x2 * cos + x1 * sin], axis=-1).astype(x.dtype)


def gla_mixer(xn, s0, w_in, w_gate_up, b_gate, head_norm, w_out):
    B, L, _ = xn.shape
    proj = xn @ w_in
    q, k, v, r, gd = jnp.split(proj, [GLA_KEY_DIM, 2 * GLA_KEY_DIM, 2 * GLA_KEY_DIM + GLA_VALUE_DIM,
                                      2 * GLA_KEY_DIM + 2 * GLA_VALUE_DIM], axis=-1)
    glog = jax.nn.log_sigmoid((gd @ w_gate_up + b_gate).astype(jnp.float32)) / GLA_GATE_NORMALIZER
    pad = (-L) % GLA_BLOCK
    nb = (L + pad) // GLA_BLOCK

    def blocks(t, hd):
        t = t.astype(jnp.float32).reshape(B, L, GLA_HEADS, hd)
        t = jnp.pad(t, ((0, 0), (pad, 0), (0, 0), (0, 0)))
        return t.reshape(B, nb, GLA_BLOCK, GLA_HEADS, hd).transpose(1, 0, 3, 2, 4)

    qb = blocks(q, GLA_DK) * (GLA_DK ** -0.5)
    kb = blocks(k, GLA_DK)
    vb = blocks(v, GLA_DV)
    gb = jnp.cumsum(blocks(glog, GLA_DK), axis=-2)
    causal = jnp.tril(jnp.ones((GLA_BLOCK, GLA_BLOCK), dtype=bool))

    def step(S, inp):
        qc, kc, vc, gc = inp
        qg = qc * jnp.exp(gc)
        a = jnp.einsum('bhid,bhjd->bhij', qg, kc * jnp.exp(-gc))
        a = jnp.where(causal, a, 0.0)
        o = jnp.einsum('bhij,bhjv->bhiv', a, vc) + jnp.einsum('bhid,bhdv->bhiv', qg, S)
        glast = gc[:, :, -1, :]
        kd = kc * jnp.exp(glast[:, :, None, :] - gc)
        S = S * jnp.exp(glast)[..., None] + jnp.einsum('bhjd,bhjv->bhdv', kd, vc)
        return S, o

    S, o = lax.scan(step, s0.astype(jnp.float32), (qb, kb, vb, gb))
    o = o.transpose(1, 0, 3, 2, 4).reshape(B, nb * GLA_BLOCK, GLA_HEADS, GLA_DV)[:, pad:]
    o = rmsnorm(o, head_norm) * jax.nn.silu(r.astype(jnp.float32).reshape(B, L, GLA_HEADS, GLA_DV))
    y = o.reshape(B, L, GLA_VALUE_DIM).astype(xn.dtype) @ w_out
    return y, S.astype(xn.dtype)


def chunk_causal_attention(q_lat, q_rope, k_lat, k_rope, q_ids, k_ids):
    B, Lq, H, R = q_lat.shape
    qblk = min(Q_BLOCK, Lq)
    pad = (-Lq) % qblk
    nb = (Lq + pad) // qblk
    q_ids = jnp.pad(q_ids, (0, pad), constant_values=np.iinfo(np.int32).max)
    scale = (MLA_NOPE + MLA_ROPE) ** -0.5

    def to_blocks(t):
        t = jnp.pad(t, ((0, 0), (0, pad), (0, 0), (0, 0)))
        return t.reshape(B, nb, qblk, H, t.shape[-1]).transpose(1, 0, 2, 3, 4)

    def attend(blk):
        ql, qr, qi = blk
        s = (jnp.einsum('bqhr,bkr->bhqk', ql, k_lat).astype(jnp.float32)
             + jnp.einsum('bqhe,bke->bhqk', qr, k_rope).astype(jnp.float32)) * scale
        mask = (k_ids[None, :] <= qi[:, None])[None, None]
        p = jax.nn.softmax(jnp.where(mask, s, -jnp.inf), axis=-1).astype(k_lat.dtype)
        return jnp.einsum('bhqk,bkr->bqhr', p, k_lat)

    o = lax.map(attend, (to_blocks(q_lat), to_blocks(q_rope), q_ids.reshape(nb, qblk)))
    return o.transpose(1, 0, 2, 3, 4).reshape(B, nb * qblk, H, R)[:, :Lq]


def mla_mixer(xn, pos, q_ids, k_ids, past_lat, past_rope, w_down, q_norm, w_uq, kv_norm, w_uk, w_uv, w_out):
    B, L, _ = xn.shape
    cq, ckv, kr = jnp.split(xn @ w_down, [MLA_Q_RANK, MLA_Q_RANK + MLA_KV_RANK], axis=-1)
    q = (rmsnorm(cq, q_norm) @ w_uq).reshape(B, L, MLA_HEADS, MLA_NOPE + MLA_ROPE)
    q_nope = q[..., :MLA_NOPE]
    q_rope = apply_rope(q[..., MLA_NOPE:], pos)
    ckv = rmsnorm(ckv, kv_norm)
    kr = apply_rope(kr[:, :, None, :], pos)[:, :, 0]
    q_lat = jnp.einsum('blhn,rhn->blhr', q_nope, w_uk)
    if past_lat is None:
        keys_lat, keys_rope = ckv, kr
    else:
        keys_lat = jnp.concatenate([past_lat.astype(ckv.dtype), ckv], axis=1)
        keys_rope = jnp.concatenate([past_rope.astype(kr.dtype), kr], axis=1)
    o_lat = chunk_causal_attention(q_lat, q_rope, keys_lat, keys_rope, q_ids, k_ids)
    o = jnp.einsum('blhr,rhv->blhv', o_lat, w_uv).reshape(B, L, MLA_HEADS * MLA_V)
    return o @ w_out, ckv, kr


def setup_inputs(seed: int = 0) -> dict:
    key = jax.random.key(seed)
    ks = jax.random.split(key, 32)
    f32 = jnp.float32

    def nrm(k, shape, scale):
        return jax.random.normal(k, shape, f32) * scale

    def gain(k, shape):
        return 1.0 + 0.02 * jax.random.normal(k, shape, f32)

    return {
        "x_prompt": nrm(ks[0], (BATCH, SEQ, D_MODEL), 1.0),
        "x_sample": nrm(ks[1], (DEC_BATCH, DEC_SEQ, D_MODEL), 1.0),
        "state_gla": nrm(ks[2], (N_GLA_LAYERS, DEC_BATCH, GLA_HEADS, GLA_DK, GLA_DV), 1.0),
        "cache_mla_latent": nrm(ks[3], (N_MLA_LAYERS, DEC_BATCH, PAST_LEN, MLA_KV_RANK), 1.0),
        "cache_mla_rope": nrm(ks[4], (N_MLA_LAYERS, DEC_BATCH, PAST_LEN, MLA_ROPE), 1.0),
        "meta_tokens": nrm(ks[5], (N_META, D_MODEL), 1.0),
        "ffn1_norm": gain(ks[6], (DEPTH, D_MODEL)),
        "ffn1_w_gate": nrm(ks[7], (DEPTH, D_MODEL, D_FF), D_MODEL ** -0.5),
        "ffn1_w_up": nrm(ks[8], (DEPTH, D_MODEL, D_FF), D_MODEL ** -0.5),
        "ffn1_w_down": nrm(ks[9], (DEPTH, D_FF, D_MODEL), D_FF ** -0.5),
        "mix_norm": gain(ks[10], (DEPTH, D_MODEL)),
        "gla_w_in": nrm(ks[11], (N_GLA_LAYERS, D_MODEL, GLA_IN_DIM), D_MODEL ** -0.5),
        "gla_w_gate_up": nrm(ks[12], (N_GLA_LAYERS, GLA_GATE_RANK, GLA_KEY_DIM), GLA_GATE_RANK ** -0.5),
        "gla_b_gate": nrm(ks[13], (N_GLA_LAYERS, GLA_KEY_DIM), 0.01),
        "gla_head_norm": gain(ks[14], (N_GLA_LAYERS, GLA_DV)),
        "gla_w_out": nrm(ks[15], (N_GLA_LAYERS, GLA_VALUE_DIM, D_MODEL), GLA_VALUE_DIM ** -0.5),
        "mla_w_down": nrm(ks[16], (N_MLA_LAYERS, D_MODEL, MLA_DOWN_DIM), D_MODEL ** -0.5),
        "mla_q_norm": gain(ks[17], (N_MLA_LAYERS, MLA_Q_RANK)),
        "mla_w_uq": nrm(ks[18], (N_MLA_LAYERS, MLA_Q_RANK, MLA_HEADS * (MLA_NOPE + MLA_ROPE)), MLA_Q_RANK ** -0.5),
        "mla_kv_norm": gain(ks[19], (N_MLA_LAYERS, MLA_KV_RANK)),
        "mla_w_uk": nrm(ks[20], (N_MLA_LAYERS, MLA_KV_RANK, MLA_HEADS, MLA_NOPE), MLA_KV_RANK ** -0.5),
        "mla_w_uv": nrm(ks[21], (N_MLA_LAYERS, MLA_KV_RANK, MLA_HEADS, MLA_V), MLA_KV_RANK ** -0.5),
        "mla_w_out": nrm(ks[22], (N_MLA_LAYERS, MLA_HEADS * MLA_V, D_MODEL), (MLA_HEADS * MLA_V) ** -0.5),
        "ffn2_norm": gain(ks[23], (DEPTH, D_MODEL)),
        "ffn2_w_gate": nrm(ks[24], (DEPTH, D_MODEL, D_FF), D_MODEL ** -0.5),
        "ffn2_w_up": nrm(ks[25], (DEPTH, D_MODEL, D_FF), D_MODEL ** -0.5),
        "ffn2_w_down": nrm(ks[26], (DEPTH, D_FF, D_MODEL), D_FF ** -0.5),
        "final_norm": gain(ks[27], (D_MODEL,)),
    }


def reference(x_prompt, x_sample, state_gla, cache_mla_latent, cache_mla_rope, meta_tokens,
              ffn1_norm, ffn1_w_gate, ffn1_w_up, ffn1_w_down, mix_norm,
              gla_w_in, gla_w_gate_up, gla_b_gate, gla_head_norm, gla_w_out,
              mla_w_down, mla_q_norm, mla_w_uq, mla_kv_norm, mla_w_uk, mla_w_uv, mla_w_out,
              ffn2_norm, ffn2_w_gate, ffn2_w_up, ffn2_w_down, final_norm):
    Bp, n_frames, _ = x_prompt.shape
    Bs, Ls, _ = x_sample.shape
    past = cache_mla_latent.shape[2]
    hp = jnp.concatenate([jnp.broadcast_to(meta_tokens[None].astype(x_prompt.dtype), (Bp, N_META, D_MODEL)),
                          x_prompt], axis=1)
    Lp = hp.shape[1]
    pos_p = jnp.arange(Lp, dtype=jnp.float32)
    ids_p = jnp.concatenate([jnp.full((N_META,), -1, jnp.int32),
                             jnp.arange(n_frames, dtype=jnp.int32) // CHUNK])
    hs = x_sample
    frame_s = past + jnp.arange(Ls, dtype=jnp.int32)
    pos_s = frame_s.astype(jnp.float32)
    ids_s = frame_s // CHUNK
    kids_s = jnp.concatenate([jnp.arange(past, dtype=jnp.int32) // CHUNK, ids_s])

    gla_sp, gla_ss, lat_p, rope_p, lat_s, rope_s = [], [], [], [], [], []
    for i in range(DEPTH):
        hp = swiglu_half(hp, ffn1_norm[i], ffn1_w_gate[i], ffn1_w_up[i], ffn1_w_down[i])
        hs = swiglu_half(hs, ffn1_norm[i], ffn1_w_gate[i], ffn1_w_up[i], ffn1_w_down[i])
        xp = rmsnorm(hp, mix_norm[i])
        xs = rmsnorm(hs, mix_norm[i])
        j = i // N_MIXERS
        if i % N_MIXERS == 0:
            s0 = jnp.zeros((Bp, GLA_HEADS, GLA_DK, GLA_DV), xp.dtype)
            dp, sp = gla_mixer(xp, s0, gla_w_in[j], gla_w_gate_up[j], gla_b_gate[j], gla_head_norm[j], gla_w_out[j])
            ds, ss = gla_mixer(xs, state_gla[j], gla_w_in[j], gla_w_gate_up[j], gla_b_gate[j], gla_head_norm[j], gla_w_out[j])
            gla_sp.append(sp)
            gla_ss.append(ss)
        else:
            dp, cp, rp = mla_mixer(xp, pos_p, ids_p, ids_p, None, None, mla_w_down[j], mla_q_norm[j], mla_w_uq[j],
                                   mla_kv_norm[j], mla_w_uk[j], mla_w_uv[j], mla_w_out[j])
            ds, cs, rs = mla_mixer(xs, pos_s, ids_s, kids_s, cache_mla_latent[j], cache_mla_rope[j], mla_w_down[j],
                                   mla_q_norm[j], mla_w_uq[j], mla_kv_norm[j], mla_w_uk[j], mla_w_uv[j], mla_w_out[j])
            lat_p.append(cp)
            rope_p.append(rp)
            lat_s.append(cs)
            rope_s.append(rs)
        hp = hp + dp
        hs = hs + ds
        hp = swiglu_half(hp, ffn2_norm[i], ffn2_w_gate[i], ffn2_w_up[i], ffn2_w_down[i])
        hs = swiglu_half(hs, ffn2_norm[i], ffn2_w_gate[i], ffn2_w_up[i], ffn2_w_down[i])

    y_prompt = rmsnorm(hp[:, N_META:], final_norm)
    y_sample = rmsnorm(hs, final_norm)
    return (y_prompt, y_sample, jnp.stack(gla_sp, 0), jnp.stack(gla_ss, 0),
            jnp.stack(lat_p, 0), jnp.stack(rope_p, 0), jnp.stack(lat_s, 0), jnp.stack(rope_s, 0))
```

```cpp
#include <hip/hip_runtime.h>
#include <cstdio>
#include <cstdint>

#ifndef MK_N_LAUNCHES
#define MK_N_LAUNCHES 1
#endif

#ifndef GB_P1
#define GB_P1 0
#endif
#ifndef GB_P2
#define GB_P2 0
#endif
#ifndef ATT_P1
#define ATT_P1 0
#endif
#ifndef ATT_P2
#define ATT_P2 0
#endif
#ifndef ATT_P3
#define ATT_P3 0
#endif
#ifndef ATT_PROBEBASE
#define ATT_PROBEBASE 0
#endif
#ifndef ATT_DUPQK
#define ATT_DUPQK 0
#endif
#ifndef ATT_DUPPV
#define ATT_DUPPV 0
#endif
#ifndef RESID_BF16
#define RESID_BF16 1
#endif
#ifndef DUP_MASK
#define DUP_MASK 0u
#endif

#define LAS __attribute__((address_space(3)))
#define GAS __attribute__((address_space(1)))
typedef unsigned short bf16_t;
typedef short bf16x8 __attribute__((ext_vector_type(8)));
typedef short s16x4 __attribute__((ext_vector_type(4)));
typedef float f32x4 __attribute__((ext_vector_type(4)));
typedef float f32x2 __attribute__((ext_vector_type(2)));
typedef unsigned u32x4 __attribute__((ext_vector_type(4)));
typedef unsigned u32x2 __attribute__((ext_vector_type(2)));
typedef __bf16 bf16x2_t __attribute__((ext_vector_type(2)));

constexpr int DM = 1024, DFF = 2816, NB = 4, SEQ = 4096, NMETA = 16, LP = 4112, LPP = 4160, NCH = 65;
constexpr int SB = 32, SL = 32, PAST = 2048;
constexpr int ROWS_P = NB * LPP;
constexpr int T = ROWS_P + SB * SL;
constexpr int GIN_N = 3328, GIN_LD = 3328;
constexpr int MDN_N = 768;
constexpr int QN = 2560, QLD = 2560;
constexpr int KLD = 320;
constexpr float EPS = 1e-6f;
constexpr float LOG2E = 1.4426950408889634f;

constexpr size_t OUT_YP = 0, OUT_YS = 16777216, OUT_GP = 17825792, OUT_GS = 18350080, OUT_LP = 22544384, OUT_RP = 26755072, OUT_LS = 27807744, OUT_RS = 28069888, OUT_END = 28135424;
constexpr size_t MiB = 1u << 20;
constexpr size_t OS_SBUFP = 0;
constexpr size_t OS_DN = 0;
constexpr size_t OS_KP = 52 * MiB;

constexpr size_t WS_CTL = 0, CTL_ZERO_BYTES = 1 * MiB;
constexpr size_t WS_SS = 256 * 1024;
constexpr size_t WS_L0 = 1 * MiB;
constexpr size_t WS_KS = WS_L0;
constexpr size_t WS_WGIN = WS_L0 + 33 * MiB;
constexpr size_t WS_WGOUT = WS_WGIN + 6 * MiB + 512 * 1024;
constexpr size_t WS_L1 = 43 * MiB;
constexpr size_t WS_WMDN = WS_L1 + 33 * MiB;
constexpr size_t WS_WMOUT = WS_WMDN + 1 * MiB + 512 * 1024;
constexpr size_t WS_WQ = WS_WMOUT + 2 * MiB;
constexpr size_t WS_WUVT = WS_WQ + 2 * MiB;
constexpr size_t WS_ROPE = WS_WUVT + 512 * 1024;
constexpr size_t WS_DEC = WS_ROPE + 1 * MiB + 256 * 1024;
constexpr size_t WS_SBUFS = WS_DEC + 1 * MiB;
__host__ __device__ constexpr size_t ws_wup(int fi) { return (fi < 2 ? WS_L0 : WS_L1) + (size_t)(fi & 1) * 11 * MiB; }
__host__ __device__ constexpr size_t ws_wdn(int fi) { return (fi < 2 ? WS_L0 : WS_L1) + 22 * MiB + (size_t)(fi & 1) * (5 * MiB + 512 * 1024); }
static_assert((size_t)(SB * (PAST + SL) + 32) * KLD * 2 <= 41 * MiB + 512 * 1024, "KS fits the layer-0 weight block");
constexpr size_t WS_H = WS_SBUFS + 8 * MiB;
constexpr size_t WS_HB = WS_H + 69 * MiB;
constexpr size_t WS_BIG = WS_HB + 34 * MiB + 512 * 1024;
constexpr size_t WS_CQB = WS_BIG + 87 * MiB;
constexpr size_t WS_END = WS_BIG + 112 * MiB + 128 * 1024;
static_assert(WS_CQB + 13 * MiB <= WS_END, "ws map");
static_assert((size_t)T * QLD * 2 <= 87 * MiB, "Q fits");

constexpr int CW_BAR = 4096;

__device__ __forceinline__ unsigned pk2(float lo, float hi) { f32x2 v = {lo, hi}; bf16x2_t b = __builtin_convertvector(v, bf16x2_t); return __builtin_bit_cast(unsigned, b); }
__device__ __forceinline__ float bf2f(unsigned short x) { return __uint_as_float((unsigned)x << 16); }
__device__ __forceinline__ float bflo(unsigned x) { return __uint_as_float(x << 16); }
__device__ __forceinline__ float bfhi(unsigned x) { return __uint_as_float(x & 0xffff0000u); }
__device__ __forceinline__ float wave_sum(float v) {
#pragma unroll
    for (int o = 1; o < 64; o <<= 1) v += __shfl_xor(v, o);
    return v;
}
__device__ __forceinline__ float fexp2(float x) { return __builtin_amdgcn_exp2f(x); }
__device__ __forceinline__ float frcp(float x) { return __builtin_amdgcn_rcpf(x); }
__device__ __forceinline__ float silu_f(float g) { return g * frcp(1.0f + fexp2(-g * LOG2E)); }
__device__ __forceinline__ f32x4 mfma16(bf16x8 a, bf16x8 b, f32x4 c) { return __builtin_amdgcn_mfma_f32_16x16x32_bf16(a, b, c, 0, 0, 0); }

namespace pg8 {
constexpr int BM = 256, BK = 64, HALF = 128, HTB = HALF * BK * 2, STAGE_BYTES = 8 * HTB, NXCD = 8, WGM = 8;
__host__ __device__ __forceinline__ int lds_byte(int r, int c) { const int st = (r >> 4) * 2 + (c >> 5), rr = r & 15, cc = c & 31, ob = rr * 64 + cc * 2; return st * 1024 + (ob ^ (((ob >> 9) & 1) << 5)); }
__host__ __device__ __forceinline__ void stage_rc(int b, int& R, int& C) { const int st = b / 1024, sb = b % 1024, swz = sb ^ (((sb >> 9) & 1) << 5); R = (st >> 1) * 16 + swz / 64; C = (st & 1) * 32 + (swz % 64) / 2; }
__host__ __device__ __forceinline__ int perm32(int rho) { const int n = rho >> 4, i = rho & 15; return 8 * (i >> 2) + 4 * n + (i & 3); }

struct Unit { int pm, pn, k0, nt, part; };
struct Gemm { const bf16_t* A; const bf16_t* Bt; int M, N, K, lda; };

struct StaticOrder {
    static constexpr bool SPLIT = false;
    int nM, nN, nwg, G, c;
    __device__ void init(int M, int N, int G_, int c_) { nM = M / BM; nN = N / BM; nwg = nM * nN; G = G_; c = c_; }
    __device__ bool next(int i, Unit& u) const {
        const long L = (long)i * G + c; if (L >= nwg) return false;
        int wgid = (int)L; { const int q = nwg / NXCD, r = nwg % NXCD, xcd = wgid % NXCD, off = wgid / NXCD; wgid = (xcd < r ? xcd * (q + 1) : r * (q + 1) + (xcd - r) * q) + off; }
        const int nig = WGM * nN, gid = wgid / nig, fm = gid * WGM, gsz = (nM - fm) < WGM ? (nM - fm) : WGM;
        u.pm = fm + ((wgid % nig) % gsz); u.pn = (wgid % nig) / gsz; return true;
    }
};

struct SplitOrder {
    static constexpr bool SPLIT = true;
    int nM, nN, nwg, G, c, full, rem, S, ntf, per;
    __device__ void init(int M, int N, int K, int G_, int c_) {
        nM = M / BM; nN = N / BM; nwg = nM * nN; G = G_; c = c_; full = nwg / G; rem = nwg % G; ntf = K / BK; S = 1;
        if (rem > 0) { const int pairs = ntf / 2, lim = G / rem; for (int d = 2; d <= pairs && d <= lim; ++d) if (pairs % d == 0) S = d; }
        per = ntf / S;
    }
    __device__ void tile(int L, int& pm, int& pn) const {
        int wgid = L; { const int q = nwg / NXCD, r = nwg % NXCD, xcd = wgid % NXCD, off = wgid / NXCD; wgid = (xcd < r ? xcd * (q + 1) : r * (q + 1) + (xcd - r) * q) + off; }
        const int nig = WGM * nN, gid = wgid / nig, fm = gid * WGM, gsz = (nM - fm) < WGM ? (nM - fm) : WGM;
        pm = fm + ((wgid % nig) % gsz); pn = (wgid % nig) / gsz;
    }
    __device__ bool next(int i, Unit& u) const {
        if (i < full) { tile(i * G + c, u.pm, u.pn); u.k0 = 0; u.nt = ntf; u.part = -1; return true; }
        if (i == full && c < rem * S) { const int j = c / S, s = c - j * S; tile(full * G + j, u.pm, u.pn); u.k0 = s * per; u.nt = per; u.part = S > 1 ? c : -1; return true; }
        return false;
    }
};

template <class Epi, class Sched, bool ALIGN_EPI>
__device__ __forceinline__ void gemm_phase(LAS unsigned char* lds, const Gemm g, const Sched& S, const Epi& E, const int tid) {
    const int wid = __builtin_amdgcn_readfirstlane(tid >> 6), lane = tid & 63, wr = wid >> 2, wc = wid & 3, fr = lane & 15, fq = lane >> 4;
    int K_ = g.K, lda_ = g.lda; asm volatile("" : "+s"(K_), "+s"(lda_));
    const int K = K_, lda = lda_, nt = K / BK;
    unsigned voffA[2], voffB[2];
#pragma unroll
    for (int i = 0; i < 2; ++i) { int R, C; stage_rc(tid * 16 + i * 8192, R, C); const int Rb = Epi::PERM ? ((R & ~31) + perm32(R & 31)) : R;
        voffA[i] = (unsigned)(R * lda + C) * 2u; voffB[i] = (unsigned)(Rb * K + C) * 2u; }
    const size_t kstep = (size_t)(BK * 2);
    const size_t hstepA = (size_t)HALF * lda * 2, hstepB = (size_t)HALF * K * 2;
    const size_t tstepA = 2 * hstepA, tstepB = 2 * hstepB;
    const unsigned ldsw = (unsigned)wid * 1024u;
    const int aoff = lds_byte(wr * 64 + fr, fq * 8), boff = lds_byte(wc * 32 + fr, fq * 8);
#define PG8_SA(b, h) (((b) * 2 + (h)) * HTB)
#define PG8_SB(b, h) ((4 + (b) * 2 + (h)) * HTB)
#define PG8_STAGE(bufoff, gbase, voff) do { _Pragma("unroll") for (int _i = 0; _i < 2; ++_i) \
        __builtin_amdgcn_global_load_lds((const unsigned*)((const char*)(gbase) + (voff)[_i]), (LAS unsigned*)(lds + (bufoff) + ldsw + _i * 8192), 16, 0, 0); } while (0)
#define PG8_LDA(dst, b, h) do { _Pragma("unroll") for (int m = 0; m < 4; ++m) _Pragma("unroll") for (int k = 0; k < 2; ++k) dst[m][k] = *(const LAS bf16x8*)(lds + PG8_SA(b, h) + aoff + m * 2048 + k * 1024); } while (0)
#define PG8_LDB(dst, b, h) do { _Pragma("unroll") for (int n = 0; n < 2; ++n) _Pragma("unroll") for (int k = 0; k < 2; ++k) dst[n][k] = *(const LAS bf16x8*)(lds + PG8_SB(b, h) + boff + n * 2048 + k * 1024); } while (0)
#define PG8_MMA(ai, bj, At, Bt) do { __builtin_amdgcn_s_setprio(1); _Pragma("unroll") for (int m = 0; m < 4; ++m) _Pragma("unroll") for (int n = 0; n < 2; ++n) _Pragma("unroll") for (int k = 0; k < 2; ++k) \
        acc[ai][bj][m][n] = __builtin_amdgcn_mfma_f32_16x16x32_bf16(Bt[n][k], At[m][k], acc[ai][bj][m][n], 0, 0, 0); __builtin_amdgcn_s_setprio(0); } while (0)
#define PG8_WAIT_V(n) asm volatile("s_waitcnt vmcnt(" #n ")" ::: "memory")
#define PG8_WAIT_L(n) asm volatile("s_waitcnt lgkmcnt(" #n ")" ::: "memory")
#define PG8_BAR __builtin_amdgcn_s_barrier()
#define PG8_SCHED __builtin_amdgcn_sched_barrier(0)
    Unit cur, nxt; int ui = 0;
    if (!S.next(0, cur)) return;
    f32x4 acc[2][2][4][2];
#pragma unroll
    for (int a = 0; a < 2; ++a)
#pragma unroll
        for (int b = 0; b < 2; ++b)
#pragma unroll
            for (int m = 0; m < 4; ++m)
#pragma unroll
                for (int n = 0; n < 2; ++n) acc[a][b][m][n] = (f32x4){0.f, 0.f, 0.f, 0.f};
    bf16x8 At[4][2], B0[2][2], B1[2][2];
    const char* cA = (const char*)g.A + (size_t)cur.pm * tstepA; const char* cB = (const char*)g.Bt + (size_t)cur.pn * tstepB;
    int ntc = nt;
    if constexpr (Sched::SPLIT) { cA += (size_t)cur.k0 * kstep; cB += (size_t)cur.k0 * kstep; ntc = cur.nt; }
    PG8_STAGE(PG8_SB(0, 0), cB, voffB); PG8_STAGE(PG8_SB(0, 1), cB + hstepB, voffB); PG8_STAGE(PG8_SA(0, 0), cA, voffA); PG8_STAGE(PG8_SA(0, 1), cA + hstepA, voffA);
    if (wr == 1) PG8_BAR;
    PG8_WAIT_V(2); PG8_BAR;
    PG8_STAGE(PG8_SB(1, 0), cB + kstep, voffB); PG8_STAGE(PG8_SA(1, 0), cA + kstep, voffA); PG8_STAGE(PG8_SB(1, 1), cB + hstepB + kstep, voffB);
    PG8_WAIT_V(6); PG8_BAR;
    for (;;) {
        const bool has_next = S.next(ui + 1, nxt);
        const char* nA = has_next ? (const char*)g.A + (size_t)nxt.pm * tstepA : cA; const char* nB = has_next ? (const char*)g.Bt + (size_t)nxt.pn * tstepB : cB;
        if constexpr (Sched::SPLIT) { if (has_next) { nA += (size_t)nxt.k0 * kstep; nB += (size_t)nxt.k0 * kstep; } }
        for (int t = 0; t < ntc; t += 2) {
            const bool last = (t == ntc - 2);
            const char* a1 = cA + (size_t)(t + 1) * kstep;
            const char* a2 = last ? nA : cA + (size_t)(t + 2) * kstep; const char* b2 = last ? nB : cB + (size_t)(t + 2) * kstep;
            const char* a3 = a2 + kstep; const char* b3 = b2 + kstep;
            PG8_LDB(B0, 0, 0); PG8_LDB(B1, 0, 1); PG8_SCHED; PG8_LDA(At, 0, 0); PG8_STAGE(PG8_SA(1, 1), a1 + hstepA, voffA);
            PG8_WAIT_V(8); PG8_WAIT_L(0); PG8_BAR; PG8_MMA(0, 0, At, B0); PG8_MMA(0, 1, At, B1); PG8_BAR; PG8_SCHED;
            PG8_LDA(At, 0, 1); PG8_STAGE(PG8_SB(0, 0), b2, voffB); PG8_STAGE(PG8_SB(0, 1), b2 + hstepB, voffB); PG8_STAGE(PG8_SA(0, 0), a2, voffA);
            PG8_WAIT_V(8); PG8_WAIT_L(0); PG8_BAR; PG8_MMA(1, 0, At, B0); PG8_MMA(1, 1, At, B1); PG8_BAR; PG8_SCHED;
            PG8_LDB(B0, 1, 0); PG8_LDB(B1, 1, 1); PG8_SCHED; PG8_LDA(At, 1, 0); PG8_STAGE(PG8_SA(0, 1), a2 + hstepA, voffA);
            PG8_WAIT_V(8); PG8_WAIT_L(0); PG8_BAR; PG8_MMA(0, 0, At, B0); PG8_MMA(0, 1, At, B1); PG8_BAR; PG8_SCHED;
            PG8_LDA(At, 1, 1); PG8_STAGE(PG8_SB(1, 0), b3, voffB); PG8_STAGE(PG8_SB(1, 1), b3 + hstepB, voffB); PG8_STAGE(PG8_SA(1, 0), a3, voffA);
            PG8_WAIT_V(8); PG8_WAIT_L(0); PG8_BAR; PG8_MMA(1, 0, At, B0); PG8_MMA(1, 1, At, B1); PG8_BAR; PG8_SCHED;
        }
        if constexpr (ALIGN_EPI) { if (wr == 0) PG8_BAR; }
        if constexpr (Sched::SPLIT) { if (cur.part >= 0) E.partial(acc, cur.part, wr, wc, fr, fq); else E(acc, cur, wr, wc, fr, fq); }
        else E(acc, cur, wr, wc, fr, fq);
        if (!has_next) break;
#pragma unroll
        for (int a = 0; a < 2; ++a)
#pragma unroll
            for (int b = 0; b < 2; ++b)
#pragma unroll
                for (int m = 0; m < 4; ++m)
#pragma unroll
                    for (int n = 0; n < 2; ++n) acc[a][b][m][n] = (f32x4){0.f, 0.f, 0.f, 0.f};
        cur = nxt; cA = nA; cB = nB; ++ui;
        if constexpr (Sched::SPLIT) ntc = nxt.nt;
        if constexpr (ALIGN_EPI) { if (wr == 1) PG8_BAR; }
    }
    PG8_WAIT_V(0);
    if constexpr (!ALIGN_EPI) { if (wr == 0) PG8_BAR; }
    PG8_BAR;
#undef PG8_SA
#undef PG8_SB
#undef PG8_STAGE
#undef PG8_LDA
#undef PG8_LDB
#undef PG8_MMA
#undef PG8_WAIT_V
#undef PG8_WAIT_L
#undef PG8_BAR
#undef PG8_SCHED
}

struct EpiSwiglu {
    static constexpr bool PERM = true;
    bf16_t* O; const float* ss;
    __device__ __forceinline__ void operator()(const f32x4 (&acc)[2][2][4][2], const Unit& u, int wr, int wc, int fr, int fq) const {
        const int row0 = u.pm * BM + wr * 64 + fr, col0 = u.pn * 128 + wc * 32 + 8 * fq;
#pragma unroll
        for (int ai = 0; ai < 2; ++ai)
#pragma unroll
            for (int m = 0; m < 4; ++m) {
                const int row = row0 + ai * HALF + m * 16;
                const float rs = __builtin_amdgcn_rsqf(ss[row] * (1.0f / DM) + EPS);
                float a[8];
#pragma unroll
                for (int n = 0; n < 2; ++n)
#pragma unroll
                    for (int e = 0; e < 4; ++e) { const float gg = acc[ai][0][m][n][e] * rs, uu = acc[ai][1][m][n][e] * rs; a[n * 4 + e] = silu_f(gg) * uu; }
                u32x4 w; w.x = pk2(a[0], a[1]); w.y = pk2(a[2], a[3]); w.z = pk2(a[4], a[5]); w.w = pk2(a[6], a[7]);
                *(u32x4*)(O + (size_t)row * DFF + col0) = w;
            }
    }
};
struct EpiResid {
    static constexpr bool PERM = false;
    float* h; bf16_t* hb; float* ssn; float scale; unsigned char* part;
    __device__ __forceinline__ void partial(const f32x4 (&acc)[2][2][4][2], int slot, int wr, int wc, int fr, int fq) const {
        unsigned char* P = part + (size_t)slot * 131072 + (size_t)(wr * 4 + wc) * 16384 + (size_t)(fq * 16 + fr) * 16;
#pragma unroll
        for (int ai = 0; ai < 2; ++ai)
#pragma unroll
            for (int m = 0; m < 4; ++m)
#pragma unroll
                for (int bj = 0; bj < 2; ++bj) { const f32x4 v0 = acc[ai][bj][m][0], v1 = acc[ai][bj][m][1];
                    u32x4 w; w.x = pk2(v0[0], v0[1]); w.y = pk2(v0[2], v0[3]); w.z = pk2(v1[0], v1[1]); w.w = pk2(v1[2], v1[3]);
                    *(u32x4*)(P + ((ai * 4 + m) * 2 + bj) * 1024) = w; }
    }
    __device__ __forceinline__ void operator()(const f32x4 (&acc)[2][2][4][2], const Unit& u, int wr, int wc, int fr, int fq) const {
        const int row0 = u.pm * BM + wr * 64 + fr, col0 = u.pn * BM + wc * 32 + 4 * fq;
#pragma unroll
        for (int ai = 0; ai < 2; ++ai)
#pragma unroll
            for (int m = 0; m < 4; ++m) {
                const int row = row0 + ai * HALF + m * 16; float s = 0.f;
#pragma unroll
                for (int bj = 0; bj < 2; ++bj)
#pragma unroll
                    for (int n = 0; n < 2; ++n) {
                        const size_t off = (size_t)row * DM + col0 + bj * HALF + n * 16;
                        f32x4 v;
                        if (RESID_BF16) { const u32x2 hv = *(const u32x2*)(hb + off); v = (f32x4){bflo(hv.x), bfhi(hv.x), bflo(hv.y), bfhi(hv.y)} + acc[ai][bj][m][n] * scale; }
                        else { v = *(const f32x4*)(h + off) + acc[ai][bj][m][n] * scale; *(f32x4*)(h + off) = v; }
                        u32x2 w; w.x = pk2(v[0], v[1]); w.y = pk2(v[2], v[3]); *(u32x2*)(hb + off) = w;
                        s += (v[0] * v[0] + v[1] * v[1]) + (v[2] * v[2] + v[3] * v[3]);
                    }
                s += __shfl_xor(s, 16); s += __shfl_xor(s, 32);
                if (fq == 0) atomicAdd(ssn + row, s);
            }
    }
};
struct EpiScaleBf16 {
    static constexpr bool PERM = true;
    bf16_t* O; int ldc; const float* ss;
    __device__ __forceinline__ void operator()(const f32x4 (&acc)[2][2][4][2], const Unit& u, int wr, int wc, int fr, int fq) const {
        const int row0 = u.pm * BM + wr * 64 + fr, col0 = u.pn * BM + wc * 32 + 8 * fq;
#pragma unroll
        for (int ai = 0; ai < 2; ++ai)
#pragma unroll
            for (int m = 0; m < 4; ++m) {
                const int row = row0 + ai * HALF + m * 16;
                const float rs = __builtin_amdgcn_rsqf(ss[row] * (1.0f / DM) + EPS);
#pragma unroll
                for (int bj = 0; bj < 2; ++bj) { const f32x4 v0 = acc[ai][bj][m][0] * rs, v1 = acc[ai][bj][m][1] * rs;
                    u32x4 w; w.x = pk2(v0[0], v0[1]); w.y = pk2(v0[2], v0[3]); w.z = pk2(v1[0], v1[1]); w.w = pk2(v1[2], v1[3]);
                    *(u32x4*)(O + (size_t)row * ldc + col0 + bj * HALF) = w; }
            }
    }
};
struct EpiScaleF32 {
    static constexpr bool PERM = false;
    float* O; int ldc; const float* ss;
    __device__ __forceinline__ void operator()(const f32x4 (&acc)[2][2][4][2], const Unit& u, int wr, int wc, int fr, int fq) const {
        const int row0 = u.pm * BM + wr * 64 + fr, col0 = u.pn * BM + wc * 32 + 4 * fq;
#pragma unroll
        for (int ai = 0; ai < 2; ++ai)
#pragma unroll
            for (int m = 0; m < 4; ++m) {
                const int row = row0 + ai * HALF + m * 16;
                const float rs = __builtin_amdgcn_rsqf(ss[row] * (1.0f / DM) + EPS);
#pragma unroll
                for (int bj = 0; bj < 2; ++bj)
#pragma unroll
                    for (int n = 0; n < 2; ++n) *(f32x4*)(O + (size_t)row * ldc + col0 + bj * HALF + n * 16) = acc[ai][bj][m][n] * rs;
            }
    }
};
struct EpiQ {
    static constexpr bool PERM = true;
    bf16_t* Q; const float* ssq; float c2;
    __device__ __forceinline__ void operator()(const f32x4 (&acc)[2][2][4][2], const Unit& u, int wr, int wc, int fr, int fq) const {
        const int row0 = u.pm * BM + wr * 64 + fr;
        const int cb0 = u.pn < 8 ? u.pn * 320 + wc * 32 + 8 * fq : (4 * (u.pn - 8) + (wc >> 1)) * 320 + 256 + 32 * (wc & 1) + 8 * fq;
        const int cbstep = u.pn < 8 ? HALF : 640;
#pragma unroll
        for (int ai = 0; ai < 2; ++ai)
#pragma unroll
            for (int m = 0; m < 4; ++m) {
                const int row = row0 + ai * HALF + m * 16;
                const float rs = __builtin_amdgcn_rsqf(ssq[row] * (1.0f / 384.0f) + EPS) * c2;
#pragma unroll
                for (int bj = 0; bj < 2; ++bj) { const f32x4 v0 = acc[ai][bj][m][0] * rs, v1 = acc[ai][bj][m][1] * rs;
                    u32x4 w; w.x = pk2(v0[0], v0[1]); w.y = pk2(v0[2], v0[3]); w.z = pk2(v1[0], v1[1]); w.w = pk2(v1[2], v1[3]);
                    *(u32x4*)(Q + (size_t)row * QLD + cb0 + bj * cbstep) = w; }
            }
    }
};
}

#define XB_TMO      128
#define XB_XCNT(j)  (256  + 64 * (j))
#define XB_XSUB(j)  (1280 + 64 * (j))
#define XB_XGEN(j)  (2304 + 64 * (j))
#define XB_TOP      3328
#define XB_TOPGEN   3392
#define XCD_BAR_WORDS 3456
#define XB_SPIN_CAP (1u << 18)
__device__ __forceinline__ unsigned xb_ld(unsigned* p)              { return __hip_atomic_load(p, __ATOMIC_RELAXED, __HIP_MEMORY_SCOPE_AGENT); }
__device__ __forceinline__ unsigned xb_add(unsigned* p, unsigned v) { return __hip_atomic_fetch_add(p, v, __ATOMIC_RELAXED, __HIP_MEMORY_SCOPE_AGENT); }
__device__ __forceinline__ unsigned xb_xcc_id() { return (unsigned)__builtin_amdgcn_s_getreg((3 << 11) | 20) & 0xFu; }
#define XB_SPIN(cond, bar) do { unsigned _sp = 0; while (cond) { __builtin_amdgcn_s_sleep(1); \
    if ((++_sp & 255u) == 0u) { if (xb_ld(&(bar)[XB_TMO])) break; if (_sp > XB_SPIN_CAP) { atomicAdd(&(bar)[XB_TMO], 1u); break; } } } } while (0)
struct XcdBarrier { unsigned* bar; unsigned x; volatile LAS unsigned* st; };
__device__ __forceinline__ XcdBarrier xcd_barrier_post(unsigned* bar, volatile LAS unsigned* st) {
    XcdBarrier b; b.bar = bar; b.x = xb_xcc_id(); b.st = st;
    if (threadIdx.x == 0) (void)xb_add(&bar[XB_XCNT(b.x)], 1u);
    return b;
}
__device__ __forceinline__ void xcd_barrier_complete(unsigned* bar, unsigned x, unsigned& nloc, unsigned& nx) {
    const unsigned G = gridDim.x * gridDim.y * gridDim.z;
    unsigned sum, cnt, mine, sp = 0u;
    for (;;) {
        sum = 0u; cnt = 0u; mine = 0u;
#pragma unroll
        for (unsigned j = 0; j < 16; ++j) { const unsigned c = xb_ld(&bar[XB_XCNT(j)]); sum += c; cnt += (c > 0u) ? 1u : 0u; mine = (j == x) ? c : mine; }
        if (sum == G) break;
        __builtin_amdgcn_s_sleep(1);
        if ((++sp & 255u) == 0u) { if (xb_ld(&bar[XB_TMO])) break; if (sp > XB_SPIN_CAP) { atomicAdd(&bar[XB_TMO], 1u); break; } }
    }
    nloc = mine > 0u ? mine : 1u; nx = cnt > 0u ? cnt : 1u;
}
__device__ __forceinline__ void xcd_barrier(const XcdBarrier& b) {
    asm volatile("s_waitcnt vmcnt(0)" ::: "memory");
    __syncthreads();
    if (threadIdx.x == 0) {
        unsigned* bar = b.bar;
        __builtin_amdgcn_s_waitcnt(0);
        unsigned nloc = b.st[0], nx = b.st[1];
        if (nloc == 0u) { xcd_barrier_complete(bar, b.x, nloc, nx); b.st[0] = nloc; b.st[1] = nx; }
        const unsigned old = xb_add(&bar[XB_XSUB(b.x)], 1u);
        const unsigned gen = old / nloc;
        if (old + 1u == (gen + 1u) * nloc) {
            __builtin_amdgcn_fence(__ATOMIC_RELEASE, "agent");
            asm volatile("s_waitcnt vmcnt(0)" ::: "memory");
            const unsigned og = xb_add(&bar[XB_TOP], 1u);
            const unsigned tg = og / nx;
            if (og + 1u == (tg + 1u) * nx) xb_add(&bar[XB_TOPGEN], 1u);
            else XB_SPIN(xb_ld(&bar[XB_TOPGEN]) == tg, bar);
            __builtin_amdgcn_fence(__ATOMIC_ACQUIRE, "agent");
            xb_add(&bar[XB_XGEN(b.x)], 1u);
            asm volatile("s_waitcnt vmcnt(0)" ::: "memory");
        } else {
            XB_SPIN(xb_ld(&bar[XB_XGEN(b.x)]) == gen, bar);
            __builtin_amdgcn_fence(__ATOMIC_ACQUIRE, "agent");
            asm volatile("s_waitcnt vmcnt(0)" ::: "memory");
        }
    }
    __syncthreads();
}

struct Args { const float* in[28]; float* out; unsigned char* ws; int ph_lo, ph_hi; };

__device__ __forceinline__ void tr_item(const float* W, int ldw, int Nvalid, const float* kscale, bf16_t* WT, int Kd, int k0, int n0, int drow0, LAS float* scr, int lane) {
    const int n = n0 + 4 * (lane & 15);
    f32x4 v[16];
#pragma unroll
    for (int i = 0; i < 16; ++i) { const int kk = 4 * i + (lane >> 4); v[i] = (f32x4){0.f, 0.f, 0.f, 0.f}; if (n < Nvalid) v[i] = *(const f32x4*)(W + (size_t)(k0 + kk) * ldw + n); }
#pragma unroll
    for (int i = 0; i < 16; ++i) { const int kk = 4 * i + (lane >> 4); f32x4 x = v[i]; if (kscale) x = x * kscale[k0 + kk];
        LAS float* d = scr + kk * 65 + 4 * (lane & 15); d[0] = x[0]; d[1] = x[1]; d[2] = x[2]; d[3] = x[3]; }
    asm volatile("s_waitcnt lgkmcnt(0)" ::: "memory");
    const int c = lane & 7;
#pragma unroll
    for (int j = 0; j < 8; ++j) { const int nn = (lane >> 3) + 8 * j; const LAS float* s = scr + (8 * c) * 65 + nn;
        u32x4 o; o.x = pk2(s[0 * 65], s[1 * 65]); o.y = pk2(s[2 * 65], s[3 * 65]); o.z = pk2(s[4 * 65], s[5 * 65]); o.w = pk2(s[6 * 65], s[7 * 65]);
        *(u32x4*)(WT + (size_t)(drow0 + nn) * Kd + k0 + 8 * c) = o; }
    asm volatile("s_waitcnt lgkmcnt(0)" ::: "memory");
}
__device__ __forceinline__ void split8(const f32x4 x0, const f32x4 x1, bf16x8& hi, bf16x8& lo) {
    u32x4 h; h.x = pk2(x0[0], x0[1]); h.y = pk2(x0[2], x0[3]); h.z = pk2(x1[0], x1[1]); h.w = pk2(x1[2], x1[3]);
    u32x4 l; l.x = pk2(x0[0] - bflo(h.x), x0[1] - bfhi(h.x)); l.y = pk2(x0[2] - bflo(h.y), x0[3] - bfhi(h.y)); l.z = pk2(x1[0] - bflo(h.z), x1[1] - bfhi(h.z)); l.w = pk2(x1[2] - bflo(h.w), x1[3] - bfhi(h.w));
    hi = __builtin_bit_cast(bf16x8, h); lo = __builtin_bit_cast(bf16x8, l);
}
__device__ __forceinline__ void phase_prep(const Args& a, unsigned char* const ws_, float* const out_, LAS unsigned char* lds, int gw, int NGW, int wave, int lane) {
    unsigned char* ws = ws_;
    LAS float* scr = (LAS float*)(lds + wave * 16640);
    constexpr int I_UP = 16 * 44, I_DN = 44 * 16, I_GIN = 16 * 52, I_SQ = 16 * 16, I_MDN = 16 * 12;
    constexpr int I_FFN = 2 * I_UP + I_DN;
    constexpr int NITEMS = 4 * I_FFN + I_GIN + I_SQ + I_MDN + I_SQ;
    for (int it = gw; it < NITEMS; it += NGW) {
        int r = it;
        if (r < 4 * I_FFN) {
            const int fi = r / I_FFN; r -= fi * I_FFN; const int layer = fi >> 1, which = fi & 1;
            const float* nrm = a.in[which ? 23 : 6] + layer * DM;
            if (r < 2 * I_UP) { const int isup = r >= I_UP; if (isup) r -= I_UP;
                const float* W = a.in[(which ? 24 : 7) + isup] + (size_t)layer * DM * DFF;
                const int kb = r / 44, nb = r % 44, n0 = nb * 64;
                tr_item(W, DFF, DFF, nrm, (bf16_t*)(ws + ws_wup(fi)), DM, kb * 64, n0, 256 * (n0 >> 7) + (n0 & 127) + 128 * isup, scr, lane);
            } else { r -= 2 * I_UP;
                const float* W = a.in[which ? 26 : 9] + (size_t)layer * DFF * DM;
                const int kb = r / 16, nb = r % 16;
                tr_item(W, DM, DM, nullptr, (bf16_t*)(ws + ws_wdn(fi)), DFF, kb * 64, nb * 64, nb * 64, scr, lane);
            }
            continue;
        }
        r -= 4 * I_FFN;
        if (r < I_GIN) { const int kb = r / 52, nb = r % 52; tr_item(a.in[11], 3088, 3088, a.in[10], (bf16_t*)(ws + WS_WGIN), DM, kb * 64, nb * 64, nb * 64, scr, lane); continue; }
        r -= I_GIN;
        if (r < I_SQ) { const int kb = r / 16, nb = r % 16; tr_item(a.in[15], DM, DM, nullptr, (bf16_t*)(ws + WS_WGOUT), DM, kb * 64, nb * 64, nb * 64, scr, lane); continue; }
        r -= I_SQ;
        if (r < I_MDN) { const int kb = r / 12, nb = r % 12; tr_item(a.in[16], 704, 704, a.in[10] + DM, (bf16_t*)(ws + WS_WMDN), DM, kb * 64, nb * 64, nb * 64, scr, lane); continue; }
        r -= I_MDN;
        { const int kb = r / 16, nb = r % 16; tr_item(a.in[22], DM, DM, nullptr, (bf16_t*)(ws + WS_WMOUT), DM, kb * 64, nb * 64, nb * 64, scr, lane); }
    }
    const int gt = gw * 64 + lane, NGT = NGW * 64;
    {   const float* wuq = a.in[18]; const float* wuk = a.in[20]; const float* qn = a.in[17]; bf16_t* WQ = (bf16_t*)(ws + WS_WQ);
        {   const int fr = lane & 15, fq = lane >> 4;
            for (int it = gw; it < 8 * 24 * 4; it += NGW) {
                const int h = it / 96, ct = (it % 96) >> 2, rg = it & 3;
                const float* ap = wuq + (size_t)(16 * ct + fr) * 1536 + h * 192 + 8 * fq;
                bf16x8 ah[4], al[4];
#pragma unroll
                for (int s = 0; s < 4; ++s) split8(*(const f32x4*)(ap + 32 * s), *(const f32x4*)(ap + 32 * s + 4), ah[s], al[s]);
                const f32x4 qs = *(const f32x4*)(qn + 16 * ct + 4 * fq);
#pragma unroll
                for (int q = 0; q < 4; ++q) { const int rt = rg * 4 + q;
                    const float* bp = wuk + (size_t)(16 * rt + fr) * 1024 + h * 128 + 8 * fq;
                    f32x4 acc = (f32x4){0.f, 0.f, 0.f, 0.f};
#pragma unroll
                    for (int s = 0; s < 4; ++s) { bf16x8 bh, bl; split8(*(const f32x4*)(bp + 32 * s), *(const f32x4*)(bp + 32 * s + 4), bh, bl);
                        acc = mfma16(al[s], bh, acc); acc = mfma16(ah[s], bl, acc); acc = mfma16(ah[s], bh, acc); }
                    acc = acc * qs;
                    u32x2 w; w.x = pk2(acc[0], acc[1]); w.y = pk2(acc[2], acc[3]);
                    *(u32x2*)(WQ + (size_t)(h * 256 + 16 * rt + fr) * 384 + 16 * ct + 4 * fq) = w; }
            }
        }
        for (int i = gt; i < 512 * 384; i += NGT) {
            const int c = i % 384, rr = i / 384, head = rr >> 6, j = rr & 63;
            WQ[(size_t)(2048 + rr) * 384 + c] = (bf16_t)(pk2(wuq[(size_t)c * 1536 + head * 192 + 128 + j] * qn[c], 0.f) & 0xffffu);
        }
    }
    {   const float* wuv = a.in[21]; bf16_t* WU = (bf16_t*)(ws + WS_WUVT);
        for (int i = gt; i < 8 * 128 * 256; i += NGT) { const int j = i & 7, ln = (i >> 3) & 63, s = (i >> 9) & 7, vt = (i >> 12) & 7, h = i >> 15;
            const int dv = 32 * s + 16 * (j >> 2) + 4 * (ln >> 4) + (j & 3), v = 16 * vt + (ln & 15);
            WU[i] = (bf16_t)(pk2(wuv[(size_t)dv * 1024 + h * 128 + v], 0.f) & 0xffffu); }
    }
    {   f32x2* rt = (f32x2*)(ws + WS_ROPE);
        for (int i = gt; i < 4144 * 32; i += NGT) { const int idx = i >> 5, k = i & 31; const float pos = idx < LP ? (float)idx : (float)(PAST + idx - LP);
            const float inv = fexp2(-(float)k * 0.41524101186092029f); const float ang = pos * inv;
            const float kq = rintf(ang * 0.63661977236758134f);
            float r = ang - kq * 1.5703125f; r -= kq * 4.837512969970703125e-4f; r -= kq * 7.54978995489188216e-8f;
            const float r2 = r * r;
            const float sr = r + r * r2 * (-1.6666654611e-1f + r2 * (8.3321608736e-3f + r2 * -1.9515295891e-4f));
            const float cr = 1.0f - 0.5f * r2 + r2 * r2 * (4.166664568298827e-2f + r2 * (-1.388731625493765e-3f + r2 * 2.443315711809948e-5f));
            const int qd = (int)kq & 3;
            const float cs = qd == 0 ? cr : qd == 1 ? -sr : qd == 2 ? -cr : sr, sn = qd == 0 ? sr : qd == 1 ? cr : qd == 2 ? -sr : -cr;
            rt[i] = (f32x2){cs, sn}; }
    }
    {   float* H = (float*)(ws + WS_H); bf16_t* HB = (bf16_t*)(ws + WS_HB); float* SS0 = (float*)(ws + WS_SS);
        for (int row = gw; row < T; row += NGW) {
            const float* src = nullptr;
            if (row < ROWS_P) { const int b = row / LPP, p = row % LPP; if (p >= 64) src = a.in[0] + ((size_t)b * SEQ + (p - 64)) * DM; else if (p >= 48) src = a.in[5] + (size_t)(p - 48) * DM; }
            else src = a.in[1] + (size_t)(row - ROWS_P) * DM;
            float s = 0.f;
#pragma unroll
            for (int j = 0; j < 4; ++j) { f32x4 v = (f32x4){0.f, 0.f, 0.f, 0.f}; if (src) v = *(const f32x4*)(src + 256 * j + 4 * lane);
                if (!RESID_BF16) *(f32x4*)(H + (size_t)row * DM + 256 * j + 4 * lane) = v;
                u32x2 w; w.x = pk2(v[0], v[1]); w.y = pk2(v[2], v[3]); *(u32x2*)(HB + (size_t)row * DM + 256 * j + 4 * lane) = w;
                s += (v[0] * v[0] + v[1] * v[1]) + (v[2] * v[2] + v[3] * v[3]); }
            s = wave_sum(s); if (lane == 0) SS0[row] = s;
        }
    }
}

__device__ __forceinline__ void phase_gla_a(const Args& a, unsigned char* const ws_, float* const out_, LAS unsigned char* lds, int G, int bx, int tid) {
    bf16_t* P = (bf16_t*)(ws_ + WS_BIG); float* DEC = (float*)(ws_ + WS_DEC);
    const float* wg = a.in[12]; const float* bg = a.in[13];
    LAS float* gd = (LAS float*)lds;
    float w[16];
#pragma unroll
    for (int r = 0; r < 16; ++r) w[r] = wg[r * 512 + tid];
    const float bias = bg[tid];
    for (int cg = bx; cg < 260 + SB; cg += G) {
        int row0, nrows, npad;
        if (cg < 260) { const int b = cg / NCH, c = cg % NCH; row0 = b * LPP + 64 * c; nrows = 64; npad = c == 0 ? 48 : 0; }
        else { row0 = ROWS_P + 32 * (cg - 260); nrows = 32; npad = 0; }
        __syncthreads();
        for (int i = tid; i < nrows * 16; i += 512) gd[i] = bf2f(P[(size_t)(row0 + (i >> 4)) * GIN_LD + 3072 + (i & 15)]);
        __syncthreads();
        unsigned short qv[64], kv[64];
#pragma unroll
        for (int i = 0; i < 64; ++i) { qv[i] = 0; kv[i] = 0; if (i < nrows) { const bf16_t* pr = P + (size_t)(row0 + i) * GIN_LD; qv[i] = pr[tid]; kv[i] = pr[512 + tid]; } }
        float gc = 0.f;
#pragma unroll
        for (int i = 0; i < 64; ++i) {
            if (i < nrows) {
                bf16_t* pr = P + (size_t)(row0 + i) * GIN_LD;
                if (i >= npad) {
                    float g = bias;
#pragma unroll
                    for (int r = 0; r < 16; ++r) g += gd[i * 16 + r] * w[r];
                    const float ls = fminf(g, 0.f) - __logf(1.0f + __expf(-fabsf(g)));
                    gc += ls * (1.0f / 16.0f);
                }
                const float q = bf2f(qv[i]), k = bf2f(kv[i]);
                const float eg = __expf(gc);
                pr[tid] = (bf16_t)(pk2(q * 0.08838834764831845f * eg, 0.f) & 0xffffu);
                pr[512 + tid] = (bf16_t)(pk2(k * frcp(eg), 0.f) & 0xffffu);
            }
        }
        DEC[(size_t)cg * 512 + tid] = __expf(gc);
    }
}
__device__ __forceinline__ bf16x8 col8(const bf16_t* p, int stride) {
    bf16x8 r;
#pragma unroll
    for (int j = 0; j < 8; ++j) r[j] = (short)p[(size_t)j * stride];
    return r;
}
__device__ __forceinline__ bf16x8 tr8(const LAS unsigned char* p) {
    const s16x4 lo = __builtin_bit_cast(s16x4, __builtin_amdgcn_ds_read_tr16_b64_v4i16((LAS s16x4*)p));
    const s16x4 hi = __builtin_bit_cast(s16x4, __builtin_amdgcn_ds_read_tr16_b64_v4i16((LAS s16x4*)(p + 128)));
    return (bf16x8){lo[0], lo[1], lo[2], lo[3], hi[0], hi[1], hi[2], hi[3]};
}
__device__ __forceinline__ void phase_gla_b(const Args& a, unsigned char* const ws_, float* const out_, LAS unsigned char* lds, int G, int vcu, int gw, int NGW, int wid, int lane) {
    const bf16_t* P = (const bf16_t*)(ws_ + WS_BIG); const float* DEC = (const float*)(ws_ + WS_DEC);
    bf16_t* SBP = (bf16_t*)((unsigned char*)out_ + OS_SBUFP); bf16_t* SBS = (bf16_t*)(ws_ + WS_SBUFS);
    const int fr = lane & 15, fq = lane >> 4, tid = wid * 64 + lane;
    LAS unsigned char* wl = lds + wid * 8192;
    const int troff = (8 * fq + (fr >> 2)) * 32 + (fr & 3) * 8;
    for (int item = vcu; item < 256; item += G) {
        const int seq = item >> 4, rect = item & 15, dkt = 2 * (rect >> 2) + (wid >> 2), dvs = 4 * (rect & 3) + (wid & 3), b = seq >> 2, h = seq & 3;
        const int krow = tid >> 2, kch = tid & 3, vrow_ = tid >> 3, vch = tid & 7;
        const bf16_t* kp = P + (size_t)(b * LPP + krow) * GIN_LD + 512 + h * 128 + 32 * (rect >> 2) + 8 * kch;
        const bf16_t* vp = P + (size_t)(b * LPP + vrow_) * GIN_LD + 1024 + h * 256 + 64 * (rect & 3) + 8 * vch;
        const int kdst = (kch >> 1) * 2048 + krow * 32 + (kch & 1) * 16, vdst = 8192 + (vch >> 1) * 2048 + vrow_ * 32 + (vch & 1) * 16;
        const int ksrc = (wid >> 2) * 2048 + troff, vsrc = 8192 + (wid & 3) * 2048 + troff;
        const float* dp = DEC + (size_t)(b * NCH) * 512 + h * 128 + 16 * dkt + 4 * fq;
        f32x4 S = (f32x4){0.f, 0.f, 0.f, 0.f};
        u32x4 rk[4], rv[4]; f32x4 rd[4];
#define GB_LOAD(c, I) do { const size_t o_ = (size_t)(64 * (c)) * GIN_LD; if (tid < 256) rk[I] = *(const u32x4*)(kp + o_); rv[I] = *(const u32x4*)(vp + o_); rd[I] = *(const f32x4*)(dp + (size_t)(c) * 512); } while (0)
#define GB_STEP(c, I) do { LAS unsigned char* bb_ = lds + (((c) & 1) ? 16384 : 0); const f32x4 dcur_ = rd[I]; \
            if (tid < 256) *(LAS u32x4*)(bb_ + kdst) = rk[I]; *(LAS u32x4*)(bb_ + vdst) = rv[I]; \
            if ((c) + 4 < NCH) GB_LOAD((c) + 4, I); \
            if ((c) >= 1) { u32x2 w_; w_.x = pk2(S[0], S[1]); w_.y = pk2(S[2], S[3]); \
                *(u32x2*)(SBP + ((size_t)(seq * 64 + ((c) - 1)) * 256 + 16 * dvs + fr) * 128 + 16 * dkt + 4 * fq) = w_; } \
            __syncthreads(); \
            const bf16x8 ka0_ = tr8(bb_ + ksrc), ka1_ = tr8(bb_ + ksrc + 1024), va0_ = tr8(bb_ + vsrc), va1_ = tr8(bb_ + vsrc + 1024); \
            S = mfma16(ka0_, va0_, S); S = mfma16(ka1_, va1_, S); \
            S = S * dcur_; } while (0)
        __syncthreads();
        GB_LOAD(0, 0); GB_LOAD(1, 1); GB_LOAD(2, 2); GB_LOAD(3, 3);
        for (int c = 0; c + 3 < NCH; c += 4) { GB_STEP(c, 0); GB_STEP(c + 1, 1); GB_STEP(c + 2, 2); GB_STEP(c + 3, 3); }
        GB_STEP(NCH - 1, 0);
#undef GB_LOAD
#undef GB_STEP
        float* og = out_ + OUT_GP + ((size_t)seq * 128 + 16 * dkt + 4 * fq) * 256 + 16 * dvs + fr;
#pragma unroll
        for (int r = 0; r < 4; ++r) og[(size_t)r * 256] = S[r];
    }
    __syncthreads();
    for (int rep_ = 0; rep_ < (GB_P2 ? 2 : 1); ++rep_)
    for (int it = gw; it < 128 * 16; it += NGW) {
        const int seq = it >> 4, dkt = (it >> 1) & 7, dvh = it & 1, bs = seq >> 2, h = seq & 3;
        const int lrow = lane & 31;
        const bf16_t* kp = P + (size_t)(ROWS_P + 32 * bs + lrow) * GIN_LD + 512 + h * 128 + 16 * dkt;
        const bf16_t* vp = P + (size_t)(ROWS_P + 32 * bs + lrow) * GIN_LD + 1024 + h * 256 + 128 * dvh;
        { const u32x4 k0 = *(const u32x4*)kp, k1 = *(const u32x4*)(kp + 8);
          if (lane < 32) { *(LAS u32x4*)(wl + lane * 32) = k0; *(LAS u32x4*)(wl + lane * 32 + 16) = k1; } }
        const bf16x8 ka = tr8(wl + troff);
        const f32x4 d = *(const f32x4*)(DEC + (size_t)(260 + bs) * 512 + h * 128 + 16 * dkt + 4 * fq);
#pragma unroll 2
        for (int q = 0; q < 8; ++q) {
            const int dvs = 8 * dvh + q;
            { const u32x4 v0 = *(const u32x4*)(vp + 16 * q), v1 = *(const u32x4*)(vp + 16 * q + 8);
              if (lane < 32) { *(LAS u32x4*)(wl + 4096 + (q & 1) * 2048 + lane * 32) = v0; *(LAS u32x4*)(wl + 4096 + (q & 1) * 2048 + lane * 32 + 16) = v1; } }
            const size_t so = ((size_t)seq * 128 + 16 * dkt + 4 * fq) * 256 + 16 * dvs + fr;
            f32x4 S;
#pragma unroll
            for (int r = 0; r < 4; ++r) S[r] = a.in[2][so + (size_t)r * 256];
            { u32x2 w; w.x = pk2(S[0], S[1]); w.y = pk2(S[2], S[3]); *(u32x2*)(SBS + ((size_t)seq * 256 + 16 * dvs + fr) * 128 + 16 * dkt + 4 * fq) = w; }
            S = mfma16(ka, tr8(wl + 4096 + (q & 1) * 2048 + troff), S);
            S = S * d;
            float* og = out_ + OUT_GS + so;
#pragma unroll
            for (int r = 0; r < 4; ++r) og[(size_t)r * 256] = S[r];
        }
    }
}
template <int NI>
__device__ __forceinline__ void gla_c_item(LAS unsigned char* abuf, LAS float* red, bf16_t* P, const bf16_t* ST, const float* hn, int row0, int h, int wid, int lane) {
    { int zz = 0; asm volatile("" : "+v"(zz)); lane = (int)__builtin_amdgcn_mbcnt_hi(~0u, __builtin_amdgcn_mbcnt_lo(~0u, 0u)) + zz; }
    const int fr = lane & 15, fq = lane >> 4;
    constexpr int ASTR = 144;
    constexpr int NTILE = NI * NI, PERW = NTILE >= 8 ? NTILE / 8 : 1;
#pragma unroll
    for (int q = 0; q < PERW; ++q) {
        const int idx = wid * PERW + q;
        if (idx < NTILE) {
            const int it = idx / NI, jt = idx % NI;
            const bf16_t* kq = P + (size_t)(row0 + 16 * jt + fr) * GIN_LD + 512 + h * 128 + 8 * fq;
            const bf16_t* qq = P + (size_t)(row0 + 16 * it + fr) * GIN_LD + h * 128 + 8 * fq;
            f32x4 d = (f32x4){0.f, 0.f, 0.f, 0.f};
#pragma unroll
            for (int s = 0; s < 4; ++s) d = mfma16(*(const bf16x8*)(kq + 32 * s), *(const bf16x8*)(qq + 32 * s), d);
            const int i = 16 * it + fr, j0 = 16 * jt + 4 * fq;
#pragma unroll
            for (int r = 0; r < 4; ++r) if (j0 + r > i) d[r] = 0.f;
            u32x2 w; w.x = pk2(d[0], d[1]); w.y = pk2(d[2], d[3]);
            *(LAS u32x2*)(abuf + i * ASTR + j0 * 2) = w;
        }
    }
    __syncthreads();
    f32x4 o[2][NI];
#pragma unroll
    for (int dt = 0; dt < 2; ++dt)
#pragma unroll
        for (int it = 0; it < NI; ++it) o[dt][it] = (f32x4){0.f, 0.f, 0.f, 0.f};
    const int dv0 = 32 * wid;
    if (ST) {
#pragma unroll
        for (int s = 0; s < 4; ++s) {
            const bf16x8 s0 = *(const bf16x8*)(ST + (size_t)(dv0 + fr) * 128 + 32 * s + 8 * fq), s1 = *(const bf16x8*)(ST + (size_t)(dv0 + 16 + fr) * 128 + 32 * s + 8 * fq);
#pragma unroll
            for (int it = 0; it < NI; ++it) { const bf16x8 qf = *(const bf16x8*)(P + (size_t)(row0 + 16 * it + fr) * GIN_LD + h * 128 + 32 * s + 8 * fq);
                o[0][it] = mfma16(s0, qf, o[0][it]); o[1][it] = mfma16(s1, qf, o[1][it]); }
        }
    }
#pragma unroll
    for (int s = 0; s < NI / 2; ++s) {
        const bf16_t* vp = P + (size_t)(row0 + 32 * s + 8 * fq) * GIN_LD + 1024 + h * 256 + dv0 + fr;
        const bf16x8 v0 = col8(vp, GIN_LD), v1 = col8(vp + 16, GIN_LD);
#pragma unroll
        for (int it = 2 * s; it < NI; ++it) { const bf16x8 af = *(const LAS bf16x8*)(abuf + (16 * it + fr) * ASTR + (32 * s + 8 * fq) * 2);
            o[0][it] = mfma16(v0, af, o[0][it]); o[1][it] = mfma16(v1, af, o[1][it]); }
    }
#pragma unroll
    for (int it = 0; it < NI; ++it) { float s = 0.f;
#pragma unroll
        for (int dt = 0; dt < 2; ++dt) s += (o[dt][it][0] * o[dt][it][0] + o[dt][it][1] * o[dt][it][1]) + (o[dt][it][2] * o[dt][it][2] + o[dt][it][3] * o[dt][it][3]);
        s += __shfl_xor(s, 16); s += __shfl_xor(s, 32);
        if (fq == 0) red[wid * 64 + 16 * it + fr] = s; }
    __syncthreads();
#pragma unroll
    for (int it = 0; it < NI; ++it) { float tot = 0.f;
#pragma unroll
        for (int w = 0; w < 8; ++w) tot += red[w * 64 + 16 * it + fr];
        const float rs = __builtin_amdgcn_rsqf(tot * (1.0f / 256.0f) + EPS);
#pragma unroll
        for (int dt = 0; dt < 2; ++dt) { const int dv = dv0 + 16 * dt + 4 * fq;
            bf16_t* rp = P + (size_t)(row0 + 16 * it + fr) * GIN_LD + 2048 + h * 256 + dv;
            const u32x2 rr = *(const u32x2*)rp; const f32x4 hw = *(const f32x4*)(hn + dv);
            const float r0 = bflo(rr.x), r1 = bfhi(rr.x), r2 = bflo(rr.y), r3 = bfhi(rr.y);
            u32x2 w; w.x = pk2(o[dt][it][0] * rs * hw[0] * silu_f(r0), o[dt][it][1] * rs * hw[1] * silu_f(r1)); w.y = pk2(o[dt][it][2] * rs * hw[2] * silu_f(r2), o[dt][it][3] * rs * hw[3] * silu_f(r3));
            *(u32x2*)rp = w; }
    }
}
__device__ __forceinline__ void phase_gla_c(const Args& a, unsigned char* const ws_, float* const out_, LAS unsigned char* lds, int G, int bx, int wid, int lane) {
    bf16_t* P = (bf16_t*)(ws_ + WS_BIG);
    const bf16_t* SBP = (const bf16_t*)((unsigned char*)out_ + OS_SBUFP); const bf16_t* SBS = (const bf16_t*)(ws_ + WS_SBUFS);
    int par = 0;
    for (int it = bx; it < 1040 + 128; it += G, par ^= 1) {
        LAS unsigned char* abuf = lds + par * 16384; LAS float* red = (LAS float*)(lds + 32768 + par * 4096);
        if (it < 1040) { const int h = it & 3, c = (it >> 2) % NCH, b = it / 260, seq = b * 4 + h;
            gla_c_item<4>(abuf, red, P, c >= 1 ? SBP + (size_t)(seq * 64 + (c - 1)) * 32768 : nullptr, a.in[14], b * LPP + 64 * c, h, wid, lane);
        } else { const int j = it - 1040, h = j & 3, bs = j >> 2;
            gla_c_item<2>(abuf, red, P, SBS + (size_t)(bs * 4 + h) * 32768, a.in[14], ROWS_P + 32 * bs, h, wid, lane); }
    }
}

__device__ __forceinline__ void phase_mla_prep(const Args& a, unsigned char* const ws_, float* const out_, int gw, int NGW, int lane) {
    const float* DN = (const float*)((unsigned char*)out_ + OS_DN); bf16_t* KP = (bf16_t*)((unsigned char*)out_ + OS_KP);
    bf16_t* KS = (bf16_t*)(ws_ + WS_KS); bf16_t* CQB = (bf16_t*)(ws_ + WS_CQB); float* SSQ = (float*)(ws_ + WS_SS) + 7 * T;
    const f32x2* rt = (const f32x2*)(ws_ + WS_ROPE); const float* kvn = a.in[19];
    for (int row = gw; row < T; row += NGW) {
        const float* d = DN + (size_t)row * MDN_N;
        const f32x2 c0 = *(const f32x2*)(d + 6 * lane), c1 = *(const f32x2*)(d + 6 * lane + 2), c2 = *(const f32x2*)(d + 6 * lane + 4);
        const f32x4 kv = *(const f32x4*)(d + 384 + 4 * lane); const float kr = d[640 + lane];
        float sq = (c0.x * c0.x + c0.y * c0.y) + (c1.x * c1.x + c1.y * c1.y) + (c2.x * c2.x + c2.y * c2.y);
        float sk = (kv[0] * kv[0] + kv[1] * kv[1]) + (kv[2] * kv[2] + kv[3] * kv[3]);
        sq = wave_sum(sq); sk = wave_sum(sk);
        if (lane == 0) SSQ[row] = sq;
        unsigned* cq = (unsigned*)(CQB + (size_t)row * 384 + 6 * lane); cq[0] = pk2(c0.x, c0.y); cq[1] = pk2(c1.x, c1.y); cq[2] = pk2(c2.x, c2.y);
        const float rs = __builtin_amdgcn_rsqf(sk * (1.0f / 256.0f) + EPS); const f32x4 w = *(const f32x4*)(kvn + 4 * lane);
        const f32x4 lat = kv * rs * w;
        int pidx, valid; float* ol; float* orp; bf16_t* krow;
        if (row < ROWS_P) { const int b = row / LPP, p = row % LPP, t = p - 48; valid = p >= 48; pidx = valid ? t : 0;
            ol = out_ + OUT_LP + ((size_t)b * LP + pidx) * 256; orp = out_ + OUT_RP + ((size_t)b * LP + pidx) * 64; krow = KP + (size_t)row * KLD; }
        else { const int j = row - ROWS_P; valid = 1; pidx = LP + (j & 31); ol = out_ + OUT_LS + (size_t)j * 256; orp = out_ + OUT_RS + (size_t)j * 64; krow = KS + ((size_t)(j >> 5) * (PAST + SL) + PAST + (j & 31)) * KLD; }
        const float other = __shfl_xor(kr, 32); const f32x2 cs = rt[(size_t)pidx * 32 + (lane & 31)];
        const float ro = lane < 32 ? kr * cs.x - other * cs.y : kr * cs.x + other * cs.y;
        if (valid) { *(f32x4*)(ol + 4 * lane) = lat; orp[lane] = ro; }
        u32x2 lw; lw.x = pk2(lat[0], lat[1]); lw.y = pk2(lat[2], lat[3]); *(u32x2*)(krow + 4 * lane) = lw;
        krow[256 + lane] = (bf16_t)(pk2(ro, 0.f) & 0xffffu);
    }
    const float* clat = a.in[3]; const float* crope = a.in[4];
    for (int r = gw; r < SB * PAST + 32; r += NGW) {
        if (r < SB * PAST) { const int bs = r >> 11, k = r & (PAST - 1); bf16_t* kd = KS + ((size_t)bs * (PAST + SL) + k) * KLD;
            const f32x4 v = *(const f32x4*)(clat + (size_t)r * 256 + 4 * lane); const float rp = crope[(size_t)r * 64 + lane];
            u32x2 w; w.x = pk2(v[0], v[1]); w.y = pk2(v[2], v[3]); *(u32x2*)(kd + 4 * lane) = w; kd[256 + lane] = (bf16_t)(pk2(rp, 0.f) & 0xffffu);
        } else { bf16_t* kd = KS + ((size_t)SB * (PAST + SL) + (r - SB * PAST)) * KLD; *(u32x2*)(kd + 4 * lane) = (u32x2){0u, 0u}; kd[256 + lane] = 0; }
    }
}

constexpr int KROW = 640, KSTAGE = 64 * KROW;
__device__ __forceinline__ void glds16_asm(const void* gsrc, unsigned lds_dst) { unsigned keep;
    asm volatile("s_mov_b32 %0, m0\n\ts_mov_b32 m0, %2\n\ts_nop 0\n\tglobal_load_lds_dwordx4 %1, off\n\ts_mov_b32 m0, %0" : "=&s"(keep) : "v"(gsrc), "s"(lds_dst) : "memory"); }
__device__ __forceinline__ float xred_max(float v) {
    auto a = __builtin_amdgcn_permlane16_swap(__float_as_uint(v), __float_as_uint(v), false, false); v = fmaxf(__uint_as_float(a[0]), __uint_as_float(a[1]));
    auto b = __builtin_amdgcn_permlane32_swap(__float_as_uint(v), __float_as_uint(v), false, false); return fmaxf(__uint_as_float(b[0]), __uint_as_float(b[1]));
}
__device__ __forceinline__ float xred_sum(float v) {
    auto a = __builtin_amdgcn_permlane16_swap(__float_as_uint(v), __float_as_uint(v), false, false); v = __uint_as_float(a[0]) + __uint_as_float(a[1]);
    auto b = __builtin_amdgcn_permlane32_swap(__float_as_uint(v), __float_as_uint(v), false, false); return __uint_as_float(b[0]) + __uint_as_float(b[1]);
}
__device__ __forceinline__ void attn_unit(LAS unsigned char* lds, const bf16_t* Qb, const bf16_t* Kb, const bf16_t* WuvT, const f32x2* rope, bf16_t* Ob, int qrow0, int NT, int klo0, int khiL, int wid) {
    int lane; { int zz = 0; asm volatile("" : "+v"(zz)); lane = (int)__builtin_amdgcn_mbcnt_hi(~0u, __builtin_amdgcn_mbcnt_lo(~0u, 0u)) + zz; }
    const int fr = lane & 15, fq = lane >> 4, h = wid;
    const bool grpB = wid >= 4;
    bf16x8 qf[10];
    { const bf16_t* qp = Qb + (size_t)(qrow0 + fr) * QLD + h * 320 + 8 * fq;
#pragma unroll
      for (int s = 0; s < 10; ++s) qf[s] = *(const bf16x8*)(qp + 32 * s);
      const int row = qrow0 + fr; int pidx;
      if (row < ROWS_P) { const int p = row % LPP; pidx = p >= 48 ? p - 48 : 0; } else pidx = LP + ((row - ROWS_P) & 31);
      const f32x2* cs = rope + (size_t)pidx * 32 + 8 * fq;
      float o1[8], o2[8];
#pragma unroll
      for (int j = 0; j < 8; ++j) { const f32x2 c = cs[j]; const float x1 = bf2f((unsigned short)qf[8][j]), x2 = bf2f((unsigned short)qf[9][j]); o1[j] = x1 * c.x - x2 * c.y; o2[j] = x2 * c.x + x1 * c.y; }
      u32x4 w1, w2; w1.x = pk2(o1[0], o1[1]); w1.y = pk2(o1[2], o1[3]); w1.z = pk2(o1[4], o1[5]); w1.w = pk2(o1[6], o1[7]);
      w2.x = pk2(o2[0], o2[1]); w2.y = pk2(o2[2], o2[3]); w2.z = pk2(o2[4], o2[5]); w2.w = pk2(o2[6], o2[7]);
      qf[8] = __builtin_bit_cast(bf16x8, w1); qf[9] = __builtin_bit_cast(bf16x8, w2); }
    f32x4 o[16];
#pragma unroll
    for (int d = 0; d < 16; ++d) o[d] = (f32x4){0.f, 0.f, 0.f, 0.f};
    float mrun = -INFINITY, lsum = 0.f;
    int crow[5], cdat[5];
#pragma unroll
    for (int i = 0; i < 5; ++i) { const int pos = (8 * i + wid) * 64 + lane; crow[i] = pos / 40; cdat[i] = (pos % 40) ^ (crow[i] & 6); }
#define ATT_DMA(t, stg) do { const unsigned sb_ = (unsigned)__builtin_amdgcn_readfirstlane((int)(unsigned)(unsigned long)((stg) + wid * 1024)); _Pragma("unroll") for (int i = 0; i < 5; ++i) \
        glds16_asm(Kb + ((size_t)(64 * (t) + crow[i]) * KLD + cdat[i] * 8), sb_ + i * 8192); } while (0)
    const int f6 = fr & 6;
    const int kbe = fr * KROW + ((fq ^ (f6 & 2)) * 16) + ((f6 & 4) ? 64 : 0), kbo = fr * KROW + ((fq ^ (f6 & 2)) * 16) - ((f6 & 4) ? 64 : 0);
    const int vrow = 4 * fq + (fr >> 2), g2 = (vrow & 6) >> 1;
    int vbs[4];
#pragma unroll
    for (int e = 0; e < 4; ++e) vbs[e] = vrow * KROW + 32 * (e ^ g2) + 16 * ((fr >> 1) & 1) + 8 * (fr & 1);
    bf16x8 pf[2] = {(bf16x8){0, 0, 0, 0, 0, 0, 0, 0}, (bf16x8){0, 0, 0, 0, 0, 0, 0, 0}};
    auto qk_sm = [&](LAS unsigned char* stg, int klo, int khi, bool masked) {
        f32x4 st[4];
#pragma unroll
        for (int Tt = 0; Tt < 4; ++Tt) st[Tt] = (f32x4){0.f, 0.f, 0.f, 0.f};
        const LAS unsigned char* kE = stg + kbe; const LAS unsigned char* kO = stg + kbo;
        constexpr int KD = 4;
        bf16x8 kf[KD][4];
#define ATT_KLOAD(s) do { _Pragma("unroll") for (int Tt = 0; Tt < 4; ++Tt) kf[(s) % KD][Tt] = *(const LAS bf16x8*)((((s) & 1) ? kO : kE) + Tt * (16 * KROW) + (s) * 64); } while (0)
#pragma unroll
        for (int s = 0; s < KD - 1; ++s) ATT_KLOAD(s);
#pragma unroll
        for (int s = 0; s < 10; ++s) {
            if (s + KD - 1 < 10) ATT_KLOAD(s + KD - 1);
#pragma unroll
            for (int Tt = 0; Tt < 4; ++Tt) st[Tt] = mfma16(kf[s % KD][Tt], qf[s], st[Tt]);
            __builtin_amdgcn_sched_barrier(0);
        }
#undef ATT_KLOAD
        if (masked) {
#pragma unroll
            for (int Tt = 0; Tt < 4; ++Tt)
#pragma unroll
                for (int r = 0; r < 4; ++r) { const int kk = 16 * Tt + 4 * fq + r; if (kk < klo || kk >= khi) st[Tt][r] = -INFINITY; }
        }
        if (ATT_P1) {
            f32x4 s2[4];
#pragma unroll
            for (int Tt = 0; Tt < 4; ++Tt) { s2[Tt] = st[Tt]; asm volatile("" : "+v"(s2[Tt])); }
            float m2 = fmaxf(fmaxf(s2[0][0], s2[0][1]), fmaxf(s2[0][2], s2[0][3]));
#pragma unroll
            for (int Tt = 1; Tt < 4; ++Tt) m2 = fmaxf(m2, fmaxf(fmaxf(s2[Tt][0], s2[Tt][1]), fmaxf(s2[Tt][2], s2[Tt][3])));
            m2 = xred_max(m2); float p2 = 0.f;
#pragma unroll
            for (int Tt = 0; Tt < 4; ++Tt)
#pragma unroll
                for (int r = 0; r < 4; ++r) { s2[Tt][r] = fexp2(s2[Tt][r] - m2); p2 += s2[Tt][r]; }
            unsigned q2 = 0;
#pragma unroll
            for (int s = 0; s < 2; ++s) { q2 ^= pk2(s2[2 * s][0], s2[2 * s][1]) ^ pk2(s2[2 * s][2], s2[2 * s][3]) ^ pk2(s2[2 * s + 1][0], s2[2 * s + 1][1]) ^ pk2(s2[2 * s + 1][2], s2[2 * s + 1][3]); }
            asm volatile("" :: "v"(p2), "v"(q2));
        }
        float mx = fmaxf(fmaxf(st[0][0], st[0][1]), fmaxf(st[0][2], st[0][3]));
#pragma unroll
        for (int Tt = 1; Tt < 4; ++Tt) mx = fmaxf(mx, fmaxf(fmaxf(st[Tt][0], st[Tt][1]), fmaxf(st[Tt][2], st[Tt][3])));
        mx = xred_max(mx);
        if (__any(mx > mrun + 8.0f)) {
            const float mnew = fmaxf(mrun, mx), alpha = fexp2(mrun - mnew); mrun = mnew;
            lsum *= alpha;
#pragma unroll
            for (int d = 0; d < 16; ++d) o[d] = o[d] * alpha;
        }
        float ps = 0.f;
#pragma unroll
        for (int Tt = 0; Tt < 4; ++Tt)
#pragma unroll
            for (int r = 0; r < 4; ++r) { st[Tt][r] = fexp2(st[Tt][r] - mrun); ps += st[Tt][r]; }
        lsum += ps;
#pragma unroll
        for (int s = 0; s < 2; ++s) { u32x4 w; w.x = pk2(st[2 * s][0], st[2 * s][1]); w.y = pk2(st[2 * s][2], st[2 * s][3]); w.z = pk2(st[2 * s + 1][0], st[2 * s + 1][1]); w.w = pk2(st[2 * s + 1][2], st[2 * s + 1][3]); pf[s] = __builtin_bit_cast(bf16x8, w); }
    };
    auto pv = [&](LAS unsigned char* stg) {
        constexpr int VD = 8;
        s16x4 vl[VD], vh[VD];
#define ATT_VLOAD(p) do { const int d_ = (p) >> 1, s_ = (p) & 1; \
            vl[(p) % VD] = __builtin_bit_cast(s16x4, __builtin_amdgcn_ds_read_tr16_b64_v4i16((LAS s16x4*)(stg + vbs[d_ & 3] + (32 * s_) * KROW + (d_ >> 2) * 128))); \
            vh[(p) % VD] = __builtin_bit_cast(s16x4, __builtin_amdgcn_ds_read_tr16_b64_v4i16((LAS s16x4*)(stg + vbs[d_ & 3] + (32 * s_ + 16) * KROW + (d_ >> 2) * 128))); } while (0)
#pragma unroll
        for (int p = 0; p < VD; ++p) ATT_VLOAD(p);
#pragma unroll
        for (int p = 0; p < 32; ++p) {
            const s16x4 lo = vl[p % VD], hi = vh[p % VD];
            const bf16x8 vf = (bf16x8){lo[0], lo[1], lo[2], lo[3], hi[0], hi[1], hi[2], hi[3]};
            o[p >> 1] = mfma16(vf, pf[p & 1], o[p >> 1]);
            if (p + VD < 32) ATT_VLOAD(p + VD);
            __builtin_amdgcn_sched_barrier(0);
        }
#undef ATT_VLOAD
    };
    ATT_DMA(0, lds);
    asm volatile("s_waitcnt vmcnt(0)" ::: "memory"); __syncthreads();
    int sc = 0;
    for (int t = 0; t < NT; ++t) {
        const int sn = sc == 2 ? 0 : sc + 1, sp = sc == 0 ? 2 : sc - 1;
        if (t + 1 < NT) ATT_DMA(t + 1, lds + sn * KSTAGE);
        const bool msk = (t == 0 && klo0 > 0) || (t == NT - 1 && khiL < 64);
        const int klo = t == 0 ? klo0 : 0, khi = t == NT - 1 ? khiL : 64;
        if (grpB && t > 0) pv(lds + sp * KSTAGE);
        qk_sm(lds + sc * KSTAGE, klo, khi, msk);
        if (!grpB) pv(lds + sc * KSTAGE);
        asm volatile("s_waitcnt vmcnt(0)" ::: "memory"); __syncthreads();
        if (ATT_P2) { asm volatile("s_waitcnt vmcnt(0)" ::: "memory"); __syncthreads(); }
        sc = sn;
    }
    if (grpB) pv(lds + (sc == 0 ? 2 : sc - 1) * KSTAGE);
#undef ATT_DMA
    lsum = xred_sum(lsum);
    const float inv = frcp(lsum);
    bf16x8 bfr[8];
#pragma unroll
    for (int s = 0; s < 8; ++s) { u32x4 w; w.x = pk2(o[2 * s][0] * inv, o[2 * s][1] * inv); w.y = pk2(o[2 * s][2] * inv, o[2 * s][3] * inv); w.z = pk2(o[2 * s + 1][0] * inv, o[2 * s + 1][1] * inv); w.w = pk2(o[2 * s + 1][2] * inv, o[2 * s + 1][3] * inv); bfr[s] = __builtin_bit_cast(bf16x8, w); }
    const bf16_t* wu = WuvT + (size_t)h * 32768 + lane * 8;
    bf16_t* op = Ob + (size_t)(qrow0 + fr) * DM + h * 128 + 4 * fq;
    bf16x8 wa[2][16];
#define EP_LOAD(g) do { _Pragma("unroll") for (int i = 0; i < 16; ++i) wa[(g) & 1][i] = *(const bf16x8*)(wu + ((g) * 16 + i) * 512); } while (0)
#define EP_COMP(g) do { _Pragma("unroll") for (int vv = 0; vv < 2; ++vv) { f32x4 acc = (f32x4){0.f, 0.f, 0.f, 0.f}; \
        _Pragma("unroll") for (int s = 0; s < 8; ++s) acc = mfma16(wa[(g) & 1][vv * 8 + s], bfr[s], acc); \
        u32x2 w; w.x = pk2(acc[0], acc[1]); w.y = pk2(acc[2], acc[3]); *(u32x2*)(op + 16 * (2 * (g) + vv)) = w; } } while (0)
    EP_LOAD(0); EP_LOAD(1); __builtin_amdgcn_sched_barrier(0);
    EP_COMP(0); __builtin_amdgcn_sched_barrier(0); EP_LOAD(2); __builtin_amdgcn_sched_barrier(0);
    EP_COMP(1); __builtin_amdgcn_sched_barrier(0); EP_LOAD(3); __builtin_amdgcn_sched_barrier(0);
    EP_COMP(2); __builtin_amdgcn_sched_barrier(0); EP_COMP(3);
#undef EP_LOAD
#undef EP_COMP
    __syncthreads();
}
__device__ __forceinline__ void phase_attn(const Args& a, unsigned char* const ws_, float* const out_, LAS unsigned char* lds, int G, int bx, int tid, int wid, int lane) {
    const bf16_t* Qb = (const bf16_t*)(ws_ + WS_BIG); const bf16_t* KP = (const bf16_t*)((unsigned char*)out_ + OS_KP); const bf16_t* KS = (const bf16_t*)(ws_ + WS_KS);
    const bf16_t* WU = (const bf16_t*)(ws_ + WS_WUVT); bf16_t* Ob = (bf16_t*)((unsigned char*)out_ + OS_DN);
    for (int rd = 0;; ++rd) {
        const int j = (rd & 1) ? (rd + 1) * G - 1 - bx : rd * G + bx;
        if (rd * G >= 1092) break;
        if (j >= 1092) continue;
        const bf16_t* Kb; int qrow0, NT, klo0, khiL;
        if (j >= 512 && j < 576) { const int s = j - 512, bs = s >> 1, half = s & 1; Kb = KS + (size_t)bs * (PAST + SL) * KLD; qrow0 = ROWS_P + 32 * bs + 16 * half; NT = 33; klo0 = 0; khiL = 32; }
        else {
            int b, m, qt;
            if (j < 512) { m = 64 - (j >> 4); b = (j & 15) >> 2; qt = j & 3; }
            else if (j < 1088) { const int jj = j - 576; m = 32 - (jj >> 4); b = (jj & 15) >> 2; qt = jj & 3; }
            else { m = 0; b = j - 1088; qt = 3; }
            Kb = KP + (size_t)b * LPP * KLD; qrow0 = b * LPP + 64 * m + 16 * qt; NT = m + 1; klo0 = 48; khiL = 64;
        }
        attn_unit(lds, Qb, Kb, WU, (const f32x2*)(ws_ + WS_ROPE), Ob, qrow0, NT, klo0, khiL, wid);
    }
}

__device__ __forceinline__ void phase_final(const Args& a, unsigned char* const ws_, float* const out_, int gw, int NGW, int lane) {
    const float* H = (const float*)(ws_ + WS_H); const float* SS = (const float*)(ws_ + WS_SS) + 6 * T; const float* fn = a.in[27];
    for (int row = gw; row < T; row += NGW) {
        float* dst;
        if (row < ROWS_P) { const int b = row / LPP, p = row % LPP; if (p < 64) continue; dst = out_ + OUT_YP + ((size_t)b * SEQ + (p - 64)) * DM; }
        else dst = out_ + OUT_YS + (size_t)(row - ROWS_P) * DM;
        const float rs = __builtin_amdgcn_rsqf(SS[row] * (1.0f / DM) + EPS);
#pragma unroll
        for (int j = 0; j < 4; ++j) { f32x4 v; const f32x4 w = *(const f32x4*)(fn + 256 * j + 4 * lane);
            if (RESID_BF16) { const u32x2 hv = *(const u32x2*)((const bf16_t*)(ws_ + WS_HB) + (size_t)row * DM + 256 * j + 4 * lane); v = (f32x4){bflo(hv.x), bfhi(hv.x), bflo(hv.y), bfhi(hv.y)}; }
            else v = *(const f32x4*)(H + (size_t)row * DM + 256 * j + 4 * lane);
            *(f32x4*)(dst + 256 * j + 4 * lane) = v * rs * w; }
    }
}

__device__ __forceinline__ void resid_fix(const pg8::SplitOrder& S, float* H, bf16_t* HB, float* ssn, float scale, const unsigned char* part, int gw, int NGW, int lane) {
    if (S.S <= 1) return;
    const int nitem = S.rem * 128, fr = lane & 15, fq = lane >> 4;
    for (int it = gw; it < nitem; it += NGW) {
        const int j = it >> 7, q = it & 127, w = q >> 4, ai = (q >> 3) & 1, m = (q >> 1) & 3, bj = q & 1; int pm, pn; S.tile(S.full * S.G + j, pm, pn);
        const unsigned char* p = part + (size_t)(j * S.S) * 131072 + (size_t)q * 1024 + lane * 16;
        f32x4 a0 = {0.f, 0.f, 0.f, 0.f}, a1 = {0.f, 0.f, 0.f, 0.f};
#define RF_ACC(v) do { a0[0] += bflo(v.x); a0[1] += bfhi(v.x); a0[2] += bflo(v.y); a0[3] += bfhi(v.y); a1[0] += bflo(v.z); a1[1] += bfhi(v.z); a1[2] += bflo(v.w); a1[3] += bfhi(v.w); } while (0)
        int s = 0;
        for (; s + 4 <= S.S; s += 4) { const u32x4 x0 = *(const u32x4*)(p + (size_t)s * 131072), x1 = *(const u32x4*)(p + (size_t)(s + 1) * 131072), x2 = *(const u32x4*)(p + (size_t)(s + 2) * 131072), x3 = *(const u32x4*)(p + (size_t)(s + 3) * 131072);
            RF_ACC(x0); RF_ACC(x1); RF_ACC(x2); RF_ACC(x3); }
        for (; s < S.S; ++s) { const u32x4 x0 = *(const u32x4*)(p + (size_t)s * 131072); RF_ACC(x0); }
#undef RF_ACC
        const int row = pm * 256 + ai * 128 + (w >> 2) * 64 + m * 16 + fr;
        const size_t off = (size_t)row * DM + pn * 256 + bj * 128 + (w & 3) * 32 + 4 * fq;
        f32x4 v0, v1;
        if (RESID_BF16) { const u32x2 h0 = *(const u32x2*)(HB + off), h1 = *(const u32x2*)(HB + off + 16);
            v0 = (f32x4){bflo(h0.x), bfhi(h0.x), bflo(h0.y), bfhi(h0.y)} + a0 * scale; v1 = (f32x4){bflo(h1.x), bfhi(h1.x), bflo(h1.y), bfhi(h1.y)} + a1 * scale; }
        else { v0 = *(const f32x4*)(H + off) + a0 * scale; v1 = *(const f32x4*)(H + off + 16) + a1 * scale; *(f32x4*)(H + off) = v0; *(f32x4*)(H + off + 16) = v1; }
        u32x2 w0; w0.x = pk2(v0[0], v0[1]); w0.y = pk2(v0[2], v0[3]); *(u32x2*)(HB + off) = w0;
        u32x2 w1; w1.x = pk2(v1[0], v1[1]); w1.y = pk2(v1[2], v1[3]); *(u32x2*)(HB + off + 16) = w1;
        float sq = ((v0[0] * v0[0] + v0[1] * v0[1]) + (v0[2] * v0[2] + v0[3] * v0[3])) + ((v1[0] * v1[0] + v1[1] * v1[1]) + (v1[2] * v1[2] + v1[3] * v1[3]));
        sq += __shfl_xor(sq, 16); sq += __shfl_xor(sq, 32);
        if (fq == 0) atomicAdd(ssn + row, sq);
    }
}

constexpr int NPHASE = 20;
constexpr int LDS_BYTES = 147456;
__global__ void __launch_bounds__(512, 2) mk_fwd(Args args0) {
    __shared__ __attribute__((aligned(16))) unsigned char lds_raw[LDS_BYTES];
    LAS unsigned char* lds = (LAS unsigned char*)lds_raw;
    const int tid0 = threadIdx.x; const int wave0 = __builtin_amdgcn_readfirstlane(tid0 >> 6);
    const int G0 = gridDim.x, bx0 = blockIdx.x;
    unsigned char* ws0 = args0.ws;
    volatile LAS unsigned* MISC = (volatile LAS unsigned*)(lds + 131072 + 8192);
    if (tid0 < 16) MISC[tid0] = 0u;
    __syncthreads();
    XcdBarrier bar; bar.bar = (unsigned*)(ws0 + WS_CTL) + CW_BAR; bar.x = 0; bar.st = nullptr;
    const bool one_launch = (args0.ph_hi - args0.ph_lo) > 1;
    if (one_launch) bar = xcd_barrier_post((unsigned*)(ws0 + WS_CTL) + CW_BAR, MISC + 8);

    const int nsteps = (args0.ph_hi - args0.ph_lo) + (one_launch ? __builtin_popcount(DUP_MASK) : 0);
    for (int step = 0; step < nsteps; ++step) {
        int ph = args0.ph_lo + step;
        if (DUP_MASK != 0u && one_launch) { int p = 0, accn = 0; for (;;) { const int cnt = 1 + (int)((DUP_MASK >> p) & 1u); if (step < accn + cnt) break; accn += cnt; ++p; } ph = p; }
        long z = 0; int bx = bx0, G = G0;
        asm volatile("" : "+s"(z), "+s"(bx), "+s"(G));
        const int NGW = G * 8;
        unsigned char* ws = ws0 + z; float* outp = args0.out + z;
        int lane = (int)__builtin_amdgcn_mbcnt_hi(~0u, __builtin_amdgcn_mbcnt_lo(~0u, 0u)) + (int)z;
        const int wave = wave0, tid = wave * 64 + lane;
        const int vcu = (G % 8 == 0) ? (bx % 8) * (G / 8) + bx / 8 : bx, gw = vcu * 8 + wave;
        float* SS = (float*)(ws + WS_SS);
        float* H = (float*)(ws + WS_H); bf16_t* HB = (bf16_t*)(ws + WS_HB); bf16_t* BIG = (bf16_t*)(ws + WS_BIG);
        switch (ph) {
        case 0: phase_prep(args0, ws, outp, lds, gw, NGW, wave, lane); break;
        case 1: case 8: case 10: case 17: {
            const int fi = ph == 1 ? 0 : ph == 8 ? 1 : ph == 10 ? 2 : 3;
            const int ssi = ph == 1 ? 0 : ph == 8 ? 2 : ph == 10 ? 3 : 5;
            pg8::Gemm g{HB, (const bf16_t*)(ws + ws_wup(fi)), T, 5632, DM, DM};
            pg8::StaticOrder S; S.init(T, 5632, G, bx);
            pg8::EpiSwiglu E{BIG, SS + (size_t)ssi * T};
            pg8::gemm_phase<pg8::EpiSwiglu, pg8::StaticOrder, true>(lds, g, S, E, tid);
        } break;
        case 2: case 9: case 11: case 18: case 7: case 16: {
            const bf16_t* A; const bf16_t* Bt; int K, lda, sso; float scale;
            if (ph == 7) { A = BIG + 2048; lda = GIN_LD; K = DM; Bt = (const bf16_t*)(ws + WS_WGOUT); sso = 2; scale = 1.0f; }
            else if (ph == 16) { A = (const bf16_t*)((unsigned char*)outp + OS_DN); lda = DM; K = DM; Bt = (const bf16_t*)(ws + WS_WMOUT); sso = 5; scale = 1.0f; }
            else { const int fi = ph == 2 ? 0 : ph == 9 ? 1 : ph == 11 ? 2 : 3; A = BIG; lda = DFF; K = DFF; Bt = (const bf16_t*)(ws + ws_wdn(fi)); sso = ph == 2 ? 1 : ph == 9 ? 3 : ph == 11 ? 4 : 6; scale = 0.5f; }
            unsigned char* part = ph == 16 ? (unsigned char*)BIG : (unsigned char*)outp;
            pg8::Gemm g{A, Bt, T, DM, K, lda};
            pg8::SplitOrder S; S.init(T, DM, K, G, bx);
            pg8::EpiResid E{H, HB, SS + (size_t)sso * T, scale, part};
            pg8::gemm_phase<pg8::EpiResid, pg8::SplitOrder, true>(lds, g, S, E, tid);
            if (S.S > 1) { xcd_barrier(bar); resid_fix(S, H, HB, SS + (size_t)sso * T, scale, part, gw, NGW, lane); }
        } break;
        case 3: {
            pg8::Gemm g{HB, (const bf16_t*)(ws + WS_WGIN), T, GIN_N, DM, DM};
            pg8::StaticOrder S; S.init(T, GIN_N, G, bx);
            pg8::EpiScaleBf16 E{BIG, GIN_LD, SS + (size_t)1 * T};
            pg8::gemm_phase<pg8::EpiScaleBf16, pg8::StaticOrder, true>(lds, g, S, E, tid);
        } break;
        case 4: phase_gla_a(args0, ws, outp, lds, G, bx, tid); break;
        case 5: phase_gla_b(args0, ws, outp, lds, G, vcu, gw, NGW, wave, lane); break;
        case 6: phase_gla_c(args0, ws, outp, lds, G, bx, wave, lane); break;
        case 12: {
            pg8::Gemm g{HB, (const bf16_t*)(ws + WS_WMDN), T, MDN_N, DM, DM};
            pg8::StaticOrder S; S.init(T, MDN_N, G, bx);
            pg8::EpiScaleF32 E{(float*)((unsigned char*)outp + OS_DN), MDN_N, SS + (size_t)4 * T};
            pg8::gemm_phase<pg8::EpiScaleF32, pg8::StaticOrder, true>(lds, g, S, E, tid);
        } break;
        case 13: phase_mla_prep(args0, ws, outp, gw, NGW, lane); break;
        case 14: {
            pg8::Gemm g{(const bf16_t*)(ws + WS_CQB), (const bf16_t*)(ws + WS_WQ), T, QN, 384, 384};
            pg8::StaticOrder S; S.init(T, QN, G, bx);
            pg8::EpiQ E{BIG, SS + (size_t)7 * T, 0.07216878364870322f * LOG2E};
            pg8::gemm_phase<pg8::EpiQ, pg8::StaticOrder, true>(lds, g, S, E, tid);
        } break;
        case 15: phase_attn(args0, ws, outp, lds, G, bx, tid, wave, lane); break;
        case 19: phase_final(args0, ws, outp, gw, NGW, lane); break;
        default: break;
        }
        if (step + 1 < nsteps) xcd_barrier(bar);
    }
}

extern "C" void kernel_launch(void* const* d_in, const int* in_sizes, int n_in, void* d_out, int out_size, void* d_ws, size_t ws_size, hipStream_t stream) {
    static int grid = 0;
    if (grid == 0) {
        if (n_in != 28 || out_size != (int)OUT_END || ws_size < WS_END) { fprintf(stderr, "kernel_launch: unexpected sizes n_in %d out %d ws %zu (need %zu)\n", n_in, out_size, ws_size, (size_t)WS_END); grid = -1; return; }
        int dev = 0, cus = 0;
        if (hipGetDevice(&dev) != hipSuccess || hipDeviceGetAttribute(&cus, hipDeviceAttributeMultiprocessorCount, dev) != hipSuccess || cus < 8) { fprintf(stderr, "kernel_launch: device query failed\n"); grid = -1; return; }
        grid = cus;
    }
    if (grid < 0) return;
    (void)hipMemsetAsync((char*)d_ws + WS_CTL, 0, CTL_ZERO_BYTES, stream);
    Args a{};
    for (int i = 0; i < 28; ++i) a.in[i] = (const float*)d_in[i];
    a.out = (float*)d_out; a.ws = (unsigned char*)d_ws;
#if MK_N_LAUNCHES == 1
    a.ph_lo = 0; a.ph_hi = NPHASE;
    hipLaunchKernelGGL(mk_fwd, dim3(grid), dim3(512), 0, stream, a);
#else
    for (int p = 0; p < NPHASE; ++p) { a.ph_lo = p; a.ph_hi = p + 1; hipLaunchKernelGGL(mk_fwd, dim3(grid), dim3(512), 0, stream, a); }
#endif
}
```

```cpp
#include <hip/hip_runtime.h>
#include <cstdio>
#include <cstdint>

#ifndef MK_N_LAUNCHES
#define MK_N_LAUNCHES 1
#endif

#ifndef GB_P1
#define GB_P1 0
#endif
#ifndef GB_P2
#define GB_P2 0
#endif
#ifndef ATT_P1
#define ATT_P1 0
#endif
#ifndef ATT_P2
#define ATT_P2 0
#endif
#ifndef ATT_P3
#define ATT_P3 0
#endif
#ifndef ATT_PROBEBASE
#define ATT_PROBEBASE 0
#endif
#ifndef ATT_DUPQK
#define ATT_DUPQK 0
#endif
#ifndef ATT_DUPPV
#define ATT_DUPPV 0
#endif
#ifndef RESID_BF16
#define RESID_BF16 1
#endif
#ifndef DUP_MASK
#define DUP_MASK 0u
#endif

#define LAS __attribute__((address_space(3)))
#define GAS __attribute__((address_space(1)))
typedef unsigned short bf16_t;
typedef short bf16x8 __attribute__((ext_vector_type(8)));
typedef short s16x4 __attribute__((ext_vector_type(4)));
typedef float f32x4 __attribute__((ext_vector_type(4)));
typedef float f32x2 __attribute__((ext_vector_type(2)));
typedef unsigned u32x4 __attribute__((ext_vector_type(4)));
typedef unsigned u32x2 __attribute__((ext_vector_type(2)));
typedef __bf16 bf16x2_t __attribute__((ext_vector_type(2)));

constexpr int DM = 1024, DFF = 2816, NB = 4, SEQ = 4096, NMETA = 16, LP = 4112, LPP = 4160, NCH = 65;
constexpr int SB = 32, SL = 32, PAST = 2048;
constexpr int ROWS_P = NB * LPP;
constexpr int T = ROWS_P + SB * SL;
constexpr int GIN_N = 3328, GIN_LD = 3328;
constexpr int MDN_N = 768;
constexpr int QN = 2560, QLD = 2560;
constexpr int KLD = 320;
constexpr float EPS = 1e-6f;
constexpr float LOG2E = 1.4426950408889634f;

constexpr size_t OUT_YP = 0, OUT_YS = 16777216, OUT_GP = 17825792, OUT_GS = 18350080, OUT_LP = 22544384, OUT_RP = 26755072, OUT_LS = 27807744, OUT_RS = 28069888, OUT_END = 28135424;
constexpr size_t MiB = 1u << 20;
constexpr size_t OS_SBUFP = 0;
constexpr size_t OS_DN = 0;
constexpr size_t OS_KP = 52 * MiB;

constexpr size_t WS_CTL = 0, CTL_ZERO_BYTES = 1 * MiB;
constexpr size_t WS_SS = 256 * 1024;
constexpr size_t WS_L0 = 1 * MiB;
constexpr size_t WS_KS = WS_L0;
constexpr size_t WS_WGIN = WS_L0 + 33 * MiB;
constexpr size_t WS_WGOUT = WS_WGIN + 6 * MiB + 512 * 1024;
constexpr size_t WS_L1 = 43 * MiB;
constexpr size_t WS_WMDN = WS_L1 + 33 * MiB;
constexpr size_t WS_WMOUT = WS_WMDN + 1 * MiB + 512 * 1024;
constexpr size_t WS_WQ = WS_WMOUT + 2 * MiB;
constexpr size_t WS_WUVT = WS_WQ + 2 * MiB;
constexpr size_t WS_ROPE = WS_WUVT + 512 * 1024;
constexpr size_t WS_DEC = WS_ROPE + 1 * MiB + 256 * 1024;
constexpr size_t WS_SBUFS = WS_DEC + 1 * MiB;
__host__ __device__ constexpr size_t ws_wup(int fi) { return (fi < 2 ? WS_L0 : WS_L1) + (size_t)(fi & 1) * 11 * MiB; }
__host__ __device__ constexpr size_t ws_wdn(int fi) { return (fi < 2 ? WS_L0 : WS_L1) + 22 * MiB + (size_t)(fi & 1) * (5 * MiB + 512 * 1024); }
static_assert((size_t)(SB * (PAST + SL) + 32) * KLD * 2 <= 41 * MiB + 512 * 1024, "KS fits the layer-0 weight block");
constexpr size_t WS_H = WS_SBUFS + 8 * MiB;
constexpr size_t WS_HB = WS_H + 69 * MiB;
constexpr size_t WS_BIG = WS_HB + 34 * MiB + 512 * 1024;
constexpr size_t WS_CQB = WS_BIG + 87 * MiB;
constexpr size_t WS_END = WS_BIG + 112 * MiB + 128 * 1024;
static_assert(WS_CQB + 13 * MiB <= WS_END, "ws map");
static_assert((size_t)T * QLD * 2 <= 87 * MiB, "Q fits");

constexpr int CW_BAR = 4096;

__device__ __forceinline__ unsigned pk2(float lo, float hi) { f32x2 v = {lo, hi}; bf16x2_t b = __builtin_convertvector(v, bf16x2_t); return __builtin_bit_cast(unsigned, b); }
__device__ __forceinline__ float bf2f(unsigned short x) { return __uint_as_float((unsigned)x << 16); }
__device__ __forceinline__ float bflo(unsigned x) { return __uint_as_float(x << 16); }
__device__ __forceinline__ float bfhi(unsigned x) { return __uint_as_float(x & 0xffff0000u); }
__device__ __forceinline__ float wave_sum(float v) {
#pragma unroll
    for (int o = 1; o < 64; o <<= 1) v += __shfl_xor(v, o);
    return v;
}
__device__ __forceinline__ float fexp2(float x) { return __builtin_amdgcn_exp2f(x); }
__device__ __forceinline__ float frcp(float x) { return __builtin_amdgcn_rcpf(x); }
__device__ __forceinline__ float silu_f(float g) { return g * frcp(1.0f + fexp2(-g * LOG2E)); }
__device__ __forceinline__ f32x4 mfma16(bf16x8 a, bf16x8 b, f32x4 c) { return __builtin_amdgcn_mfma_f32_16x16x32_bf16(a, b, c, 0, 0, 0); }

namespace pg8 {
constexpr int BM = 256, BK = 64, HALF = 128, HTB = HALF * BK * 2, STAGE_BYTES = 8 * HTB, NXCD = 8, WGM = 8;
__host__ __device__ __forceinline__ int lds_byte(int r, int c) { const int st = (r >> 4) * 2 + (c >> 5), rr = r & 15, cc = c & 31, ob = rr * 64 + cc * 2; return st * 1024 + (ob ^ (((ob >> 9) & 1) << 5)); }
__host__ __device__ __forceinline__ void stage_rc(int b, int& R, int& C) { const int st = b / 1024, sb = b % 1024, swz = sb ^ (((sb >> 9) & 1) << 5); R = (st >> 1) * 16 + swz / 64; C = (st & 1) * 32 + (swz % 64) / 2; }
__host__ __device__ __forceinline__ int perm32(int rho) { const int n = rho >> 4, i = rho & 15; return 8 * (i >> 2) + 4 * n + (i & 3); }

struct Unit { int pm, pn, k0, nt, part; };
struct Gemm { const bf16_t* A; const bf16_t* Bt; int M, N, K, lda; };

struct StaticOrder {
    static constexpr bool SPLIT = false;
    int nM, nN, nwg, G, c;
    __device__ void init(int M, int N, int G_, int c_) { nM = M / BM; nN = N / BM; nwg = nM * nN; G = G_; c = c_; }
    __device__ bool next(int i, Unit& u) const {
        const long L = (long)i * G + c; if (L >= nwg) return false;
        int wgid = (int)L; { const int q = nwg / NXCD, r = nwg % NXCD, xcd = wgid % NXCD, off = wgid / NXCD; wgid = (xcd < r ? xcd * (q + 1) : r * (q + 1) + (xcd - r) * q) + off; }
        const int nig = WGM * nN, gid = wgid / nig, fm = gid * WGM, gsz = (nM - fm) < WGM ? (nM - fm) : WGM;
        u.pm = fm + ((wgid % nig) % gsz); u.pn = (wgid % nig) / gsz; return true;
    }
};

struct SplitOrder {
    static constexpr bool SPLIT = true;
    int nM, nN, nwg, G, c, full, rem, S, ntf, per;
    __device__ void init(int M, int N, int K, int G_, int c_) {
        nM = M / BM; nN = N / BM; nwg = nM * nN; G = G_; c = c_; full = nwg / G; rem = nwg % G; ntf = K / BK; S = 1;
        if (rem > 0) { const int pairs = ntf / 2, lim = G / rem; for (int d = 2; d <= pairs && d <= lim; ++d) if (pairs % d == 0) S = d; }
        per = ntf / S;
    }
    __device__ void tile(int L, int& pm, int& pn) const {
        int wgid = L; { const int q = nwg / NXCD, r = nwg % NXCD, xcd = wgid % NXCD, off = wgid / NXCD; wgid = (xcd < r ? xcd * (q + 1) : r * (q + 1) + (xcd - r) * q) + off; }
        const int nig = WGM * nN, gid = wgid / nig, fm = gid * WGM, gsz = (nM - fm) < WGM ? (nM - fm) : WGM;
        pm = fm + ((wgid % nig) % gsz); pn = (wgid % nig) / gsz;
    }
    __device__ bool next(int i, Unit& u) const {
        if (i < full) { tile(i * G + c, u.pm, u.pn); u.k0 = 0; u.nt = ntf; u.part = -1; return true; }
        if (i == full && c < rem * S) { const int j = c / S, s = c - j * S; tile(full * G + j, u.pm, u.pn); u.k0 = s * per; u.nt = per; u.part = S > 1 ? c : -1; return true; }
        return false;
    }
};

template <class Epi, class Sched, bool ALIGN_EPI>
__device__ __forceinline__ void gemm_phase(LAS unsigned char* lds, const Gemm g, const Sched& S, const Epi& E, const int tid) {
    const int wid = __builtin_amdgcn_readfirstlane(tid >> 6), lane = tid & 63, wr = wid >> 2, wc = wid & 3, fr = lane & 15, fq = lane >> 4;
    int K_ = g.K, lda_ = g.lda; asm volatile("" : "+s"(K_), "+s"(lda_));
    const int K = K_, lda = lda_, nt = K / BK;
    unsigned voffA[2], voffB[2];
#pragma unroll
    for (int i = 0; i < 2; ++i) { int R, C; stage_rc(tid * 16 + i * 8192, R, C); const int Rb = Epi::PERM ? ((R & ~31) + perm32(R & 31)) : R;
        voffA[i] = (unsigned)(R * lda + C) * 2u; voffB[i] = (unsigned)(Rb * K + C) * 2u; }
    const size_t kstep = (size_t)(BK * 2);
    const size_t hstepA = (size_t)HALF * lda * 2, hstepB = (size_t)HALF * K * 2;
    const size_t tstepA = 2 * hstepA, tstepB = 2 * hstepB;
    const unsigned ldsw = (unsigned)wid * 1024u;
    const int aoff = lds_byte(wr * 64 + fr, fq * 8), boff = lds_byte(wc * 32 + fr, fq * 8);
#define PG8_SA(b, h) (((b) * 2 + (h)) * HTB)
#define PG8_SB(b, h) ((4 + (b) * 2 + (h)) * HTB)
#define PG8_STAGE(bufoff, gbase, voff) do { _Pragma("unroll") for (int _i = 0; _i < 2; ++_i) \
        __builtin_amdgcn_global_load_lds((const unsigned*)((const char*)(gbase) + (voff)[_i]), (LAS unsigned*)(lds + (bufoff) + ldsw + _i * 8192), 16, 0, 0); } while (0)
#define PG8_LDA(dst, b, h) do { _Pragma("unroll") for (int m = 0; m < 4; ++m) _Pragma("unroll") for (int k = 0; k < 2; ++k) dst[m][k] = *(const LAS bf16x8*)(lds + PG8_SA(b, h) + aoff + m * 2048 + k * 1024); } while (0)
#define PG8_LDB(dst, b, h) do { _Pragma("unroll") for (int n = 0; n < 2; ++n) _Pragma("unroll") for (int k = 0; k < 2; ++k) dst[n][k] = *(const LAS bf16x8*)(lds + PG8_SB(b, h) + boff + n * 2048 + k * 1024); } while (0)
#define PG8_MMA(ai, bj, At, Bt) do { __builtin_amdgcn_s_setprio(1); _Pragma("unroll") for (int m = 0; m < 4; ++m) _Pragma("unroll") for (int n = 0; n < 2; ++n) _Pragma("unroll") for (int k = 0; k < 2; ++k) \
        acc[ai][bj][m][n] = __builtin_amdgcn_mfma_f32_16x16x32_bf16(Bt[n][k], At[m][k], acc[ai][bj][m][n], 0, 0, 0); __builtin_amdgcn_s_setprio(0); } while (0)
#define PG8_WAIT_V(n) asm volatile("s_waitcnt vmcnt(" #n ")" ::: "memory")
#define PG8_WAIT_L(n) asm volatile("s_waitcnt lgkmcnt(" #n ")" ::: "memory")
#define PG8_BAR __builtin_amdgcn_s_barrier()
#define PG8_SCHED __builtin_amdgcn_sched_barrier(0)
    Unit cur, nxt; int ui = 0;
    if (!S.next(0, cur)) return;
    f32x4 acc[2][2][4][2];
#pragma unroll
    for (int a = 0; a < 2; ++a)
#pragma unroll
        for (int b = 0; b < 2; ++b)
#pragma unroll
            for (int m = 0; m < 4; ++m)
#pragma unroll
                for (int n = 0; n < 2; ++n) acc[a][b][m][n] = (f32x4){0.f, 0.f, 0.f, 0.f};
    bf16x8 At[4][2], B0[2][2], B1[2][2];
    const char* cA = (const char*)g.A + (size_t)cur.pm * tstepA; const char* cB = (const char*)g.Bt + (size_t)cur.pn * tstepB;
    int ntc = nt;
    if constexpr (Sched::SPLIT) { cA += (size_t)cur.k0 * kstep; cB += (size_t)cur.k0 * kstep; ntc = cur.nt; }
    PG8_STAGE(PG8_SB(0, 0), cB, voffB); PG8_STAGE(PG8_SB(0, 1), cB + hstepB, voffB); PG8_STAGE(PG8_SA(0, 0), cA, voffA); PG8_STAGE(PG8_SA(0, 1), cA + hstepA, voffA);
    if (wr == 1) PG8_BAR;
    PG8_WAIT_V(2); PG8_BAR;
    PG8_STAGE(PG8_SB(1, 0), cB + kstep, voffB); PG8_STAGE(PG8_SA(1, 0), cA + kstep, voffA); PG8_STAGE(PG8_SB(1, 1), cB + hstepB + kstep, voffB);
    PG8_WAIT_V(6); PG8_BAR;
    for (;;) {
        const bool has_next = S.next(ui + 1, nxt);
        const char* nA = has_next ? (const char*)g.A + (size_t)nxt.pm * tstepA : cA; const char* nB = has_next ? (const char*)g.Bt + (size_t)nxt.pn * tstepB : cB;
        if constexpr (Sched::SPLIT) { if (has_next) { nA += (size_t)nxt.k0 * kstep; nB += (size_t)nxt.k0 * kstep; } }
        for (int t = 0; t < ntc; t += 2) {
            const bool last = (t == ntc - 2);
            const char* a1 = cA + (size_t)(t + 1) * kstep;
            const char* a2 = last ? nA : cA + (size_t)(t + 2) * kstep; const char* b2 = last ? nB : cB + (size_t)(t + 2) * kstep;
            const char* a3 = a2 + kstep; const char* b3 = b2 + kstep;
            PG8_LDB(B0, 0, 0); PG8_LDB(B1, 0, 1); PG8_SCHED; PG8_LDA(At, 0, 0); PG8_STAGE(PG8_SA(1, 1), a1 + hstepA, voffA);
            PG8_WAIT_V(8); PG8_WAIT_L(0); PG8_BAR; PG8_MMA(0, 0, At, B0); PG8_MMA(0, 1, At, B1); PG8_BAR; PG8_SCHED;
            PG8_LDA(At, 0, 1); PG8_STAGE(PG8_SB(0, 0), b2, voffB); PG8_STAGE(PG8_SB(0, 1), b2 + hstepB, voffB); PG8_STAGE(PG8_SA(0, 0), a2, voffA);
            PG8_WAIT_V(8); PG8_WAIT_L(0); PG8_BAR; PG8_MMA(1, 0, At, B0); PG8_MMA(1, 1, At, B1); PG8_BAR; PG8_SCHED;
            PG8_LDB(B0, 1, 0); PG8_LDB(B1, 1, 1); PG8_SCHED; PG8_LDA(At, 1, 0); PG8_STAGE(PG8_SA(0, 1), a2 + hstepA, voffA);
            PG8_WAIT_V(8); PG8_WAIT_L(0); PG8_BAR; PG8_MMA(0, 0, At, B0); PG8_MMA(0, 1, At, B1); PG8_BAR; PG8_SCHED;
            PG8_LDA(At, 1, 1); PG8_STAGE(PG8_SB(1, 0), b3, voffB); PG8_STAGE(PG8_SB(1, 1), b3 + hstepB, voffB); PG8_STAGE(PG8_SA(1, 0), a3, voffA);
            PG8_WAIT_V(8); PG8_WAIT_L(0); PG8_BAR; PG8_MMA(1, 0, At, B0); PG8_MMA(1, 1, At, B1); PG8_BAR; PG8_SCHED;
        }
        if constexpr (ALIGN_EPI) { if (wr == 0) PG8_BAR; }
        if constexpr (Sched::SPLIT) { if (cur.part >= 0) E.partial(acc, cur.part, wr, wc, fr, fq); else E(acc, cur, wr, wc, fr, fq); }
        else E(acc, cur, wr, wc, fr, fq);
        if (!has_next) break;
#pragma unroll
        for (int a = 0; a < 2; ++a)
#pragma unroll
            for (int b = 0; b < 2; ++b)
#pragma unroll
                for (int m = 0; m < 4; ++m)
#pragma unroll
                    for (int n = 0; n < 2; ++n) acc[a][b][m][n] = (f32x4){0.f, 0.f, 0.f, 0.f};
        cur = nxt; cA = nA; cB = nB; ++ui;
        if constexpr (Sched::SPLIT) ntc = nxt.nt;
        if constexpr (ALIGN_EPI) { if (wr == 1) PG8_BAR; }
    }
    PG8_WAIT_V(0);
    if constexpr (!ALIGN_EPI) { if (wr == 0) PG8_BAR; }
    PG8_BAR;
#undef PG8_SA
#undef PG8_SB
#undef PG8_STAGE
#undef PG8_LDA
#undef PG8_LDB
#undef PG8_MMA
#undef PG8_WAIT_V
#undef PG8_WAIT_L
#undef PG8_BAR
#undef PG8_SCHED
}

struct EpiSwiglu {
    static constexpr bool PERM = true;
    bf16_t* O; const float* ss;
    __device__ __forceinline__ void operator()(const f32x4 (&acc)[2][2][4][2], const Unit& u, int wr, int wc, int fr, int fq) const {
        const int row0 = u.pm * BM + wr * 64 + fr, col0 = u.pn * 128 + wc * 32 + 8 * fq;
#pragma unroll
        for (int ai = 0; ai < 2; ++ai)
#pragma unroll
            for (int m = 0; m < 4; ++m) {
                const int row = row0 + ai * HALF + m * 16;
                const float rs = __builtin_amdgcn_rsqf(ss[row] * (1.0f / DM) + EPS);
                float a[8];
#pragma unroll
                for (int n = 0; n < 2; ++n)
#pragma unroll
                    for (int e = 0; e < 4; ++e) { const float gg = acc[ai][0][m][n][e] * rs, uu = acc[ai][1][m][n][e] * rs; a[n * 4 + e] = silu_f(gg) * uu; }
                u32x4 w; w.x = pk2(a[0], a[1]); w.y = pk2(a[2], a[3]); w.z = pk2(a[4], a[5]); w.w = pk2(a[6], a[7]);
                *(u32x4*)(O + (size_t)row * DFF + col0) = w;
            }
    }
};
struct EpiResid {
    static constexpr bool PERM = false;
    float* h; bf16_t* hb; float* ssn; float scale; unsigned char* part;
    __device__ __forceinline__ void partial(const f32x4 (&acc)[2][2][4][2], int slot, int wr, int wc, int fr, int fq) const {
        unsigned char* P = part + (size_t)slot * 131072 + (size_t)(wr * 4 + wc) * 16384 + (size_t)(fq * 16 + fr) * 16;
#pragma unroll
        for (int ai = 0; ai < 2; ++ai)
#pragma unroll
            for (int m = 0; m < 4; ++m)
#pragma unroll
                for (int bj = 0; bj < 2; ++bj) { const f32x4 v0 = acc[ai][bj][m][0], v1 = acc[ai][bj][m][1];
                    u32x4 w; w.x = pk2(v0[0], v0[1]); w.y = pk2(v0[2], v0[3]); w.z = pk2(v1[0], v1[1]); w.w = pk2(v1[2], v1[3]);
                    *(u32x4*)(P + ((ai * 4 + m) * 2 + bj) * 1024) = w; }
    }
    __device__ __forceinline__ void operator()(const f32x4 (&acc)[2][2][4][2], const Unit& u, int wr, int wc, int fr, int fq) const {
        const int row0 = u.pm * BM + wr * 64 + fr, col0 = u.pn * BM + wc * 32 + 4 * fq;
#pragma unroll
        for (int ai = 0; ai < 2; ++ai)
#pragma unroll
            for (int m = 0; m < 4; ++m) {
                const int row = row0 + ai * HALF + m * 16; float s = 0.f;
#pragma unroll
                for (int bj = 0; bj < 2; ++bj)
#pragma unroll
                    for (int n = 0; n < 2; ++n) {
                        const size_t off = (size_t)row * DM + col0 + bj * HALF + n * 16;
                        f32x4 v;
                        if (RESID_BF16) { const u32x2 hv = *(const u32x2*)(hb + off); v = (f32x4){bflo(hv.x), bfhi(hv.x), bflo(hv.y), bfhi(hv.y)} + acc[ai][bj][m][n] * scale; }
                        else { v = *(const f32x4*)(h + off) + acc[ai][bj][m][n] * scale; *(f32x4*)(h + off) = v; }
                        u32x2 w; w.x = pk2(v[0], v[1]); w.y = pk2(v[2], v[3]); *(u32x2*)(hb + off) = w;
                        s += (v[0] * v[0] + v[1] * v[1]) + (v[2] * v[2] + v[3] * v[3]);
                    }
                s += __shfl_xor(s, 16); s += __shfl_xor(s, 32);
                if (fq == 0) atomicAdd(ssn + row, s);
            }
    }
};
struct EpiScaleBf16 {
    static constexpr bool PERM = true;
    bf16_t* O; int ldc; const float* ss;
    __device__ __forceinline__ void operator()(const f32x4 (&acc)[2][2][4][2], const Unit& u, int wr, int wc, int fr, int fq) const {
        const int row0 = u.pm * BM + wr * 64 + fr, col0 = u.pn * BM + wc * 32 + 8 * fq;
#pragma unroll
        for (int ai = 0; ai < 2; ++ai)
#pragma unroll
            for (int m = 0; m < 4; ++m) {
                const int row = row0 + ai * HALF + m * 16;
                const float rs = __builtin_amdgcn_rsqf(ss[row] * (1.0f / DM) + EPS);
#pragma unroll
                for (int bj = 0; bj < 2; ++bj) { const f32x4 v0 = acc[ai][bj][m][0] * rs, v1 = acc[ai][bj][m][1] * rs;
                    u32x4 w; w.x = pk2(v0[0], v0[1]); w.y = pk2(v0[2], v0[3]); w.z = pk2(v1[0], v1[1]); w.w = pk2(v1[2], v1[3]);
                    *(u32x4*)(O + (size_t)row * ldc + col0 + bj * HALF) = w; }
            }
    }
};
struct EpiScaleF32 {
    static constexpr bool PERM = false;
    float* O; int ldc; const float* ss;
    __device__ __forceinline__ void operator()(const f32x4 (&acc)[2][2][4][2], const Unit& u, int wr, int wc, int fr, int fq) const {
        const int row0 = u.pm * BM + wr * 64 + fr, col0 = u.pn * BM + wc * 32 + 4 * fq;
#pragma unroll
        for (int ai = 0; ai < 2; ++ai)
#pragma unroll
            for (int m = 0; m < 4; ++m) {
                const int row = row0 + ai * HALF + m * 16;
                const float rs = __builtin_amdgcn_rsqf(ss[row] * (1.0f / DM) + EPS);
#pragma unroll
                for (int bj = 0; bj < 2; ++bj)
#pragma unroll
                    for (int n = 0; n < 2; ++n) *(f32x4*)(O + (size_t)row * ldc + col0 + bj * HALF + n * 16) = acc[ai][bj][m][n] * rs;
            }
    }
};
struct EpiQ {
    static constexpr bool PERM = true;
    bf16_t* Q; const float* ssq; float c2;
    __device__ __forceinline__ void operator()(const f32x4 (&acc)[2][2][4][2], const Unit& u, int wr, int wc, int fr, int fq) const {
        const int row0 = u.pm * BM + wr * 64 + fr;
        const int cb0 = u.pn < 8 ? u.pn * 320 + wc * 32 + 8 * fq : (4 * (u.pn - 8) + (wc >> 1)) * 320 + 256 + 32 * (wc & 1) + 8 * fq;
        const int cbstep = u.pn < 8 ? HALF : 640;
#pragma unroll
        for (int ai = 0; ai < 2; ++ai)
#pragma unroll
            for (int m = 0; m < 4; ++m) {
                const int row = row0 + ai * HALF + m * 16;
                const float rs = __builtin_amdgcn_rsqf(ssq[row] * (1.0f / 384.0f) + EPS) * c2;
#pragma unroll
                for (int bj = 0; bj < 2; ++bj) { const f32x4 v0 = acc[ai][bj][m][0] * rs, v1 = acc[ai][bj][m][1] * rs;
                    u32x4 w; w.x = pk2(v0[0], v0[1]); w.y = pk2(v0[2], v0[3]); w.z = pk2(v1[0], v1[1]); w.w = pk2(v1[2], v1[3]);
                    *(u32x4*)(Q + (size_t)row * QLD + cb0 + bj * cbstep) = w; }
            }
    }
};
}

#define XB_TMO      128
#define XB_XCNT(j)  (256  + 64 * (j))
#define XB_XSUB(j)  (1280 + 64 * (j))
#define XB_XGEN(j)  (2304 + 64 * (j))
#define XB_TOP      3328
#define XB_TOPGEN   3392
#define XCD_BAR_WORDS 3456
#define XB_SPIN_CAP (1u << 18)
__device__ __forceinline__ unsigned xb_ld(unsigned* p)              { return __hip_atomic_load(p, __ATOMIC_RELAXED, __HIP_MEMORY_SCOPE_AGENT); }
__device__ __forceinline__ unsigned xb_add(unsigned* p, unsigned v) { return __hip_atomic_fetch_add(p, v, __ATOMIC_RELAXED, __HIP_MEMORY_SCOPE_AGENT); }
__device__ __forceinline__ unsigned xb_xcc_id() { return (unsigned)__builtin_amdgcn_s_getreg((3 << 11) | 20) & 0xFu; }
#define XB_SPIN(cond, bar) do { unsigned _sp = 0; while (cond) { __builtin_amdgcn_s_sleep(1); \
    if ((++_sp & 255u) == 0u) { if (xb_ld(&(bar)[XB_TMO])) break; if (_sp > XB_SPIN_CAP) { atomicAdd(&(bar)[XB_TMO], 1u); break; } } } } while (0)
struct XcdBarrier { unsigned* bar; unsigned x; volatile LAS unsigned* st; };
__device__ __forceinline__ XcdBarrier xcd_barrier_post(unsigned* bar, volatile LAS unsigned* st) {
    XcdBarrier b; b.bar = bar; b.x = xb_xcc_id(); b.st = st;
    if (threadIdx.x == 0) (void)xb_add(&bar[XB_XCNT(b.x)], 1u);
    return b;
}
__device__ __forceinline__ void xcd_barrier_complete(unsigned* bar, unsigned x, unsigned& nloc, unsigned& nx) {
    const unsigned G = gridDim.x * gridDim.y * gridDim.z;
    unsigned sum, cnt, mine, sp = 0u;
    for (;;) {
        sum = 0u; cnt = 0u; mine = 0u;
#pragma unroll
        for (unsigned j = 0; j < 16; ++j) { const unsigned c = xb_ld(&bar[XB_XCNT(j)]); sum += c; cnt += (c > 0u) ? 1u : 0u; mine = (j == x) ? c : mine; }
        if (sum == G) break;
        __builtin_amdgcn_s_sleep(1);
        if ((++sp & 255u) == 0u) { if (xb_ld(&bar[XB_TMO])) break; if (sp > XB_SPIN_CAP) { atomicAdd(&bar[XB_TMO], 1u); break; } }
    }
    nloc = mine > 0u ? mine : 1u; nx = cnt > 0u ? cnt : 1u;
}
__device__ __forceinline__ void xcd_barrier(const XcdBarrier& b) {
    asm volatile("s_waitcnt vmcnt(0)" ::: "memory");
    __syncthreads();
    if (threadIdx.x == 0) {
        unsigned* bar = b.bar;
        __builtin_amdgcn_s_waitcnt(0);
        unsigned nloc = b.st[0], nx = b.st[1];
        if (nloc == 0u) { xcd_barrier_complete(bar, b.x, nloc, nx); b.st[0] = nloc; b.st[1] = nx; }
        const unsigned old = xb_add(&bar[XB_XSUB(b.x)], 1u);
        const unsigned gen = old / nloc;
        if (old + 1u == (gen + 1u) * nloc) {
            __builtin_amdgcn_fence(__ATOMIC_RELEASE, "agent");
            asm volatile("s_waitcnt vmcnt(0)" ::: "memory");
            const unsigned og = xb_add(&bar[XB_TOP], 1u);
            const unsigned tg = og / nx;
            if (og + 1u == (tg + 1u) * nx) xb_add(&bar[XB_TOPGEN], 1u);
            else XB_SPIN(xb_ld(&bar[XB_TOPGEN]) == tg, bar);
            __builtin_amdgcn_fence(__ATOMIC_ACQUIRE, "agent");
            xb_add(&bar[XB_XGEN(b.x)], 1u);
            asm volatile("s_waitcnt vmcnt(0)" ::: "memory");
        } else {
            XB_SPIN(xb_ld(&bar[XB_XGEN(b.x)]) == gen, bar);
            __builtin_amdgcn_fence(__ATOMIC_ACQUIRE, "agent");
            asm volatile("s_waitcnt vmcnt(0)" ::: "memory");
        }
    }
    __syncthreads();
}

struct Args { const float* in[28]; float* out; unsigned char* ws; int ph_lo, ph_hi; };

__device__ __forceinline__ void tr_item(const float* W, int ldw, int Nvalid, const float* kscale, bf16_t* WT, int Kd, int k0, int n0, int drow0, LAS float* scr, int lane) {
    const int n = n0 + 4 * (lane & 15);
    f32x4 v[16];
#pragma unroll
    for (int i = 0; i < 16; ++i) { const int kk = 4 * i + (lane >> 4); v[i] = (f32x4){0.f, 0.f, 0.f, 0.f}; if (n < Nvalid) v[i] = *(const f32x4*)(W + (size_t)(k0 + kk) * ldw + n); }
#pragma unroll
    for (int i = 0; i < 16; ++i) { const int kk = 4 * i + (lane >> 4); f32x4 x = v[i]; if (kscale) x = x * kscale[k0 + kk];
        LAS float* d = scr + kk * 65 + 4 * (lane & 15); d[0] = x[0]; d[1] = x[1]; d[2] = x[2]; d[3] = x[3]; }
    asm volatile("s_waitcnt lgkmcnt(0)" ::: "memory");
    const int c = lane & 7;
#pragma unroll
    for (int j = 0; j < 8; ++j) { const int nn = (lane >> 3) + 8 * j; const LAS float* s = scr + (8 * c) * 65 + nn;
        u32x4 o; o.x = pk2(s[0 * 65], s[1 * 65]); o.y = pk2(s[2 * 65], s[3 * 65]); o.z = pk2(s[4 * 65], s[5 * 65]); o.w = pk2(s[6 * 65], s[7 * 65]);
        *(u32x4*)(WT + (size_t)(drow0 + nn) * Kd + k0 + 8 * c) = o; }
    asm volatile("s_waitcnt lgkmcnt(0)" ::: "memory");
}
__device__ __forceinline__ void split8(const f32x4 x0, const f32x4 x1, bf16x8& hi, bf16x8& lo) {
    u32x4 h; h.x = pk2(x0[0], x0[1]); h.y = pk2(x0[2], x0[3]); h.z = pk2(x1[0], x1[1]); h.w = pk2(x1[2], x1[3]);
    u32x4 l; l.x = pk2(x0[0] - bflo(h.x), x0[1] - bfhi(h.x)); l.y = pk2(x0[2] - bflo(h.y), x0[3] - bfhi(h.y)); l.z = pk2(x1[0] - bflo(h.z), x1[1] - bfhi(h.z)); l.w = pk2(x1[2] - bflo(h.w), x1[3] - bfhi(h.w));
    hi = __builtin_bit_cast(bf16x8, h); lo = __builtin_bit_cast(bf16x8, l);
}
__device__ __forceinline__ void phase_prep(const Args& a, unsigned char* const ws_, float* const out_, LAS unsigned char* lds, int gw, int NGW, int wave, int lane) {
    unsigned char* ws = ws_;
    LAS float* scr = (LAS float*)(lds + wave * 16640);
    constexpr int I_UP = 16 * 44, I_DN = 44 * 16, I_GIN = 16 * 52, I_SQ = 16 * 16, I_MDN = 16 * 12;
    constexpr int I_FFN = 2 * I_UP + I_DN;
    constexpr int NITEMS = 4 * I_FFN + I_GIN + I_SQ + I_MDN + I_SQ;
    for (int it = gw; it < NITEMS; it += NGW) {
        int r = it;
        if (r < 4 * I_FFN) {
            const int fi = r / I_FFN; r -= fi * I_FFN; const int layer = fi >> 1, which = fi & 1;
            const float* nrm = a.in[which ? 23 : 6] + layer * DM;
            if (r < 2 * I_UP) { const int isup = r >= I_UP; if (isup) r -= I_UP;
                const float* W = a.in[(which ? 24 : 7) + isup] + (size_t)layer * DM * DFF;
                const int kb = r / 44, nb = r % 44, n0 = nb * 64;
                tr_item(W, DFF, DFF, nrm, (bf16_t*)(ws + ws_wup(fi)), DM, kb * 64, n0, 256 * (n0 >> 7) + (n0 & 127) + 128 * isup, scr, lane);
            } else { r -= 2 * I_UP;
                const float* W = a.in[which ? 26 : 9] + (size_t)layer * DFF * DM;
                const int kb = r / 16, nb = r % 16;
                tr_item(W, DM, DM, nullptr, (bf16_t*)(ws + ws_wdn(fi)), DFF, kb * 64, nb * 64, nb * 64, scr, lane);
            }
            continue;
        }
        r -= 4 * I_FFN;
        if (r < I_GIN) { const int kb = r / 52, nb = r % 52; tr_item(a.in[11], 3088, 3088, a.in[10], (bf16_t*)(ws + WS_WGIN), DM, kb * 64, nb * 64, nb * 64, scr, lane); continue; }
        r -= I_GIN;
        if (r < I_SQ) { const int kb = r / 16, nb = r % 16; tr_item(a.in[15], DM, DM, nullptr, (bf16_t*)(ws + WS_WGOUT), DM, kb * 64, nb * 64, nb * 64, scr, lane); continue; }
        r -= I_SQ;
        if (r < I_MDN) { const int kb = r / 12, nb = r % 12; tr_item(a.in[16], 704, 704, a.in[10] + DM, (bf16_t*)(ws + WS_WMDN), DM, kb * 64, nb * 64, nb * 64, scr, lane); continue; }
        r -= I_MDN;
        { const int kb = r / 16, nb = r % 16; tr_item(a.in[22], DM, DM, nullptr, (bf16_t*)(ws + WS_WMOUT), DM, kb * 64, nb * 64, nb * 64, scr, lane); }
    }
    const int gt = gw * 64 + lane, NGT = NGW * 64;
    {   const float* wuq = a.in[18]; const float* wuk = a.in[20]; const float* qn = a.in[17]; bf16_t* WQ = (bf16_t*)(ws + WS_WQ);
        {   const int fr = lane & 15, fq = lane >> 4;
            for (int it = gw; it < 8 * 24 * 4; it += NGW) {
                const int h = it / 96, ct = (it % 96) >> 2, rg = it & 3;
                const float* ap = wuq + (size_t)(16 * ct + fr) * 1536 + h * 192 + 8 * fq;
                bf16x8 ah[4], al[4];
#pragma unroll
                for (int s = 0; s < 4; ++s) split8(*(const f32x4*)(ap + 32 * s), *(const f32x4*)(ap + 32 * s + 4), ah[s], al[s]);
                const f32x4 qs = *(const f32x4*)(qn + 16 * ct + 4 * fq);
#pragma unroll
                for (int q = 0; q < 4; ++q) { const int rt = rg * 4 + q;
                    const float* bp = wuk + (size_t)(16 * rt + fr) * 1024 + h * 128 + 8 * fq;
                    f32x4 acc = (f32x4){0.f, 0.f, 0.f, 0.f};
#pragma unroll
                    for (int s = 0; s < 4; ++s) { bf16x8 bh, bl; split8(*(const f32x4*)(bp + 32 * s), *(const f32x4*)(bp + 32 * s + 4), bh, bl);
                        acc = mfma16(al[s], bh, acc); acc = mfma16(ah[s], bl, acc); acc = mfma16(ah[s], bh, acc); }
                    acc = acc * qs;
                    u32x2 w; w.x = pk2(acc[0], acc[1]); w.y = pk2(acc[2], acc[3]);
                    *(u32x2*)(WQ + (size_t)(h * 256 + 16 * rt + fr) * 384 + 16 * ct + 4 * fq) = w; }
            }
        }
        for (int i = gt; i < 512 * 384; i += NGT) {
            const int c = i % 384, rr = i / 384, head = rr >> 6, j = rr & 63;
            WQ[(size_t)(2048 + rr) * 384 + c] = (bf16_t)(pk2(wuq[(size_t)c * 1536 + head * 192 + 128 + j] * qn[c], 0.f) & 0xffffu);
        }
    }
    {   const float* wuv = a.in[21]; bf16_t* WU = (bf16_t*)(ws + WS_WUVT);
        for (int i = gt; i < 8 * 128 * 256; i += NGT) { const int j = i & 7, ln = (i >> 3) & 63, s = (i >> 9) & 7, vt = (i >> 12) & 7, h = i >> 15;
            const int dv = 32 * s + 16 * (j >> 2) + 4 * (ln >> 4) + (j & 3), v = 16 * vt + (ln & 15);
            WU[i] = (bf16_t)(pk2(wuv[(size_t)dv * 1024 + h * 128 + v], 0.f) & 0xffffu); }
    }
    {   f32x2* rt = (f32x2*)(ws + WS_ROPE);
        for (int i = gt; i < 4144 * 32; i += NGT) { const int idx = i >> 5, k = i & 31; const float pos = idx < LP ? (float)idx : (float)(PAST + idx - LP);
            const float inv = fexp2(-(float)k * 0.41524101186092029f); const float ang = pos * inv;
            const float kq = rintf(ang * 0.63661977236758134f);
            float r = ang - kq * 1.5703125f; r -= kq * 4.837512969970703125e-4f; r -= kq * 7.54978995489188216e-8f;
            const float r2 = r * r;
            const float sr = r + r * r2 * (-1.6666654611e-1f + r2 * (8.3321608736e-3f + r2 * -1.9515295891e-4f));
            const float cr = 1.0f - 0.5f * r2 + r2 * r2 * (4.166664568298827e-2f + r2 * (-1.388731625493765e-3f + r2 * 2.443315711809948e-5f));
            const int qd = (int)kq & 3;
            const float cs = qd == 0 ? cr : qd == 1 ? -sr : qd == 2 ? -cr : sr, sn = qd == 0 ? sr : qd == 1 ? cr : qd == 2 ? -sr : -cr;
            rt[i] = (f32x2){cs, sn}; }
    }
    {   float* H = (float*)(ws + WS_H); bf16_t* HB = (bf16_t*)(ws + WS_HB); float* SS0 = (float*)(ws + WS_SS);
        for (int row = gw; row < T; row += NGW) {
            const float* src = nullptr;
            if (row < ROWS_P) { const int b = row / LPP, p = row % LPP; if (p >= 64) src = a.in[0] + ((size_t)b * SEQ + (p - 64)) * DM; else if (p >= 48) src = a.in[5] + (size_t)(p - 48) * DM; }
            else src = a.in[1] + (size_t)(row - ROWS_P) * DM;
            float s = 0.f;
#pragma unroll
            for (int j = 0; j < 4; ++j) { f32x4 v = (f32x4){0.f, 0.f, 0.f, 0.f}; if (src) v = *(const f32x4*)(src + 256 * j + 4 * lane);
                if (!RESID_BF16) *(f32x4*)(H + (size_t)row * DM + 256 * j + 4 * lane) = v;
                u32x2 w; w.x = pk2(v[0], v[1]); w.y = pk2(v[2], v[3]); *(u32x2*)(HB + (size_t)row * DM + 256 * j + 4 * lane) = w;
                s += (v[0] * v[0] + v[1] * v[1]) + (v[2] * v[2] + v[3] * v[3]); }
            s = wave_sum(s); if (lane == 0) SS0[row] = s;
        }
    }
}

__device__ __forceinline__ void phase_gla_a(const Args& a, unsigned char* const ws_, float* const out_, LAS unsigned char* lds, int G, int bx, int tid) {
    bf16_t* P = (bf16_t*)(ws_ + WS_BIG); float* DEC = (float*)(ws_ + WS_DEC);
    const float* wg = a.in[12]; const float* bg = a.in[13];
    LAS float* gd = (LAS float*)lds;
    float w[16];
#pragma unroll
    for (int r = 0; r < 16; ++r) w[r] = wg[r * 512 + tid];
    const float bias = bg[tid];
    for (int cg = bx; cg < 260 + SB; cg += G) {
        int row0, nrows, npad;
        if (cg < 260) { const int b = cg / NCH, c = cg % NCH; row0 = b * LPP + 64 * c; nrows = 64; npad = c == 0 ? 48 : 0; }
        else { row0 = ROWS_P + 32 * (cg - 260); nrows = 32; npad = 0; }
        __syncthreads();
        for (int i = tid; i < nrows * 16; i += 512) gd[i] = bf2f(P[(size_t)(row0 + (i >> 4)) * GIN_LD + 3072 + (i & 15)]);
        __syncthreads();
        unsigned short qv[64], kv[64];
#pragma unroll
        for (int i = 0; i < 64; ++i) { qv[i] = 0; kv[i] = 0; if (i < nrows) { const bf16_t* pr = P + (size_t)(row0 + i) * GIN_LD; qv[i] = pr[tid]; kv[i] = pr[512 + tid]; } }
        float gc = 0.f;
#pragma unroll
        for (int i = 0; i < 64; ++i) {
            if (i < nrows) {
                bf16_t* pr = P + (size_t)(row0 + i) * GIN_LD;
                if (i >= npad) {
                    float g = bias;
#pragma unroll
                    for (int r = 0; r < 16; ++r) g += gd[i * 16 + r] * w[r];
                    const float ls = fminf(g, 0.f) - __logf(1.0f + __expf(-fabsf(g)));
                    gc += ls * (1.0f / 16.0f);
                }
                const float q = bf2f(qv[i]), k = bf2f(kv[i]);
                const float eg = __expf(gc);
                pr[tid] = (bf16_t)(pk2(q * 0.08838834764831845f * eg, 0.f) & 0xffffu);
                pr[512 + tid] = (bf16_t)(pk2(k * frcp(eg), 0.f) & 0xffffu);
            }
        }
        DEC[(size_t)cg * 512 + tid] = __expf(gc);
    }
}
__device__ __forceinline__ bf16x8 col8(const bf16_t* p, int stride) {
    bf16x8 r;
#pragma unroll
    for (int j = 0; j < 8; ++j) r[j] = (short)p[(size_t)j * stride];
    return r;
}
__device__ __forceinline__ bf16x8 tr8(const LAS unsigned char* p) {
    const s16x4 lo = __builtin_bit_cast(s16x4, __builtin_amdgcn_ds_read_tr16_b64_v4i16((LAS s16x4*)p));
    const s16x4 hi = __builtin_bit_cast(s16x4, __builtin_amdgcn_ds_read_tr16_b64_v4i16((LAS s16x4*)(p + 128)));
    return (bf16x8){lo[0], lo[1], lo[2], lo[3], hi[0], hi[1], hi[2], hi[3]};
}
__device__ __forceinline__ void phase_gla_b(const Args& a, unsigned char* const ws_, float* const out_, LAS unsigned char* lds, int G, int vcu, int gw, int NGW, int wid, int lane) {
    const bf16_t* P = (const bf16_t*)(ws_ + WS_BIG); const float* DEC = (const float*)(ws_ + WS_DEC);
    bf16_t* SBP = (bf16_t*)((unsigned char*)out_ + OS_SBUFP); bf16_t* SBS = (bf16_t*)(ws_ + WS_SBUFS);
    const int fr = lane & 15, fq = lane >> 4, tid = wid * 64 + lane;
    LAS unsigned char* wl = lds + wid * 8192;
    const int troff = (8 * fq + (fr >> 2)) * 32 + (fr & 3) * 8;
    for (int item = vcu; item < 256; item += G) {
        const int seq = item >> 4, rect = item & 15, dkt = 2 * (rect >> 2) + (wid >> 2), dvs = 4 * (rect & 3) + (wid & 3), b = seq >> 2, h = seq & 3;
        const int krow = tid >> 2, kch = tid & 3, vrow_ = tid >> 3, vch = tid & 7;
        const bf16_t* kp = P + (size_t)(b * LPP + krow) * GIN_LD + 512 + h * 128 + 32 * (rect >> 2) + 8 * kch;
        const bf16_t* vp = P + (size_t)(b * LPP + vrow_) * GIN_LD + 1024 + h * 256 + 64 * (rect & 3) + 8 * vch;
        const int kdst = (kch >> 1) * 2048 + krow * 32 + (kch & 1) * 16, vdst = 8192 + (vch >> 1) * 2048 + vrow_ * 32 + (vch & 1) * 16;
        const int ksrc = (wid >> 2) * 2048 + troff, vsrc = 8192 + (wid & 3) * 2048 + troff;
        const float* dp = DEC + (size_t)(b * NCH) * 512 + h * 128 + 16 * dkt + 4 * fq;
        f32x4 S = (f32x4){0.f, 0.f, 0.f, 0.f};
        u32x4 rk[4], rv[4]; f32x4 rd[4];
#define GB_LOAD(c, I) do { const size_t o_ = (size_t)(64 * (c)) * GIN_LD; if (tid < 256) rk[I] = *(const u32x4*)(kp + o_); rv[I] = *(const u32x4*)(vp + o_); rd[I] = *(const f32x4*)(dp + (size_t)(c) * 512); } while (0)
#define GB_STEP(c, I) do { LAS unsigned char* bb_ = lds + (((c) & 1) ? 16384 : 0); const f32x4 dcur_ = rd[I]; \
            if (tid < 256) *(LAS u32x4*)(bb_ + kdst) = rk[I]; *(LAS u32x4*)(bb_ + vdst) = rv[I]; \
            if ((c) + 4 < NCH) GB_LOAD((c) + 4, I); \
            if ((c) >= 1) { u32x2 w_; w_.x = pk2(S[0], S[1]); w_.y = pk2(S[2], S[3]); \
                *(u32x2*)(SBP + ((size_t)(seq * 64 + ((c) - 1)) * 256 + 16 * dvs + fr) * 128 + 16 * dkt + 4 * fq) = w_; } \
            __syncthreads(); \
            const bf16x8 ka0_ = tr8(bb_ + ksrc), ka1_ = tr8(bb_ + ksrc + 1024), va0_ = tr8(bb_ + vsrc), va1_ = tr8(bb_ + vsrc + 1024); \
            S = mfma16(ka0_, va0_, S); S = mfma16(ka1_, va1_, S); \
            S = S * dcur_; } while (0)
        __syncthreads();
        GB_LOAD(0, 0); GB_LOAD(1, 1); GB_LOAD(2, 2); GB_LOAD(3, 3);
        for (int c = 0; c + 3 < NCH; c += 4) { GB_STEP(c, 0); GB_STEP(c + 1, 1); GB_STEP(c + 2, 2); GB_STEP(c + 3, 3); }
        GB_STEP(NCH - 1, 0);
#undef GB_LOAD
#undef GB_STEP
        float* og = out_ + OUT_GP + ((size_t)seq * 128 + 16 * dkt + 4 * fq) * 256 + 16 * dvs + fr;
#pragma unroll
        for (int r = 0; r < 4; ++r) og[(size_t)r * 256] = S[r];
    }
    __syncthreads();
    for (int rep_ = 0; rep_ < (GB_P2 ? 2 : 1); ++rep_)
    for (int it = gw; it < 128 * 16; it += NGW) {
        const int seq = it >> 4, dkt = (it >> 1) & 7, dvh = it & 1, bs = seq >> 2, h = seq & 3;
        const int lrow = lane & 31;
        const bf16_t* kp = P + (size_t)(ROWS_P + 32 * bs + lrow) * GIN_LD + 512 + h * 128 + 16 * dkt;
        const bf16_t* vp = P + (size_t)(ROWS_P + 32 * bs + lrow) * GIN_LD + 1024 + h * 256 + 128 * dvh;
        { const u32x4 k0 = *(const u32x4*)kp, k1 = *(const u32x4*)(kp + 8);
          if (lane < 32) { *(LAS u32x4*)(wl + lane * 32) = k0; *(LAS u32x4*)(wl + lane * 32 + 16) = k1; } }
        const bf16x8 ka = tr8(wl + troff);
        const f32x4 d = *(const f32x4*)(DEC + (size_t)(260 + bs) * 512 + h * 128 + 16 * dkt + 4 * fq);
#pragma unroll 2
        for (int q = 0; q < 8; ++q) {
            const int dvs = 8 * dvh + q;
            { const u32x4 v0 = *(const u32x4*)(vp + 16 * q), v1 = *(const u32x4*)(vp + 16 * q + 8);
              if (lane < 32) { *(LAS u32x4*)(wl + 4096 + (q & 1) * 2048 + lane * 32) = v0; *(LAS u32x4*)(wl + 4096 + (q & 1) * 2048 + lane * 32 + 16) = v1; } }
            const size_t so = ((size_t)seq * 128 + 16 * dkt + 4 * fq) * 256 + 16 * dvs + fr;
            f32x4 S;
#pragma unroll
            for (int r = 0; r < 4; ++r) S[r] = a.in[2][so + (size_t)r * 256];
            { u32x2 w; w.x = pk2(S[0], S[1]); w.y = pk2(S[2], S[3]); *(u32x2*)(SBS + ((size_t)seq * 256 + 16 * dvs + fr) * 128 + 16 * dkt + 4 * fq) = w; }
            S = mfma16(ka, tr8(wl + 4096 + (q & 1) * 2048 + troff), S);
            S = S * d;
            float* og = out_ + OUT_GS + so;
#pragma unroll
            for (int r = 0; r < 4; ++r) og[(size_t)r * 256] = S[r];
        }
    }
}
template <int NI>
__device__ __forceinline__ void gla_c_item(LAS unsigned char* abuf, LAS float* red, bf16_t* P, const bf16_t* ST, const float* hn, int row0, int h, int wid, int lane) {
    { int zz = 0; asm volatile("" : "+v"(zz)); lane = (int)__builtin_amdgcn_mbcnt_hi(~0u, __builtin_amdgcn_mbcnt_lo(~0u, 0u)) + zz; }
    const int fr = lane & 15, fq = lane >> 4;
    constexpr int ASTR = 144;
    constexpr int NTILE = NI * NI, PERW = NTILE >= 8 ? NTILE / 8 : 1;
#pragma unroll
    for (int q = 0; q < PERW; ++q) {
        const int idx = wid * PERW + q;
        if (idx < NTILE) {
            const int it = idx / NI, jt = idx % NI;
            const bf16_t* kq = P + (size_t)(row0 + 16 * jt + fr) * GIN_LD + 512 + h * 128 + 8 * fq;
            const bf16_t* qq = P + (size_t)(row0 + 16 * it + fr) * GIN_LD + h * 128 + 8 * fq;
            f32x4 d = (f32x4){0.f, 0.f, 0.f, 0.f};
#pragma unroll
            for (int s = 0; s < 4; ++s) d = mfma16(*(const bf16x8*)(kq + 32 * s), *(const bf16x8*)(qq + 32 * s), d);
            const int i = 16 * it + fr, j0 = 16 * jt + 4 * fq;
#pragma unroll
            for (int r = 0; r < 4; ++r) if (j0 + r > i) d[r] = 0.f;
            u32x2 w; w.x = pk2(d[0], d[1]); w.y = pk2(d[2], d[3]);
            *(LAS u32x2*)(abuf + i * ASTR + j0 * 2) = w;
        }
    }
    __syncthreads();
    f32x4 o[2][NI];
#pragma unroll
    for (int dt = 0; dt < 2; ++dt)
#pragma unroll
        for (int it = 0; it < NI; ++it) o[dt][it] = (f32x4){0.f, 0.f, 0.f, 0.f};
    const int dv0 = 32 * wid;
    if (ST) {
#pragma unroll
        for (int s = 0; s < 4; ++s) {
            const bf16x8 s0 = *(const bf16x8*)(ST + (size_t)(dv0 + fr) * 128 + 32 * s + 8 * fq), s1 = *(const bf16x8*)(ST + (size_t)(dv0 + 16 + fr) * 128 + 32 * s + 8 * fq);
#pragma unroll
            for (int it = 0; it < NI; ++it) { const bf16x8 qf = *(const bf16x8*)(P + (size_t)(row0 + 16 * it + fr) * GIN_LD + h * 128 + 32 * s + 8 * fq);
                o[0][it] = mfma16(s0, qf, o[0][it]); o[1][it] = mfma16(s1, qf, o[1][it]); }
        }
    }
#pragma unroll
    for (int s = 0; s < NI / 2; ++s) {
        const bf16_t* vp = P + (size_t)(row0 + 32 * s + 8 * fq) * GIN_LD + 1024 + h * 256 + dv0 + fr;
        const bf16x8 v0 = col8(vp, GIN_LD), v1 = col8(vp + 16, GIN_LD);
#pragma unroll
        for (int it = 2 * s; it < NI; ++it) { const bf16x8 af = *(const LAS bf16x8*)(abuf + (16 * it + fr) * ASTR + (32 * s + 8 * fq) * 2);
            o[0][it] = mfma16(v0, af, o[0][it]); o[1][it] = mfma16(v1, af, o[1][it]); }
    }
#pragma unroll
    for (int it = 0; it < NI; ++it) { float s = 0.f;
#pragma unroll
        for (int dt = 0; dt < 2; ++dt) s += (o[dt][it][0] * o[dt][it][0] + o[dt][it][1] * o[dt][it][1]) + (o[dt][it][2] * o[dt][it][2] + o[dt][it][3] * o[dt][it][3]);
        s += __shfl_xor(s, 16); s += __shfl_xor(s, 32);
        if (fq == 0) red[wid * 64 + 16 * it + fr] = s; }
    __syncthreads();
#pragma unroll
    for (int it = 0; it < NI; ++it) { float tot = 0.f;
#pragma unroll
        for (int w = 0; w < 8; ++w) tot += red[w * 64 + 16 * it + fr];
        const float rs = __builtin_amdgcn_rsqf(tot * (1.0f / 256.0f) + EPS);
#pragma unroll
        for (int dt = 0; dt < 2; ++dt) { const int dv = dv0 + 16 * dt + 4 * fq;
            bf16_t* rp = P + (size_t)(row0 + 16 * it + fr) * GIN_LD + 2048 + h * 256 + dv;
            const u32x2 rr = *(const u32x2*)rp; const f32x4 hw = *(const f32x4*)(hn + dv);
            const float r0 = bflo(rr.x), r1 = bfhi(rr.x), r2 = bflo(rr.y), r3 = bfhi(rr.y);
            u32x2 w; w.x = pk2(o[dt][it][0] * rs * hw[0] * silu_f(r0), o[dt][it][1] * rs * hw[1] * silu_f(r1)); w.y = pk2(o[dt][it][2] * rs * hw[2] * silu_f(r2), o[dt][it][3] * rs * hw[3] * silu_f(r3));
            *(u32x2*)rp = w; }
    }
}
__device__ __forceinline__ void phase_gla_c(const Args& a, unsigned char* const ws_, float* const out_, LAS unsigned char* lds, int G, int bx, int wid, int lane) {
    bf16_t* P = (bf16_t*)(ws_ + WS_BIG);
    const bf16_t* SBP = (const bf16_t*)((unsigned char*)out_ + OS_SBUFP); const bf16_t* SBS = (const bf16_t*)(ws_ + WS_SBUFS);
    int par = 0;
    for (int it = bx; it < 1040 + 128; it += G, par ^= 1) {
        LAS unsigned char* abuf = lds + par * 16384; LAS float* red = (LAS float*)(lds + 32768 + par * 4096);
        if (it < 1040) { const int h = it & 3, c = (it >> 2) % NCH, b = it / 260, seq = b * 4 + h;
            gla_c_item<4>(abuf, red, P, c >= 1 ? SBP + (size_t)(seq * 64 + (c - 1)) * 32768 : nullptr, a.in[14], b * LPP + 64 * c, h, wid, lane);
        } else { const int j = it - 1040, h = j & 3, bs = j >> 2;
            gla_c_item<2>(abuf, red, P, SBS + (size_t)(bs * 4 + h) * 32768, a.in[14], ROWS_P + 32 * bs, h, wid, lane); }
    }
}

__device__ __forceinline__ void phase_mla_prep(const Args& a, unsigned char* const ws_, float* const out_, int gw, int NGW, int lane) {
    const float* DN = (const float*)((unsigned char*)out_ + OS_DN); bf16_t* KP = (bf16_t*)((unsigned char*)out_ + OS_KP);
    bf16_t* KS = (bf16_t*)(ws_ + WS_KS); bf16_t* CQB = (bf16_t*)(ws_ + WS_CQB); float* SSQ = (float*)(ws_ + WS_SS) + 7 * T;
    const f32x2* rt = (const f32x2*)(ws_ + WS_ROPE); const float* kvn = a.in[19];
    for (int row = gw; row < T; row += NGW) {
        const float* d = DN + (size_t)row * MDN_N;
        const f32x2 c0 = *(const f32x2*)(d + 6 * lane), c1 = *(const f32x2*)(d + 6 * lane + 2), c2 = *(const f32x2*)(d + 6 * lane + 4);
        const f32x4 kv = *(const f32x4*)(d + 384 + 4 * lane); const float kr = d[640 + lane];
        float sq = (c0.x * c0.x + c0.y * c0.y) + (c1.x * c1.x + c1.y * c1.y) + (c2.x * c2.x + c2.y * c2.y);
        float sk = (kv[0] * kv[0] + kv[1] * kv[1]) + (kv[2] * kv[2] + kv[3] * kv[3]);
        sq = wave_sum(sq); sk = wave_sum(sk);
        if (lane == 0) SSQ[row] = sq;
        unsigned* cq = (unsigned*)(CQB + (size_t)row * 384 + 6 * lane); cq[0] = pk2(c0.x, c0.y); cq[1] = pk2(c1.x, c1.y); cq[2] = pk2(c2.x, c2.y);
        const float rs = __builtin_amdgcn_rsqf(sk * (1.0f / 256.0f) + EPS); const f32x4 w = *(const f32x4*)(kvn + 4 * lane);
        const f32x4 lat = kv * rs * w;
        int pidx, valid; float* ol; float* orp; bf16_t* krow;
        if (row < ROWS_P) { const int b = row / LPP, p = row % LPP, t = p - 48; valid = p >= 48; pidx = valid ? t : 0;
            ol = out_ + OUT_LP + ((size_t)b * LP + pidx) * 256; orp = out_ + OUT_RP + ((size_t)b * LP + pidx) * 64; krow = KP + (size_t)row * KLD; }
        else { const int j = row - ROWS_P; valid = 1; pidx = LP + (j & 31); ol = out_ + OUT_LS + (size_t)j * 256; orp = out_ + OUT_RS + (size_t)j * 64; krow = KS + ((size_t)(j >> 5) * (PAST + SL) + PAST + (j & 31)) * KLD; }
        const float other = __shfl_xor(kr, 32); const f32x2 cs = rt[(size_t)pidx * 32 + (lane & 31)];
        const float ro = lane < 32 ? kr * cs.x - other * cs.y : kr * cs.x + other * cs.y;
        if (valid) { *(f32x4*)(ol + 4 * lane) = lat; orp[lane] = ro; }
        u32x2 lw; lw.x = pk2(lat[0], lat[1]); lw.y = pk2(lat[2], lat[3]); *(u32x2*)(krow + 4 * lane) = lw;
        krow[256 + lane] = (bf16_t)(pk2(ro, 0.f) & 0xffffu);
    }
    const float* clat = a.in[3]; const float* crope = a.in[4];
    for (int r = gw; r < SB * PAST + 32; r += NGW) {
        if (r < SB * PAST) { const int bs = r >> 11, k = r & (PAST - 1); bf16_t* kd = KS + ((size_t)bs * (PAST + SL) + k) * KLD;
            const f32x4 v = *(const f32x4*)(clat + (size_t)r * 256 + 4 * lane); const float rp = crope[(size_t)r * 64 + lane];
            u32x2 w; w.x = pk2(v[0], v[1]); w.y = pk2(v[2], v[3]); *(u32x2*)(kd + 4 * lane) = w; kd[256 + lane] = (bf16_t)(pk2(rp, 0.f) & 0xffffu);
        } else { bf16_t* kd = KS + ((size_t)SB * (PAST + SL) + (r - SB * PAST)) * KLD; *(u32x2*)(kd + 4 * lane) = (u32x2){0u, 0u}; kd[256 + lane] = 0; }
    }
}

constexpr int KROW = 640, KSTAGE = 64 * KROW;
__device__ __forceinline__ void glds16_asm(const void* gsrc, unsigned lds_dst) { unsigned keep;
    asm volatile("s_mov_b32 %0, m0\n\ts_mov_b32 m0, %2\n\ts_nop 0\n\tglobal_load_lds_dwordx4 %1, off\n\ts_mov_b32 m0, %0" : "=&s"(keep) : "v"(gsrc), "s"(lds_dst) : "memory"); }
__device__ __forceinline__ float xred_max(float v) {
    auto a = __builtin_amdgcn_permlane16_swap(__float_as_uint(v), __float_as_uint(v), false, false); v = fmaxf(__uint_as_float(a[0]), __uint_as_float(a[1]));
    auto b = __builtin_amdgcn_permlane32_swap(__float_as_uint(v), __float_as_uint(v), false, false); return fmaxf(__uint_as_float(b[0]), __uint_as_float(b[1]));
}
__device__ __forceinline__ float xred_sum(float v) {
    auto a = __builtin_amdgcn_permlane16_swap(__float_as_uint(v), __float_as_uint(v), false, false); v = __uint_as_float(a[0]) + __uint_as_float(a[1]);
    auto b = __builtin_amdgcn_permlane32_swap(__float_as_uint(v), __float_as_uint(v), false, false); return __uint_as_float(b[0]) + __uint_as_float(b[1]);
}
__device__ __forceinline__ void attn_unit(LAS unsigned char* lds, const bf16_t* Qb, const bf16_t* Kb, const bf16_t* WuvT, const f32x2* rope, bf16_t* Ob, int qrow0, int NT, int klo0, int khiL, int wid) {
    int lane; { int zz = 0; asm volatile("" : "+v"(zz)); lane = (int)__builtin_amdgcn_mbcnt_hi(~0u, __builtin_amdgcn_mbcnt_lo(~0u, 0u)) + zz; }
    const int fr = lane & 15, fq = lane >> 4, h = wid;
    bf16x8 qf[10];
    { const bf16_t* qp = Qb + (size_t)(qrow0 + fr) * QLD + h * 320 + 8 * fq;
#pragma unroll
      for (int s = 0; s < 10; ++s) qf[s] = *(const bf16x8*)(qp + 32 * s);
      const int row = qrow0 + fr; int pidx;
      if (row < ROWS_P) { const int p = row % LPP; pidx = p >= 48 ? p - 48 : 0; } else pidx = LP + ((row - ROWS_P) & 31);
      const f32x2* cs = rope + (size_t)pidx * 32 + 8 * fq;
      float o1[8], o2[8];
#pragma unroll
      for (int j = 0; j < 8; ++j) { const f32x2 c = cs[j]; const float x1 = bf2f((unsigned short)qf[8][j]), x2 = bf2f((unsigned short)qf[9][j]); o1[j] = x1 * c.x - x2 * c.y; o2[j] = x2 * c.x + x1 * c.y; }
      u32x4 w1, w2; w1.x = pk2(o1[0], o1[1]); w1.y = pk2(o1[2], o1[3]); w1.z = pk2(o1[4], o1[5]); w1.w = pk2(o1[6], o1[7]);
      w2.x = pk2(o2[0], o2[1]); w2.y = pk2(o2[2], o2[3]); w2.z = pk2(o2[4], o2[5]); w2.w = pk2(o2[6], o2[7]);
      qf[8] = __builtin_bit_cast(bf16x8, w1); qf[9] = __builtin_bit_cast(bf16x8, w2); }
    f32x4 o[16];
#pragma unroll
    for (int d = 0; d < 16; ++d) o[d] = (f32x4){0.f, 0.f, 0.f, 0.f};
    float mrun = -INFINITY, lsum = 0.f;
    int crow[5], cdat[5];
#pragma unroll
    for (int i = 0; i < 5; ++i) { const int pos = (8 * i + wid) * 64 + lane; crow[i] = pos / 40; cdat[i] = (pos % 40) ^ (crow[i] & 6); }
#define ATT_DMA(t, stg) do { const unsigned sb_ = (unsigned)__builtin_amdgcn_readfirstlane((int)(unsigned)(unsigned long)((stg) + wid * 1024)); _Pragma("unroll") for (int i = 0; i < 5; ++i) \
        glds16_asm(Kb + ((size_t)(64 * (t) + crow[i]) * KLD + cdat[i] * 8), sb_ + i * 8192); } while (0)
    const int f6 = fr & 6;
    const int kbe = fr * KROW + ((fq ^ (f6 & 2)) * 16) + ((f6 & 4) ? 64 : 0), kbo = fr * KROW + ((fq ^ (f6 & 2)) * 16) - ((f6 & 4) ? 64 : 0);
    const int vrow = 4 * fq + (fr >> 2), g2 = (vrow & 6) >> 1;
    int vbs[4];
#pragma unroll
    for (int e = 0; e < 4; ++e) vbs[e] = vrow * KROW + 32 * (e ^ g2) + 16 * ((fr >> 1) & 1) + 8 * (fr & 1);
    bf16x8 pf[2] = {(bf16x8){0, 0, 0, 0, 0, 0, 0, 0}, (bf16x8){0, 0, 0, 0, 0, 0, 0, 0}};
    auto qk_sm = [&](LAS unsigned char* stg, int klo, int khi, bool masked) {
        f32x4 st[4];
#pragma unroll
        for (int Tt = 0; Tt < 4; ++Tt) st[Tt] = (f32x4){0.f, 0.f, 0.f, 0.f};
        const LAS unsigned char* kE = stg + kbe; const LAS unsigned char* kO = stg + kbo;
        constexpr int KD = 3;
        bf16x8 kf[KD][4];
#define ATT_KLOAD(s) do { _Pragma("unroll") for (int Tt = 0; Tt < 4; ++Tt) kf[(s) % KD][Tt] = *(const LAS bf16x8*)((((s) & 1) ? kO : kE) + Tt * (16 * KROW) + (s) * 64); } while (0)
#pragma unroll
        for (int s = 0; s < KD - 1; ++s) ATT_KLOAD(s);
#pragma unroll
        for (int s = 0; s < 10; ++s) {
            if (s + KD - 1 < 10) ATT_KLOAD(s + KD - 1);
#pragma unroll
            for (int Tt = 0; Tt < 4; ++Tt) st[Tt] = mfma16(kf[s % KD][Tt], qf[s], st[Tt]);
            __builtin_amdgcn_sched_barrier(0);
        }
#undef ATT_KLOAD
        if (masked) {
#pragma unroll
            for (int Tt = 0; Tt < 4; ++Tt)
#pragma unroll
                for (int r = 0; r < 4; ++r) { const int kk = 16 * Tt + 4 * fq + r; if (kk < klo || kk >= khi) st[Tt][r] = -INFINITY; }
        }
        if (ATT_P1) {
            f32x4 s2[4];
#pragma unroll
            for (int Tt = 0; Tt < 4; ++Tt) { s2[Tt] = st[Tt]; asm volatile("" : "+v"(s2[Tt])); }
            float m2 = fmaxf(fmaxf(s2[0][0], s2[0][1]), fmaxf(s2[0][2], s2[0][3]));
#pragma unroll
            for (int Tt = 1; Tt < 4; ++Tt) m2 = fmaxf(m2, fmaxf(fmaxf(s2[Tt][0], s2[Tt][1]), fmaxf(s2[Tt][2], s2[Tt][3])));
            m2 = xred_max(m2); float p2 = 0.f;
#pragma unroll
            for (int Tt = 0; Tt < 4; ++Tt)
#pragma unroll
                for (int r = 0; r < 4; ++r) { s2[Tt][r] = fexp2(s2[Tt][r] - m2); p2 += s2[Tt][r]; }
            unsigned q2 = 0;
#pragma unroll
            for (int s = 0; s < 2; ++s) { q2 ^= pk2(s2[2 * s][0], s2[2 * s][1]) ^ pk2(s2[2 * s][2], s2[2 * s][3]) ^ pk2(s2[2 * s + 1][0], s2[2 * s + 1][1]) ^ pk2(s2[2 * s + 1][2], s2[2 * s + 1][3]); }
            asm volatile("" :: "v"(p2), "v"(q2));
        }
        float mx = fmaxf(fmaxf(st[0][0], st[0][1]), fmaxf(st[0][2], st[0][3]));
#pragma unroll
        for (int Tt = 1; Tt < 4; ++Tt) mx = fmaxf(mx, fmaxf(fmaxf(st[Tt][0], st[Tt][1]), fmaxf(st[Tt][2], st[Tt][3])));
        mx = xred_max(mx);
        if (__any(mx > mrun + 8.0f)) {
            const float mnew = fmaxf(mrun, mx), alpha = fexp2(mrun - mnew); mrun = mnew;
            lsum *= alpha;
#pragma unroll
            for (int d = 0; d < 16; ++d) o[d] = o[d] * alpha;
        }
        float ps = 0.f;
#pragma unroll
        for (int Tt = 0; Tt < 4; ++Tt)
#pragma unroll
            for (int r = 0; r < 4; ++r) { st[Tt][r] = fexp2(st[Tt][r] - mrun); ps += st[Tt][r]; }
        lsum += ps;
#pragma unroll
        for (int s = 0; s < 2; ++s) { u32x4 w; w.x = pk2(st[2 * s][0], st[2 * s][1]); w.y = pk2(st[2 * s][2], st[2 * s][3]); w.z = pk2(st[2 * s + 1][0], st[2 * s + 1][1]); w.w = pk2(st[2 * s + 1][2], st[2 * s + 1][3]); pf[s] = __builtin_bit_cast(bf16x8, w); }
    };
    auto pv = [&](LAS unsigned char* stg) {
        constexpr int VD = 4;
        s16x4 vl[VD], vh[VD];
#define ATT_VLOAD(p) do { const int d_ = (p) >> 1, s_ = (p) & 1; \
            vl[(p) % VD] = __builtin_bit_cast(s16x4, __builtin_amdgcn_ds_read_tr16_b64_v4i16((LAS s16x4*)(stg + vbs[d_ & 3] + (32 * s_) * KROW + (d_ >> 2) * 128))); \
            vh[(p) % VD] = __builtin_bit_cast(s16x4, __builtin_amdgcn_ds_read_tr16_b64_v4i16((LAS s16x4*)(stg + vbs[d_ & 3] + (32 * s_ + 16) * KROW + (d_ >> 2) * 128))); } while (0)
#pragma unroll
        for (int p = 0; p < VD; ++p) ATT_VLOAD(p);
#pragma unroll
        for (int p = 0; p < 32; ++p) {
            const s16x4 lo = vl[p % VD], hi = vh[p % VD];
            const bf16x8 vf = (bf16x8){lo[0], lo[1], lo[2], lo[3], hi[0], hi[1], hi[2], hi[3]};
            o[p >> 1] = mfma16(vf, pf[p & 1], o[p >> 1]);
            if (p + VD < 32) ATT_VLOAD(p + VD);
            __builtin_amdgcn_sched_barrier(0);
        }
#undef ATT_VLOAD
    };
    ATT_DMA(0, lds);
    if (NT > 1) { ATT_DMA(1, lds + KSTAGE); asm volatile("s_waitcnt vmcnt(5)" ::: "memory"); } else asm volatile("s_waitcnt vmcnt(0)" ::: "memory");
    __syncthreads();
    int sc = 0;
    for (int t = 0; t < NT; ++t) {
        const int sn = sc == 2 ? 0 : sc + 1, sp = sc == 0 ? 2 : sc - 1;
        const bool more = t + 2 < NT;
        if (more) ATT_DMA(t + 2, lds + sp * KSTAGE);
        const bool msk = (t == 0 && klo0 > 0) || (t == NT - 1 && khiL < 64);
        const int klo = t == 0 ? klo0 : 0, khi = t == NT - 1 ? khiL : 64;
        qk_sm(lds + sc * KSTAGE, klo, khi, msk);
        pv(lds + sc * KSTAGE);
        if (more) asm volatile("s_waitcnt vmcnt(5)" ::: "memory"); else asm volatile("s_waitcnt vmcnt(0)" ::: "memory");
        __syncthreads();
        sc = sn;
    }
#undef ATT_DMA
    lsum = xred_sum(lsum);
    const float inv = frcp(lsum);
    bf16x8 bfr[8];
#pragma unroll
    for (int s = 0; s < 8; ++s) { u32x4 w; w.x = pk2(o[2 * s][0] * inv, o[2 * s][1] * inv); w.y = pk2(o[2 * s][2] * inv, o[2 * s][3] * inv); w.z = pk2(o[2 * s + 1][0] * inv, o[2 * s + 1][1] * inv); w.w = pk2(o[2 * s + 1][2] * inv, o[2 * s + 1][3] * inv); bfr[s] = __builtin_bit_cast(bf16x8, w); }
    const bf16_t* wu = WuvT + (size_t)h * 32768 + lane * 8;
    bf16_t* op = Ob + (size_t)(qrow0 + fr) * DM + h * 128 + 4 * fq;
    bf16x8 wa[2][16];
#define EP_LOAD(g) do { _Pragma("unroll") for (int i = 0; i < 16; ++i) wa[(g) & 1][i] = *(const bf16x8*)(wu + ((g) * 16 + i) * 512); } while (0)
#define EP_COMP(g) do { _Pragma("unroll") for (int vv = 0; vv < 2; ++vv) { f32x4 acc = (f32x4){0.f, 0.f, 0.f, 0.f}; \
        _Pragma("unroll") for (int s = 0; s < 8; ++s) acc = mfma16(wa[(g) & 1][vv * 8 + s], bfr[s], acc); \
        u32x2 w; w.x = pk2(acc[0], acc[1]); w.y = pk2(acc[2], acc[3]); *(u32x2*)(op + 16 * (2 * (g) + vv)) = w; } } while (0)
    EP_LOAD(0); EP_LOAD(1); __builtin_amdgcn_sched_barrier(0);
    EP_COMP(0); __builtin_amdgcn_sched_barrier(0); EP_LOAD(2); __builtin_amdgcn_sched_barrier(0);
    EP_COMP(1); __builtin_amdgcn_sched_barrier(0); EP_LOAD(3); __builtin_amdgcn_sched_barrier(0);
    EP_COMP(2); __builtin_amdgcn_sched_barrier(0); EP_COMP(3);
#undef EP_LOAD
#undef EP_COMP
}
__device__ __forceinline__ void phase_attn(const Args& a, unsigned char* const ws_, float* const out_, LAS unsigned char* lds, int G, int bx, int tid, int wid, int lane) {
    const bf16_t* Qb = (const bf16_t*)(ws_ + WS_BIG); const bf16_t* KP = (const bf16_t*)((unsigned char*)out_ + OS_KP); const bf16_t* KS = (const bf16_t*)(ws_ + WS_KS);
    const bf16_t* WU = (const bf16_t*)(ws_ + WS_WUVT); bf16_t* Ob = (bf16_t*)((unsigned char*)out_ + OS_DN);
    for (int rd = 0;; ++rd) {
        const int j = (rd & 1) ? (rd + 1) * G - 1 - bx : rd * G + bx;
        if (rd * G >= 1092) break;
        if (j >= 1092) continue;
        const bf16_t* Kb; int qrow0, NT, klo0, khiL;
        if (j >= 512 && j < 576) { const int s = j - 512, bs = s >> 1, half = s & 1; Kb = KS + (size_t)bs * (PAST + SL) * KLD; qrow0 = ROWS_P + 32 * bs + 16 * half; NT = 33; klo0 = 0; khiL = 32; }
        else {
            int b, m, qt;
            if (j < 512) { m = 64 - (j >> 4); b = (j & 15) >> 2; qt = j & 3; }
            else if (j < 1088) { const int jj = j - 576; m = 32 - (jj >> 4); b = (jj & 15) >> 2; qt = jj & 3; }
            else { m = 0; b = j - 1088; qt = 3; }
            Kb = KP + (size_t)b * LPP * KLD; qrow0 = b * LPP + 64 * m + 16 * qt; NT = m + 1; klo0 = 48; khiL = 64;
        }
        attn_unit(lds, Qb, Kb, WU, (const f32x2*)(ws_ + WS_ROPE), Ob, qrow0, NT, klo0, khiL, wid);
    }
}

__device__ __forceinline__ void phase_final(const Args& a, unsigned char* const ws_, float* const out_, int gw, int NGW, int lane) {
    const float* H = (const float*)(ws_ + WS_H); const float* SS = (const float*)(ws_ + WS_SS) + 6 * T; const float* fn = a.in[27];
    for (int row = gw; row < T; row += NGW) {
        float* dst;
        if (row < ROWS_P) { const int b = row / LPP, p = row % LPP; if (p < 64) continue; dst = out_ + OUT_YP + ((size_t)b * SEQ + (p - 64)) * DM; }
        else dst = out_ + OUT_YS + (size_t)(row - ROWS_P) * DM;
        const float rs = __builtin_amdgcn_rsqf(SS[row] * (1.0f / DM) + EPS);
#pragma unroll
        for (int j = 0; j < 4; ++j) { f32x4 v; const f32x4 w = *(const f32x4*)(fn + 256 * j + 4 * lane);
            if (RESID_BF16) { const u32x2 hv = *(const u32x2*)((const bf16_t*)(ws_ + WS_HB) + (size_t)row * DM + 256 * j + 4 * lane); v = (f32x4){bflo(hv.x), bfhi(hv.x), bflo(hv.y), bfhi(hv.y)}; }
            else v = *(const f32x4*)(H + (size_t)row * DM + 256 * j + 4 * lane);
            *(f32x4*)(dst + 256 * j + 4 * lane) = v * rs * w; }
    }
}

__device__ __forceinline__ void resid_fix(const pg8::SplitOrder& S, float* H, bf16_t* HB, float* ssn, float scale, const unsigned char* part, int gw, int NGW, int lane) {
    if (S.S <= 1) return;
    const int nitem = S.rem * 128, fr = lane & 15, fq = lane >> 4;
    for (int it = gw; it < nitem; it += NGW) {
        const int j = it >> 7, q = it & 127, w = q >> 4, ai = (q >> 3) & 1, m = (q >> 1) & 3, bj = q & 1; int pm, pn; S.tile(S.full * S.G + j, pm, pn);
        const unsigned char* p = part + (size_t)(j * S.S) * 131072 + (size_t)q * 1024 + lane * 16;
        f32x4 a0 = {0.f, 0.f, 0.f, 0.f}, a1 = {0.f, 0.f, 0.f, 0.f};
#define RF_ACC(v) do { a0[0] += bflo(v.x); a0[1] += bfhi(v.x); a0[2] += bflo(v.y); a0[3] += bfhi(v.y); a1[0] += bflo(v.z); a1[1] += bfhi(v.z); a1[2] += bflo(v.w); a1[3] += bfhi(v.w); } while (0)
        int s = 0;
        for (; s + 4 <= S.S; s += 4) { const u32x4 x0 = *(const u32x4*)(p + (size_t)s * 131072), x1 = *(const u32x4*)(p + (size_t)(s + 1) * 131072), x2 = *(const u32x4*)(p + (size_t)(s + 2) * 131072), x3 = *(const u32x4*)(p + (size_t)(s + 3) * 131072);
            RF_ACC(x0); RF_ACC(x1); RF_ACC(x2); RF_ACC(x3); }
        for (; s < S.S; ++s) { const u32x4 x0 = *(const u32x4*)(p + (size_t)s * 131072); RF_ACC(x0); }
#undef RF_ACC
        const int row = pm * 256 + ai * 128 + (w >> 2) * 64 + m * 16 + fr;
        const size_t off = (size_t)row * DM + pn * 256 + bj * 128 + (w & 3) * 32 + 4 * fq;
        f32x4 v0, v1;
        if (RESID_BF16) { const u32x2 h0 = *(const u32x2*)(HB + off), h1 = *(const u32x2*)(HB + off + 16);
            v0 = (f32x4){bflo(h0.x), bfhi(h0.x), bflo(h0.y), bfhi(h0.y)} + a0 * scale; v1 = (f32x4){bflo(h1.x), bfhi(h1.x), bflo(h1.y), bfhi(h1.y)} + a1 * scale; }
        else { v0 = *(const f32x4*)(H + off) + a0 * scale; v1 = *(const f32x4*)(H + off + 16) + a1 * scale; *(f32x4*)(H + off) = v0; *(f32x4*)(H + off + 16) = v1; }
        u32x2 w0; w0.x = pk2(v0[0], v0[1]); w0.y = pk2(v0[2], v0[3]); *(u32x2*)(HB + off) = w0;
        u32x2 w1; w1.x = pk2(v1[0], v1[1]); w1.y = pk2(v1[2], v1[3]); *(u32x2*)(HB + off + 16) = w1;
        float sq = ((v0[0] * v0[0] + v0[1] * v0[1]) + (v0[2] * v0[2] + v0[3] * v0[3])) + ((v1[0] * v1[0] + v1[1] * v1[1]) + (v1[2] * v1[2] + v1[3] * v1[3]));
        sq += __shfl_xor(sq, 16); sq += __shfl_xor(sq, 32);
        if (fq == 0) atomicAdd(ssn + row, sq);
    }
}

constexpr int NPHASE = 20;
constexpr int LDS_BYTES = 147456;
__global__ void __launch_bounds__(512, 2) mk_fwd(Args args0) {
    __shared__ __attribute__((aligned(16))) unsigned char lds_raw[LDS_BYTES];
    LAS unsigned char* lds = (LAS unsigned char*)lds_raw;
    const int tid0 = threadIdx.x; const int wave0 = __builtin_amdgcn_readfirstlane(tid0 >> 6);
    const int G0 = gridDim.x, bx0 = blockIdx.x;
    unsigned char* ws0 = args0.ws;
    volatile LAS unsigned* MISC = (volatile LAS unsigned*)(lds + 131072 + 8192);
    if (tid0 < 16) MISC[tid0] = 0u;
    __syncthreads();
    XcdBarrier bar; bar.bar = (unsigned*)(ws0 + WS_CTL) + CW_BAR; bar.x = 0; bar.st = nullptr;
    const bool one_launch = (args0.ph_hi - args0.ph_lo) > 1;
    if (one_launch) bar = xcd_barrier_post((unsigned*)(ws0 + WS_CTL) + CW_BAR, MISC + 8);

    const int nsteps = (args0.ph_hi - args0.ph_lo) + (one_launch ? __builtin_popcount(DUP_MASK) : 0);
    for (int step = 0; step < nsteps; ++step) {
        int ph = args0.ph_lo + step;
        if (DUP_MASK != 0u && one_launch) { int p = 0, accn = 0; for (;;) { const int cnt = 1 + (int)((DUP_MASK >> p) & 1u); if (step < accn + cnt) break; accn += cnt; ++p; } ph = p; }
        long z = 0; int bx = bx0, G = G0;
        asm volatile("" : "+s"(z), "+s"(bx), "+s"(G));
        const int NGW = G * 8;
        unsigned char* ws = ws0 + z; float* outp = args0.out + z;
        int lane = (int)__builtin_amdgcn_mbcnt_hi(~0u, __builtin_amdgcn_mbcnt_lo(~0u, 0u)) + (int)z;
        const int wave = wave0, tid = wave * 64 + lane;
        const int vcu = (G % 8 == 0) ? (bx % 8) * (G / 8) + bx / 8 : bx, gw = vcu * 8 + wave;
        float* SS = (float*)(ws + WS_SS);
        float* H = (float*)(ws + WS_H); bf16_t* HB = (bf16_t*)(ws + WS_HB); bf16_t* BIG = (bf16_t*)(ws + WS_BIG);
        switch (ph) {
        case 0: phase_prep(args0, ws, outp, lds, gw, NGW, wave, lane); break;
        case 1: case 8: case 10: case 17: {
            const int fi = ph == 1 ? 0 : ph == 8 ? 1 : ph == 10 ? 2 : 3;
            const int ssi = ph == 1 ? 0 : ph == 8 ? 2 : ph == 10 ? 3 : 5;
            pg8::Gemm g{HB, (const bf16_t*)(ws + ws_wup(fi)), T, 5632, DM, DM};
            pg8::StaticOrder S; S.init(T, 5632, G, bx);
            pg8::EpiSwiglu E{BIG, SS + (size_t)ssi * T};
            pg8::gemm_phase<pg8::EpiSwiglu, pg8::StaticOrder, true>(lds, g, S, E, tid);
        } break;
        case 2: case 9: case 11: case 18: case 7: case 16: {
            const bf16_t* A; const bf16_t* Bt; int K, lda, sso; float scale;
            if (ph == 7) { A = BIG + 2048; lda = GIN_LD; K = DM; Bt = (const bf16_t*)(ws + WS_WGOUT); sso = 2; scale = 1.0f; }
            else if (ph == 16) { A = (const bf16_t*)((unsigned char*)outp + OS_DN); lda = DM; K = DM; Bt = (const bf16_t*)(ws + WS_WMOUT); sso = 5; scale = 1.0f; }
            else { const int fi = ph == 2 ? 0 : ph == 9 ? 1 : ph == 11 ? 2 : 3; A = BIG; lda = DFF; K = DFF; Bt = (const bf16_t*)(ws + ws_wdn(fi)); sso = ph == 2 ? 1 : ph == 9 ? 3 : ph == 11 ? 4 : 6; scale = 0.5f; }
            unsigned char* part = ph == 16 ? (unsigned char*)BIG : (unsigned char*)outp;
            pg8::Gemm g{A, Bt, T, DM, K, lda};
            pg8::SplitOrder S; S.init(T, DM, K, G, bx);
            pg8::EpiResid E{H, HB, SS + (size_t)sso * T, scale, part};
            pg8::gemm_phase<pg8::EpiResid, pg8::SplitOrder, true>(lds, g, S, E, tid);
            if (S.S > 1) { xcd_barrier(bar); resid_fix(S, H, HB, SS + (size_t)sso * T, scale, part, gw, NGW, lane); }
        } break;
        case 3: {
            pg8::Gemm g{HB, (const bf16_t*)(ws + WS_WGIN), T, GIN_N, DM, DM};
            pg8::StaticOrder S; S.init(T, GIN_N, G, bx);
            pg8::EpiScaleBf16 E{BIG, GIN_LD, SS + (size_t)1 * T};
            pg8::gemm_phase<pg8::EpiScaleBf16, pg8::StaticOrder, true>(lds, g, S, E, tid);
        } break;
        case 4: phase_gla_a(args0, ws, outp, lds, G, bx, tid); break;
        case 5: phase_gla_b(args0, ws, outp, lds, G, vcu, gw, NGW, wave, lane); break;
        case 6: phase_gla_c(args0, ws, outp, lds, G, bx, wave, lane); break;
        case 12: {
            pg8::Gemm g{HB, (const bf16_t*)(ws + WS_WMDN), T, MDN_N, DM, DM};
            pg8::StaticOrder S; S.init(T, MDN_N, G, bx);
            pg8::EpiScaleF32 E{(float*)((unsigned char*)outp + OS_DN), MDN_N, SS + (size_t)4 * T};
            pg8::gemm_phase<pg8::EpiScaleF32, pg8::StaticOrder, true>(lds, g, S, E, tid);
        } break;
        case 13: phase_mla_prep(args0, ws, outp, gw, NGW, lane); break;
        case 14: {
            pg8::Gemm g{(const bf16_t*)(ws + WS_CQB), (const bf16_t*)(ws + WS_WQ), T, QN, 384, 384};
            pg8::StaticOrder S; S.init(T, QN, G, bx);
            pg8::EpiQ E{BIG, SS + (size_t)7 * T, 0.07216878364870322f * LOG2E};
            pg8::gemm_phase<pg8::EpiQ, pg8::StaticOrder, true>(lds, g, S, E, tid);
        } break;
        case 15: phase_attn(args0, ws, outp, lds, G, bx, tid, wave, lane); break;
        case 19: phase_final(args0, ws, outp, gw, NGW, lane); break;
        default: break;
        }
        if (step + 1 < nsteps) xcd_barrier(bar);
    }
}

extern "C" void kernel_launch(void* const* d_in, const int* in_sizes, int n_in, void* d_out, int out_size, void* d_ws, size_t ws_size, hipStream_t stream) {
    static int grid = 0;
    if (grid == 0) {
        if (n_in != 28 || out_size != (int)OUT_END || ws_size < WS_END) { fprintf(stderr, "kernel_launch: unexpected sizes n_in %d out %d ws %zu (need %zu)\n", n_in, out_size, ws_size, (size_t)WS_END); grid = -1; return; }
        int dev = 0, cus = 0;
        if (hipGetDevice(&dev) != hipSuccess || hipDeviceGetAttribute(&cus, hipDeviceAttributeMultiprocessorCount, dev) != hipSuccess || cus < 8) { fprintf(stderr, "kernel_launch: device query failed\n"); grid = -1; return; }
        grid = cus;
    }
    if (grid < 0) return;
    (void)hipMemsetAsync((char*)d_ws + WS_CTL, 0, CTL_ZERO_BYTES, stream);
    Args a{};
    for (int i = 0; i < 28; ++i) a.in[i] = (const float*)d_in[i];
    a.out = (float*)d_out; a.ws = (unsigned char*)d_ws;
#if MK_N_LAUNCHES == 1
    a.ph_lo = 0; a.ph_hi = NPHASE;
    hipLaunchKernelGGL(mk_fwd, dim3(grid), dim3(512), 0, stream, a);
#else
    for (int p = 0; p < NPHASE; ++p) { a.ph_lo = p; a.ph_hi = p + 1; hipLaunchKernelGGL(mk_fwd, dim3(grid), dim3(512), 0, stream, a); }
#endif
}
```

```cpp
#include <hip/hip_runtime.h>
#include <cstdio>
#include <cstdint>

#ifndef MK_N_LAUNCHES
#define MK_N_LAUNCHES 1
#endif

#ifndef GB_P1
#define GB_P1 0
#endif
#ifndef GB_P2
#define GB_P2 0
#endif
#ifndef ATT_P1
#define ATT_P1 0
#endif
#ifndef ATT_P2
#define ATT_P2 0
#endif
#ifndef ATT_P3
#define ATT_P3 0
#endif
#ifndef ATT_PROBEBASE
#define ATT_PROBEBASE 0
#endif
#ifndef ATT_DUPQK
#define ATT_DUPQK 0
#endif
#ifndef ATT_DUPPV
#define ATT_DUPPV 0
#endif
#ifndef RESID_BF16
#define RESID_BF16 1
#endif
#ifndef DUP_MASK
#define DUP_MASK 0u
#endif

#define LAS __attribute__((address_space(3)))
#define GAS __attribute__((address_space(1)))
typedef unsigned short bf16_t;
typedef short bf16x8 __attribute__((ext_vector_type(8)));
typedef short s16x4 __attribute__((ext_vector_type(4)));
typedef float f32x4 __attribute__((ext_vector_type(4)));
typedef float f32x2 __attribute__((ext_vector_type(2)));
typedef unsigned u32x4 __attribute__((ext_vector_type(4)));
typedef unsigned u32x2 __attribute__((ext_vector_type(2)));
typedef __bf16 bf16x2_t __attribute__((ext_vector_type(2)));

constexpr int DM = 1024, DFF = 2816, NB = 4, SEQ = 4096, NMETA = 16, LP = 4112, LPP = 4160, NCH = 65;
constexpr int SB = 32, SL = 32, PAST = 2048;
constexpr int ROWS_P = NB * LPP;
constexpr int T = ROWS_P + SB * SL;
constexpr int GIN_N = 3328, GIN_LD = 3328;
constexpr int MDN_N = 768;
constexpr int QN = 2560, QLD = 2560;
constexpr int KLD = 320;
constexpr float EPS = 1e-6f;
constexpr float LOG2E = 1.4426950408889634f;

constexpr size_t OUT_YP = 0, OUT_YS = 16777216, OUT_GP = 17825792, OUT_GS = 18350080, OUT_LP = 22544384, OUT_RP = 26755072, OUT_LS = 27807744, OUT_RS = 28069888, OUT_END = 28135424;
constexpr size_t MiB = 1u << 20;
constexpr size_t OS_SBUFP = 0;
constexpr size_t OS_DN = 0;
constexpr size_t OS_KP = 52 * MiB;

constexpr size_t WS_CTL = 0, CTL_ZERO_BYTES = 1 * MiB;
constexpr size_t WS_SS = 256 * 1024;
constexpr size_t WS_L0 = 1 * MiB;
constexpr size_t WS_KS = WS_L0;
constexpr size_t WS_WGIN = WS_L0 + 33 * MiB;
constexpr size_t WS_WGOUT = WS_WGIN + 6 * MiB + 512 * 1024;
constexpr size_t WS_L1 = 43 * MiB;
constexpr size_t WS_WMDN = WS_L1 + 33 * MiB;
constexpr size_t WS_WMOUT = WS_WMDN + 1 * MiB + 512 * 1024;
constexpr size_t WS_WQ = WS_WMOUT + 2 * MiB;
constexpr size_t WS_WUVT = WS_WQ + 2 * MiB;
constexpr size_t WS_ROPE = WS_WUVT + 512 * 1024;
constexpr size_t WS_DEC = WS_ROPE + 1 * MiB + 256 * 1024;
constexpr size_t WS_SBUFS = WS_DEC + 1 * MiB;
__host__ __device__ constexpr size_t ws_wup(int fi) { return (fi < 2 ? WS_L0 : WS_L1) + (size_t)(fi & 1) * 11 * MiB; }
__host__ __device__ constexpr size_t ws_wdn(int fi) { return (fi < 2 ? WS_L0 : WS_L1) + 22 * MiB + (size_t)(fi & 1) * (5 * MiB + 512 * 1024); }
static_assert((size_t)(SB * (PAST + SL) + 32) * KLD * 2 <= 41 * MiB + 512 * 1024, "KS fits the layer-0 weight block");
constexpr size_t WS_H = WS_SBUFS + 8 * MiB;
constexpr size_t WS_HB = WS_H + 69 * MiB;
constexpr size_t WS_BIG = WS_HB + 34 * MiB + 512 * 1024;
constexpr size_t WS_CQB = WS_BIG + 87 * MiB;
constexpr size_t WS_END = WS_BIG + 112 * MiB + 128 * 1024;
static_assert(WS_CQB + 13 * MiB <= WS_END, "ws map");
static_assert((size_t)T * QLD * 2 <= 87 * MiB, "Q fits");

constexpr int CW_BAR = 4096;
constexpr int CW_SPLIT = 8192;

__device__ __forceinline__ unsigned pk2(float lo, float hi) { f32x2 v = {lo, hi}; bf16x2_t b = __builtin_convertvector(v, bf16x2_t); return __builtin_bit_cast(unsigned, b); }
__device__ __forceinline__ float bf2f(unsigned short x) { return __uint_as_float((unsigned)x << 16); }
__device__ __forceinline__ float bflo(unsigned x) { return __uint_as_float(x << 16); }
__device__ __forceinline__ float bfhi(unsigned x) { return __uint_as_float(x & 0xffff0000u); }
__device__ __forceinline__ float wave_sum(float v) {
#pragma unroll
    for (int o = 1; o < 64; o <<= 1) v += __shfl_xor(v, o);
    return v;
}
__device__ __forceinline__ float fexp2(float x) { return __builtin_amdgcn_exp2f(x); }
__device__ __forceinline__ float frcp(float x) { return __builtin_amdgcn_rcpf(x); }
__device__ __forceinline__ float silu_f(float g) { return g * frcp(1.0f + fexp2(-g * LOG2E)); }
__device__ __forceinline__ f32x4 mfma16(bf16x8 a, bf16x8 b, f32x4 c) { return __builtin_amdgcn_mfma_f32_16x16x32_bf16(a, b, c, 0, 0, 0); }

namespace pg8 {
constexpr int BM = 256, BK = 64, HALF = 128, HTB = HALF * BK * 2, STAGE_BYTES = 8 * HTB, NXCD = 8, WGM = 8;
__host__ __device__ __forceinline__ int lds_byte(int r, int c) { const int st = (r >> 4) * 2 + (c >> 5), rr = r & 15, cc = c & 31, ob = rr * 64 + cc * 2; return st * 1024 + (ob ^ (((ob >> 9) & 1) << 5)); }
__host__ __device__ __forceinline__ void stage_rc(int b, int& R, int& C) { const int st = b / 1024, sb = b % 1024, swz = sb ^ (((sb >> 9) & 1) << 5); R = (st >> 1) * 16 + swz / 64; C = (st & 1) * 32 + (swz % 64) / 2; }
__host__ __device__ __forceinline__ int perm32(int rho) { const int n = rho >> 4, i = rho & 15; return 8 * (i >> 2) + 4 * n + (i & 3); }

struct Unit { int pm, pn, k0, nt, part; };
struct Gemm { const bf16_t* A; const bf16_t* Bt; int M, N, K, lda; };

struct StaticOrder {
    static constexpr bool SPLIT = false;
    int nM, nN, nwg, G, c;
    __device__ void init(int M, int N, int G_, int c_) { nM = M / BM; nN = N / BM; nwg = nM * nN; G = G_; c = c_; }
    __device__ bool next(int i, Unit& u) const {
        const long L = (long)i * G + c; if (L >= nwg) return false;
        int wgid = (int)L; { const int q = nwg / NXCD, r = nwg % NXCD, xcd = wgid % NXCD, off = wgid / NXCD; wgid = (xcd < r ? xcd * (q + 1) : r * (q + 1) + (xcd - r) * q) + off; }
        const int nig = WGM * nN, gid = wgid / nig, fm = gid * WGM, gsz = (nM - fm) < WGM ? (nM - fm) : WGM;
        u.pm = fm + ((wgid % nig) % gsz); u.pn = (wgid % nig) / gsz; return true;
    }
};

struct SplitOrder {
    static constexpr bool SPLIT = true;
    int nM, nN, nwg, G, c, full, rem, S, ntf, per;
    __device__ void init(int M, int N, int K, int G_, int c_) {
        nM = M / BM; nN = N / BM; nwg = nM * nN; G = G_; c = c_; full = nwg / G; rem = nwg % G; ntf = K / BK; S = 1;
        if (rem > 0) { const int pairs = ntf / 2, lim = G / rem; for (int d = 2; d <= pairs && d <= lim; ++d) if (pairs % d == 0) S = d; }
        per = ntf / S;
    }
    __device__ void tile(int L, int& pm, int& pn) const {
        int wgid = L; { const int q = nwg / NXCD, r = nwg % NXCD, xcd = wgid % NXCD, off = wgid / NXCD; wgid = (xcd < r ? xcd * (q + 1) : r * (q + 1) + (xcd - r) * q) + off; }
        const int nig = WGM * nN, gid = wgid / nig, fm = gid * WGM, gsz = (nM - fm) < WGM ? (nM - fm) : WGM;
        pm = fm + ((wgid % nig) % gsz); pn = (wgid % nig) / gsz;
    }
    __device__ bool next(int i, Unit& u) const {
        int r = i;
        if (S > 1 && c < rem * S) {
            if (i == 0) { const int j = c / S, s = c - j * S; tile(full * G + j, u.pm, u.pn); u.k0 = s * per; u.nt = per; u.part = c; return true; }
            r = i - 1;
        }
        if (r < full) { tile(r * G + c, u.pm, u.pn); u.k0 = 0; u.nt = ntf; u.part = -1; return true; }
        if (S == 1 && r == full && c < rem) { tile(full * G + c, u.pm, u.pn); u.k0 = 0; u.nt = ntf; u.part = -1; return true; }
        return false;
    }
};

template <class Epi, class Sched, bool ALIGN_EPI>
__device__ __forceinline__ void gemm_phase(LAS unsigned char* lds, const Gemm g, const Sched& S, const Epi& E, const int tid) {
    const int wid = __builtin_amdgcn_readfirstlane(tid >> 6), lane = tid & 63, wr = wid >> 2, wc = wid & 3, fr = lane & 15, fq = lane >> 4;
    int K_ = g.K, lda_ = g.lda; asm volatile("" : "+s"(K_), "+s"(lda_));
    const int K = K_, lda = lda_, nt = K / BK;
    unsigned voffA[2], voffB[2];
#pragma unroll
    for (int i = 0; i < 2; ++i) { int R, C; stage_rc(tid * 16 + i * 8192, R, C); const int Rb = Epi::PERM ? ((R & ~31) + perm32(R & 31)) : R;
        voffA[i] = (unsigned)(R * lda + C) * 2u; voffB[i] = (unsigned)(Rb * K + C) * 2u; }
    const size_t kstep = (size_t)(BK * 2);
    const size_t hstepA = (size_t)HALF * lda * 2, hstepB = (size_t)HALF * K * 2;
    const size_t tstepA = 2 * hstepA, tstepB = 2 * hstepB;
    const unsigned ldsw = (unsigned)wid * 1024u;
    const int aoff = lds_byte(wr * 64 + fr, fq * 8), boff = lds_byte(wc * 32 + fr, fq * 8);
#define PG8_SA(b, h) (((b) * 2 + (h)) * HTB)
#define PG8_SB(b, h) ((4 + (b) * 2 + (h)) * HTB)
#define PG8_STAGE(bufoff, gbase, voff) do { _Pragma("unroll") for (int _i = 0; _i < 2; ++_i) \
        __builtin_amdgcn_global_load_lds((const unsigned*)((const char*)(gbase) + (voff)[_i]), (LAS unsigned*)(lds + (bufoff) + ldsw + _i * 8192), 16, 0, 0); } while (0)
#define PG8_LDA(dst, b, h) do { _Pragma("unroll") for (int m = 0; m < 4; ++m) _Pragma("unroll") for (int k = 0; k < 2; ++k) dst[m][k] = *(const LAS bf16x8*)(lds + PG8_SA(b, h) + aoff + m * 2048 + k * 1024); } while (0)
#define PG8_LDB(dst, b, h) do { _Pragma("unroll") for (int n = 0; n < 2; ++n) _Pragma("unroll") for (int k = 0; k < 2; ++k) dst[n][k] = *(const LAS bf16x8*)(lds + PG8_SB(b, h) + boff + n * 2048 + k * 1024); } while (0)
#define PG8_MMA(ai, bj, At, Bt) do { __builtin_amdgcn_s_setprio(1); _Pragma("unroll") for (int m = 0; m < 4; ++m) _Pragma("unroll") for (int n = 0; n < 2; ++n) _Pragma("unroll") for (int k = 0; k < 2; ++k) \
        acc[ai][bj][m][n] = __builtin_amdgcn_mfma_f32_16x16x32_bf16(Bt[n][k], At[m][k], acc[ai][bj][m][n], 0, 0, 0); __builtin_amdgcn_s_setprio(0); } while (0)
#define PG8_WAIT_V(n) asm volatile("s_waitcnt vmcnt(" #n ")" ::: "memory")
#define PG8_WAIT_L(n) asm volatile("s_waitcnt lgkmcnt(" #n ")" ::: "memory")
#define PG8_BAR __builtin_amdgcn_s_barrier()
#define PG8_SCHED __builtin_amdgcn_sched_barrier(0)
    Unit cur, nxt; int ui = 0;
    if (!S.next(0, cur)) return;
    f32x4 acc[2][2][4][2];
#pragma unroll
    for (int a = 0; a < 2; ++a)
#pragma unroll
        for (int b = 0; b < 2; ++b)
#pragma unroll
            for (int m = 0; m < 4; ++m)
#pragma unroll
                for (int n = 0; n < 2; ++n) acc[a][b][m][n] = (f32x4){0.f, 0.f, 0.f, 0.f};
    bf16x8 At[4][2], B0[2][2], B1[2][2];
    const char* cA = (const char*)g.A + (size_t)cur.pm * tstepA; const char* cB = (const char*)g.Bt + (size_t)cur.pn * tstepB;
    int ntc = nt;
    if constexpr (Sched::SPLIT) { cA += (size_t)cur.k0 * kstep; cB += (size_t)cur.k0 * kstep; ntc = cur.nt; }
    PG8_STAGE(PG8_SB(0, 0), cB, voffB); PG8_STAGE(PG8_SB(0, 1), cB + hstepB, voffB); PG8_STAGE(PG8_SA(0, 0), cA, voffA); PG8_STAGE(PG8_SA(0, 1), cA + hstepA, voffA);
    if (wr == 1) PG8_BAR;
    PG8_WAIT_V(2); PG8_BAR;
    PG8_STAGE(PG8_SB(1, 0), cB + kstep, voffB); PG8_STAGE(PG8_SA(1, 0), cA + kstep, voffA); PG8_STAGE(PG8_SB(1, 1), cB + hstepB + kstep, voffB);
    PG8_WAIT_V(6); PG8_BAR;
    for (;;) {
        const bool has_next = S.next(ui + 1, nxt);
        const char* nA = has_next ? (const char*)g.A + (size_t)nxt.pm * tstepA : cA; const char* nB = has_next ? (const char*)g.Bt + (size_t)nxt.pn * tstepB : cB;
        if constexpr (Sched::SPLIT) { if (has_next) { nA += (size_t)nxt.k0 * kstep; nB += (size_t)nxt.k0 * kstep; } }
        for (int t = 0; t < ntc; t += 2) {
            const bool last = (t == ntc - 2);
            const char* a1 = cA + (size_t)(t + 1) * kstep;
            const char* a2 = last ? nA : cA + (size_t)(t + 2) * kstep; const char* b2 = last ? nB : cB + (size_t)(t + 2) * kstep;
            const char* a3 = a2 + kstep; const char* b3 = b2 + kstep;
            PG8_LDB(B0, 0, 0); PG8_LDB(B1, 0, 1); PG8_SCHED; PG8_LDA(At, 0, 0); PG8_STAGE(PG8_SA(1, 1), a1 + hstepA, voffA);
            PG8_WAIT_V(8); PG8_WAIT_L(0); PG8_BAR; PG8_MMA(0, 0, At, B0); PG8_MMA(0, 1, At, B1); PG8_BAR; PG8_SCHED;
            PG8_LDA(At, 0, 1); PG8_STAGE(PG8_SB(0, 0), b2, voffB); PG8_STAGE(PG8_SB(0, 1), b2 + hstepB, voffB); PG8_STAGE(PG8_SA(0, 0), a2, voffA);
            PG8_WAIT_V(8); PG8_WAIT_L(0); PG8_BAR; PG8_MMA(1, 0, At, B0); PG8_MMA(1, 1, At, B1); PG8_BAR; PG8_SCHED;
            PG8_LDB(B0, 1, 0); PG8_LDB(B1, 1, 1); PG8_SCHED; PG8_LDA(At, 1, 0); PG8_STAGE(PG8_SA(0, 1), a2 + hstepA, voffA);
            PG8_WAIT_V(8); PG8_WAIT_L(0); PG8_BAR; PG8_MMA(0, 0, At, B0); PG8_MMA(0, 1, At, B1); PG8_BAR; PG8_SCHED;
            PG8_LDA(At, 1, 1); PG8_STAGE(PG8_SB(1, 0), b3, voffB); PG8_STAGE(PG8_SB(1, 1), b3 + hstepB, voffB); PG8_STAGE(PG8_SA(1, 0), a3, voffA);
            PG8_WAIT_V(8); PG8_WAIT_L(0); PG8_BAR; PG8_MMA(1, 0, At, B0); PG8_MMA(1, 1, At, B1); PG8_BAR; PG8_SCHED;
        }
        if constexpr (ALIGN_EPI) { if (wr == 0) PG8_BAR; }
        if constexpr (Sched::SPLIT) {
            if (cur.part >= 0) {
                E.partial(acc, cur.part, wr, wc, fr, fq);
                PG8_WAIT_V(0); PG8_BAR;
                if (tid == 0) E.signal();
            } else E(acc, cur, wr, wc, fr, fq);
        }
        else E(acc, cur, wr, wc, fr, fq);
        if (!has_next) break;
#pragma unroll
        for (int a = 0; a < 2; ++a)
#pragma unroll
            for (int b = 0; b < 2; ++b)
#pragma unroll
                for (int m = 0; m < 4; ++m)
#pragma unroll
                    for (int n = 0; n < 2; ++n) acc[a][b][m][n] = (f32x4){0.f, 0.f, 0.f, 0.f};
        cur = nxt; cA = nA; cB = nB; ++ui;
        if constexpr (Sched::SPLIT) ntc = nxt.nt;
        if constexpr (ALIGN_EPI) { if (wr == 1) PG8_BAR; }
    }
    PG8_WAIT_V(0);
    if constexpr (!ALIGN_EPI) { if (wr == 0) PG8_BAR; }
    PG8_BAR;
#undef PG8_SA
#undef PG8_SB
#undef PG8_STAGE
#undef PG8_LDA
#undef PG8_LDB
#undef PG8_MMA
#undef PG8_WAIT_V
#undef PG8_WAIT_L
#undef PG8_BAR
#undef PG8_SCHED
}

struct EpiSwiglu {
    static constexpr bool PERM = true;
    bf16_t* O; const float* ss;
    __device__ __forceinline__ void operator()(const f32x4 (&acc)[2][2][4][2], const Unit& u, int wr, int wc, int fr, int fq) const {
        const int row0 = u.pm * BM + wr * 64 + fr, col0 = u.pn * 128 + wc * 32 + 8 * fq;
#pragma unroll
        for (int ai = 0; ai < 2; ++ai)
#pragma unroll
            for (int m = 0; m < 4; ++m) {
                const int row = row0 + ai * HALF + m * 16;
                const float rs = __builtin_amdgcn_rsqf(ss[row] * (1.0f / DM) + EPS);
                float a[8];
#pragma unroll
                for (int n = 0; n < 2; ++n)
#pragma unroll
                    for (int e = 0; e < 4; ++e) { const float gg = acc[ai][0][m][n][e] * rs, uu = acc[ai][1][m][n][e] * rs; a[n * 4 + e] = silu_f(gg) * uu; }
                u32x4 w; w.x = pk2(a[0], a[1]); w.y = pk2(a[2], a[3]); w.z = pk2(a[4], a[5]); w.w = pk2(a[6], a[7]);
                *(u32x4*)(O + (size_t)row * DFF + col0) = w;
            }
    }
};
struct EpiResid {
    static constexpr bool PERM = false;
    float* h; bf16_t* hb; float* ssn; float scale; unsigned char* part; unsigned* cnt;
    __device__ __forceinline__ void signal() const { __builtin_amdgcn_fence(__ATOMIC_RELEASE, "agent"); __hip_atomic_fetch_add(cnt, 1u, __ATOMIC_RELAXED, __HIP_MEMORY_SCOPE_AGENT); }
    __device__ __forceinline__ void partial(const f32x4 (&acc)[2][2][4][2], int slot, int wr, int wc, int fr, int fq) const {
        unsigned char* P = part + (size_t)slot * 131072 + (size_t)(wr * 4 + wc) * 16384 + (size_t)(fq * 16 + fr) * 16;
#pragma unroll
        for (int ai = 0; ai < 2; ++ai)
#pragma unroll
            for (int m = 0; m < 4; ++m)
#pragma unroll
                for (int bj = 0; bj < 2; ++bj) { const f32x4 v0 = acc[ai][bj][m][0], v1 = acc[ai][bj][m][1];
                    u32x4 w; w.x = pk2(v0[0], v0[1]); w.y = pk2(v0[2], v0[3]); w.z = pk2(v1[0], v1[1]); w.w = pk2(v1[2], v1[3]);
                    *(u32x4*)(P + ((ai * 4 + m) * 2 + bj) * 1024) = w; }
    }
    __device__ __forceinline__ void operator()(const f32x4 (&acc)[2][2][4][2], const Unit& u, int wr, int wc, int fr, int fq) const {
        const int row0 = u.pm * BM + wr * 64 + fr, col0 = u.pn * BM + wc * 32 + 4 * fq;
#pragma unroll
        for (int ai = 0; ai < 2; ++ai)
#pragma unroll
            for (int m = 0; m < 4; ++m) {
                const int row = row0 + ai * HALF + m * 16; float s = 0.f;
#pragma unroll
                for (int bj = 0; bj < 2; ++bj)
#pragma unroll
                    for (int n = 0; n < 2; ++n) {
                        const size_t off = (size_t)row * DM + col0 + bj * HALF + n * 16;
                        f32x4 v;
                        if (RESID_BF16) { const u32x2 hv = *(const u32x2*)(hb + off); v = (f32x4){bflo(hv.x), bfhi(hv.x), bflo(hv.y), bfhi(hv.y)} + acc[ai][bj][m][n] * scale; }
                        else { v = *(const f32x4*)(h + off) + acc[ai][bj][m][n] * scale; *(f32x4*)(h + off) = v; }
                        u32x2 w; w.x = pk2(v[0], v[1]); w.y = pk2(v[2], v[3]); *(u32x2*)(hb + off) = w;
                        s += (v[0] * v[0] + v[1] * v[1]) + (v[2] * v[2] + v[3] * v[3]);
                    }
                s += __shfl_xor(s, 16); s += __shfl_xor(s, 32);
                if (fq == 0) atomicAdd(ssn + row, s);
            }
    }
};
struct EpiScaleBf16 {
    static constexpr bool PERM = true;
    bf16_t* O; int ldc; const float* ss;
    __device__ __forceinline__ void operator()(const f32x4 (&acc)[2][2][4][2], const Unit& u, int wr, int wc, int fr, int fq) const {
        const int row0 = u.pm * BM + wr * 64 + fr, col0 = u.pn * BM + wc * 32 + 8 * fq;
#pragma unroll
        for (int ai = 0; ai < 2; ++ai)
#pragma unroll
            for (int m = 0; m < 4; ++m) {
                const int row = row0 + ai * HALF + m * 16;
                const float rs = __builtin_amdgcn_rsqf(ss[row] * (1.0f / DM) + EPS);
#pragma unroll
                for (int bj = 0; bj < 2; ++bj) { const f32x4 v0 = acc[ai][bj][m][0] * rs, v1 = acc[ai][bj][m][1] * rs;
                    u32x4 w; w.x = pk2(v0[0], v0[1]); w.y = pk2(v0[2], v0[3]); w.z = pk2(v1[0], v1[1]); w.w = pk2(v1[2], v1[3]);
                    *(u32x4*)(O + (size_t)row * ldc + col0 + bj * HALF) = w; }
            }
    }
};
struct EpiScaleF32 {
    static constexpr bool PERM = false;
    float* O; int ldc; const float* ss;
    __device__ __forceinline__ void operator()(const f32x4 (&acc)[2][2][4][2], const Unit& u, int wr, int wc, int fr, int fq) const {
        const int row0 = u.pm * BM + wr * 64 + fr, col0 = u.pn * BM + wc * 32 + 4 * fq;
#pragma unroll
        for (int ai = 0; ai < 2; ++ai)
#pragma unroll
            for (int m = 0; m < 4; ++m) {
                const int row = row0 + ai * HALF + m * 16;
                const float rs = __builtin_amdgcn_rsqf(ss[row] * (1.0f / DM) + EPS);
#pragma unroll
                for (int bj = 0; bj < 2; ++bj)
#pragma unroll
                    for (int n = 0; n < 2; ++n) *(f32x4*)(O + (size_t)row * ldc + col0 + bj * HALF + n * 16) = acc[ai][bj][m][n] * rs;
            }
    }
};
struct EpiQ {
    static constexpr bool PERM = true;
    bf16_t* Q; const float* ssq; float c2;
    __device__ __forceinline__ void operator()(const f32x4 (&acc)[2][2][4][2], const Unit& u, int wr, int wc, int fr, int fq) const {
        const int row0 = u.pm * BM + wr * 64 + fr;
        const int cb0 = u.pn < 8 ? u.pn * 320 + wc * 32 + 8 * fq : (4 * (u.pn - 8) + (wc >> 1)) * 320 + 256 + 32 * (wc & 1) + 8 * fq;
        const int cbstep = u.pn < 8 ? HALF : 640;
#pragma unroll
        for (int ai = 0; ai < 2; ++ai)
#pragma unroll
            for (int m = 0; m < 4; ++m) {
                const int row = row0 + ai * HALF + m * 16;
                const float rs = __builtin_amdgcn_rsqf(ssq[row] * (1.0f / 384.0f) + EPS) * c2;
#pragma unroll
                for (int bj = 0; bj < 2; ++bj) { const f32x4 v0 = acc[ai][bj][m][0] * rs, v1 = acc[ai][bj][m][1] * rs;
                    u32x4 w; w.x = pk2(v0[0], v0[1]); w.y = pk2(v0[2], v0[3]); w.z = pk2(v1[0], v1[1]); w.w = pk2(v1[2], v1[3]);
                    *(u32x4*)(Q + (size_t)row * QLD + cb0 + bj * cbstep) = w; }
            }
    }
};
}

#define XB_TMO      128
#define XB_XCNT(j)  (256  + 64 * (j))
#define XB_XSUB(j)  (1280 + 64 * (j))
#define XB_XGEN(j)  (2304 + 64 * (j))
#define XB_TOP      3328
#define XB_TOPGEN   3392
#define XCD_BAR_WORDS 3456
#define XB_SPIN_CAP (1u << 18)
__device__ __forceinline__ unsigned xb_ld(unsigned* p)              { return __hip_atomic_load(p, __ATOMIC_RELAXED, __HIP_MEMORY_SCOPE_AGENT); }
__device__ __forceinline__ unsigned xb_add(unsigned* p, unsigned v) { return __hip_atomic_fetch_add(p, v, __ATOMIC_RELAXED, __HIP_MEMORY_SCOPE_AGENT); }
__device__ __forceinline__ unsigned xb_xcc_id() { return (unsigned)__builtin_amdgcn_s_getreg((3 << 11) | 20) & 0xFu; }
#define XB_SPIN(cond, bar) do { unsigned _sp = 0; while (cond) { __builtin_amdgcn_s_sleep(1); \
    if ((++_sp & 255u) == 0u) { if (xb_ld(&(bar)[XB_TMO])) break; if (_sp > XB_SPIN_CAP) { atomicAdd(&(bar)[XB_TMO], 1u); break; } } } } while (0)
struct XcdBarrier { unsigned* bar; unsigned x; volatile LAS unsigned* st; };
__device__ __forceinline__ XcdBarrier xcd_barrier_post(unsigned* bar, volatile LAS unsigned* st) {
    XcdBarrier b; b.bar = bar; b.x = xb_xcc_id(); b.st = st;
    if (threadIdx.x == 0) (void)xb_add(&bar[XB_XCNT(b.x)], 1u);
    return b;
}
__device__ __forceinline__ void xcd_barrier_complete(unsigned* bar, unsigned x, unsigned& nloc, unsigned& nx) {
    const unsigned G = gridDim.x * gridDim.y * gridDim.z;
    unsigned sum, cnt, mine, sp = 0u;
    for (;;) {
        sum = 0u; cnt = 0u; mine = 0u;
#pragma unroll
        for (unsigned j = 0; j < 16; ++j) { const unsigned c = xb_ld(&bar[XB_XCNT(j)]); sum += c; cnt += (c > 0u) ? 1u : 0u; mine = (j == x) ? c : mine; }
        if (sum == G) break;
        __builtin_amdgcn_s_sleep(1);
        if ((++sp & 255u) == 0u) { if (xb_ld(&bar[XB_TMO])) break; if (sp > XB_SPIN_CAP) { atomicAdd(&bar[XB_TMO], 1u); break; } }
    }
    nloc = mine > 0u ? mine : 1u; nx = cnt > 0u ? cnt : 1u;
}
__device__ __forceinline__ void xcd_barrier(const XcdBarrier& b) {
    asm volatile("s_waitcnt vmcnt(0)" ::: "memory");
    __syncthreads();
    if (threadIdx.x == 0) {
        unsigned* bar = b.bar;
        __builtin_amdgcn_s_waitcnt(0);
        unsigned nloc = b.st[0], nx = b.st[1];
        if (nloc == 0u) { xcd_barrier_complete(bar, b.x, nloc, nx); b.st[0] = nloc; b.st[1] = nx; }
        const unsigned old = xb_add(&bar[XB_XSUB(b.x)], 1u);
        const unsigned gen = old / nloc;
        if (old + 1u == (gen + 1u) * nloc) {
            __builtin_amdgcn_fence(__ATOMIC_RELEASE, "agent");
            asm volatile("s_waitcnt vmcnt(0)" ::: "memory");
            const unsigned og = xb_add(&bar[XB_TOP], 1u);
            const unsigned tg = og / nx;
            if (og + 1u == (tg + 1u) * nx) xb_add(&bar[XB_TOPGEN], 1u);
            else XB_SPIN(xb_ld(&bar[XB_TOPGEN]) == tg, bar);
            __builtin_amdgcn_fence(__ATOMIC_ACQUIRE, "agent");
            xb_add(&bar[XB_XGEN(b.x)], 1u);
            asm volatile("s_waitcnt vmcnt(0)" ::: "memory");
        } else {
            XB_SPIN(xb_ld(&bar[XB_XGEN(b.x)]) == gen, bar);
            __builtin_amdgcn_fence(__ATOMIC_ACQUIRE, "agent");
            asm volatile("s_waitcnt vmcnt(0)" ::: "memory");
        }
    }
    __syncthreads();
}

struct Args { const float* in[28]; float* out; unsigned char* ws; int ph_lo, ph_hi; };

__device__ __forceinline__ void tr_item(const float* W, int ldw, int Nvalid, const float* kscale, bf16_t* WT, int Kd, int k0, int n0, int drow0, LAS float* scr, int lane) {
    const int n = n0 + 4 * (lane & 15);
    f32x4 v[16];
#pragma unroll
    for (int i = 0; i < 16; ++i) { const int kk = 4 * i + (lane >> 4); v[i] = (f32x4){0.f, 0.f, 0.f, 0.f}; if (n < Nvalid) v[i] = *(const f32x4*)(W + (size_t)(k0 + kk) * ldw + n); }
#pragma unroll
    for (int i = 0; i < 16; ++i) { const int kk = 4 * i + (lane >> 4); f32x4 x = v[i]; if (kscale) x = x * kscale[k0 + kk];
        LAS float* d = scr + kk * 65 + 4 * (lane & 15); d[0] = x[0]; d[1] = x[1]; d[2] = x[2]; d[3] = x[3]; }
    asm volatile("s_waitcnt lgkmcnt(0)" ::: "memory");
    const int c = lane & 7;
#pragma unroll
    for (int j = 0; j < 8; ++j) { const int nn = (lane >> 3) + 8 * j; const LAS float* s = scr + (8 * c) * 65 + nn;
        u32x4 o; o.x = pk2(s[0 * 65], s[1 * 65]); o.y = pk2(s[2 * 65], s[3 * 65]); o.z = pk2(s[4 * 65], s[5 * 65]); o.w = pk2(s[6 * 65], s[7 * 65]);
        *(u32x4*)(WT + (size_t)(drow0 + nn) * Kd + k0 + 8 * c) = o; }
    asm volatile("s_waitcnt lgkmcnt(0)" ::: "memory");
}
__device__ __forceinline__ void split8(const f32x4 x0, const f32x4 x1, bf16x8& hi, bf16x8& lo) {
    u32x4 h; h.x = pk2(x0[0], x0[1]); h.y = pk2(x0[2], x0[3]); h.z = pk2(x1[0], x1[1]); h.w = pk2(x1[2], x1[3]);
    u32x4 l; l.x = pk2(x0[0] - bflo(h.x), x0[1] - bfhi(h.x)); l.y = pk2(x0[2] - bflo(h.y), x0[3] - bfhi(h.y)); l.z = pk2(x1[0] - bflo(h.z), x1[1] - bfhi(h.z)); l.w = pk2(x1[2] - bflo(h.w), x1[3] - bfhi(h.w));
    hi = __builtin_bit_cast(bf16x8, h); lo = __builtin_bit_cast(bf16x8, l);
}
__device__ __forceinline__ void phase_prep(const Args& a, unsigned char* const ws_, float* const out_, LAS unsigned char* lds, int gw, int NGW, int wave, int lane) {
    unsigned char* ws = ws_;
    LAS float* scr = (LAS float*)(lds + wave * 16640);
    constexpr int I_UP = 16 * 44, I_DN = 44 * 16, I_GIN = 16 * 52, I_SQ = 16 * 16, I_MDN = 16 * 12;
    constexpr int I_FFN = 2 * I_UP + I_DN;
    constexpr int NITEMS = 4 * I_FFN + I_GIN + I_SQ + I_MDN + I_SQ;
    for (int it = gw; it < NITEMS; it += NGW) {
        int r = it;
        if (r < 4 * I_FFN) {
            const int fi = r / I_FFN; r -= fi * I_FFN; const int layer = fi >> 1, which = fi & 1;
            const float* nrm = a.in[which ? 23 : 6] + layer * DM;
            if (r < 2 * I_UP) { const int isup = r >= I_UP; if (isup) r -= I_UP;
                const float* W = a.in[(which ? 24 : 7) + isup] + (size_t)layer * DM * DFF;
                const int kb = r / 44, nb = r % 44, n0 = nb * 64;
                tr_item(W, DFF, DFF, nrm, (bf16_t*)(ws + ws_wup(fi)), DM, kb * 64, n0, 256 * (n0 >> 7) + (n0 & 127) + 128 * isup, scr, lane);
            } else { r -= 2 * I_UP;
                const float* W = a.in[which ? 26 : 9] + (size_t)layer * DFF * DM;
                const int kb = r / 16, nb = r % 16;
                tr_item(W, DM, DM, nullptr, (bf16_t*)(ws + ws_wdn(fi)), DFF, kb * 64, nb * 64, nb * 64, scr, lane);
            }
            continue;
        }
        r -= 4 * I_FFN;
        if (r < I_GIN) { const int kb = r / 52, nb = r % 52; tr_item(a.in[11], 3088, 3088, a.in[10], (bf16_t*)(ws + WS_WGIN), DM, kb * 64, nb * 64, nb * 64, scr, lane); continue; }
        r -= I_GIN;
        if (r < I_SQ) { const int kb = r / 16, nb = r % 16; tr_item(a.in[15], DM, DM, nullptr, (bf16_t*)(ws + WS_WGOUT), DM, kb * 64, nb * 64, nb * 64, scr, lane); continue; }
        r -= I_SQ;
        if (r < I_MDN) { const int kb = r / 12, nb = r % 12; tr_item(a.in[16], 704, 704, a.in[10] + DM, (bf16_t*)(ws + WS_WMDN), DM, kb * 64, nb * 64, nb * 64, scr, lane); continue; }
        r -= I_MDN;
        { const int kb = r / 16, nb = r % 16; tr_item(a.in[22], DM, DM, nullptr, (bf16_t*)(ws + WS_WMOUT), DM, kb * 64, nb * 64, nb * 64, scr, lane); }
    }
    const int gt = gw * 64 + lane, NGT = NGW * 64;
    {   const float* wuq = a.in[18]; const float* wuk = a.in[20]; const float* qn = a.in[17]; bf16_t* WQ = (bf16_t*)(ws + WS_WQ);
        {   const int fr = lane & 15, fq = lane >> 4;
            for (int it = gw; it < 8 * 24 * 4; it += NGW) {
                const int h = it / 96, ct = (it % 96) >> 2, rg = it & 3;
                const float* ap = wuq + (size_t)(16 * ct + fr) * 1536 + h * 192 + 8 * fq;
                bf16x8 ah[4], al[4];
#pragma unroll
                for (int s = 0; s < 4; ++s) split8(*(const f32x4*)(ap + 32 * s), *(const f32x4*)(ap + 32 * s + 4), ah[s], al[s]);
                const f32x4 qs = *(const f32x4*)(qn + 16 * ct + 4 * fq);
#pragma unroll
                for (int q = 0; q < 4; ++q) { const int rt = rg * 4 + q;
                    const float* bp = wuk + (size_t)(16 * rt + fr) * 1024 + h * 128 + 8 * fq;
                    f32x4 acc = (f32x4){0.f, 0.f, 0.f, 0.f};
#pragma unroll
                    for (int s = 0; s < 4; ++s) { bf16x8 bh, bl; split8(*(const f32x4*)(bp + 32 * s), *(const f32x4*)(bp + 32 * s + 4), bh, bl);
                        acc = mfma16(al[s], bh, acc); acc = mfma16(ah[s], bl, acc); acc = mfma16(ah[s], bh, acc); }
                    acc = acc * qs;
                    u32x2 w; w.x = pk2(acc[0], acc[1]); w.y = pk2(acc[2], acc[3]);
                    *(u32x2*)(WQ + (size_t)(h * 256 + 16 * rt + fr) * 384 + 16 * ct + 4 * fq) = w; }
            }
        }
        for (int i = gt; i < 512 * 384; i += NGT) {
            const int c = i % 384, rr = i / 384, head = rr >> 6, j = rr & 63;
            WQ[(size_t)(2048 + rr) * 384 + c] = (bf16_t)(pk2(wuq[(size_t)c * 1536 + head * 192 + 128 + j] * qn[c], 0.f) & 0xffffu);
        }
    }
    {   const float* wuv = a.in[21]; bf16_t* WU = (bf16_t*)(ws + WS_WUVT);
        for (int i = gt; i < 8 * 128 * 256; i += NGT) { const int j = i & 7, ln = (i >> 3) & 63, s = (i >> 9) & 7, vt = (i >> 12) & 7, h = i >> 15;
            const int dv = 32 * s + 16 * (j >> 2) + 4 * (ln >> 4) + (j & 3), v = 16 * vt + (ln & 15);
            WU[i] = (bf16_t)(pk2(wuv[(size_t)dv * 1024 + h * 128 + v], 0.f) & 0xffffu); }
    }
    {   f32x2* rt = (f32x2*)(ws + WS_ROPE);
        for (int i = gt; i < 4144 * 32; i += NGT) { const int idx = i >> 5, k = i & 31; const float pos = idx < LP ? (float)idx : (float)(PAST + idx - LP);
            const float inv = fexp2(-(float)k * 0.41524101186092029f); const float ang = pos * inv;
            const float kq = rintf(ang * 0.63661977236758134f);
            float r = ang - kq * 1.5703125f; r -= kq * 4.837512969970703125e-4f; r -= kq * 7.54978995489188216e-8f;
            const float r2 = r * r;
            const float sr = r + r * r2 * (-1.6666654611e-1f + r2 * (8.3321608736e-3f + r2 * -1.9515295891e-4f));
            const float cr = 1.0f - 0.5f * r2 + r2 * r2 * (4.166664568298827e-2f + r2 * (-1.388731625493765e-3f + r2 * 2.443315711809948e-5f));
            const int qd = (int)kq & 3;
            const float cs = qd == 0 ? cr : qd == 1 ? -sr : qd == 2 ? -cr : sr, sn = qd == 0 ? sr : qd == 1 ? cr : qd == 2 ? -sr : -cr;
            rt[i] = (f32x2){cs, sn}; }
    }
    {   float* H = (float*)(ws + WS_H); bf16_t* HB = (bf16_t*)(ws + WS_HB); float* SS0 = (float*)(ws + WS_SS);
        for (int row = gw; row < T; row += NGW) {
            const float* src = nullptr;
            if (row < ROWS_P) { const int b = row / LPP, p = row % LPP; if (p >= 64) src = a.in[0] + ((size_t)b * SEQ + (p - 64)) * DM; else if (p >= 48) src = a.in[5] + (size_t)(p - 48) * DM; }
            else src = a.in[1] + (size_t)(row - ROWS_P) * DM;
            float s = 0.f;
#pragma unroll
            for (int j = 0; j < 4; ++j) { f32x4 v = (f32x4){0.f, 0.f, 0.f, 0.f}; if (src) v = *(const f32x4*)(src + 256 * j + 4 * lane);
                if (!RESID_BF16) *(f32x4*)(H + (size_t)row * DM + 256 * j + 4 * lane) = v;
                u32x2 w; w.x = pk2(v[0], v[1]); w.y = pk2(v[2], v[3]); *(u32x2*)(HB + (size_t)row * DM + 256 * j + 4 * lane) = w;
                s += (v[0] * v[0] + v[1] * v[1]) + (v[2] * v[2] + v[3] * v[3]); }
            s = wave_sum(s); if (lane == 0) SS0[row] = s;
        }
    }
}

__device__ __forceinline__ void phase_gla_a(const Args& a, unsigned char* const ws_, float* const out_, LAS unsigned char* lds, int G, int bx, int tid) {
    bf16_t* P = (bf16_t*)(ws_ + WS_BIG); float* DEC = (float*)(ws_ + WS_DEC);
    const float* wg = a.in[12]; const float* bg = a.in[13];
    LAS float* gd = (LAS float*)lds;
    float w[16];
#pragma unroll
    for (int r = 0; r < 16; ++r) w[r] = wg[r * 512 + tid];
    const float bias = bg[tid];
    for (int cg = bx; cg < 260 + SB; cg += G) {
        int row0, nrows, npad;
        if (cg < 260) { const int b = cg / NCH, c = cg % NCH; row0 = b * LPP + 64 * c; nrows = 64; npad = c == 0 ? 48 : 0; }
        else { row0 = ROWS_P + 32 * (cg - 260); nrows = 32; npad = 0; }
        __syncthreads();
        for (int i = tid; i < nrows * 16; i += 512) gd[i] = bf2f(P[(size_t)(row0 + (i >> 4)) * GIN_LD + 3072 + (i & 15)]);
        __syncthreads();
        unsigned short qv[64], kv[64];
#pragma unroll
        for (int i = 0; i < 64; ++i) { qv[i] = 0; kv[i] = 0; if (i < nrows) { const bf16_t* pr = P + (size_t)(row0 + i) * GIN_LD; qv[i] = pr[tid]; kv[i] = pr[512 + tid]; } }
        float gc = 0.f;
#pragma unroll
        for (int i = 0; i < 64; ++i) {
            if (i < nrows) {
                bf16_t* pr = P + (size_t)(row0 + i) * GIN_LD;
                if (i >= npad) {
                    float g = bias;
#pragma unroll
                    for (int r = 0; r < 16; ++r) g += gd[i * 16 + r] * w[r];
                    const float ls = fminf(g, 0.f) - __logf(1.0f + __expf(-fabsf(g)));
                    gc += ls * (1.0f / 16.0f);
                }
                const float q = bf2f(qv[i]), k = bf2f(kv[i]);
                const float eg = __expf(gc);
                pr[tid] = (bf16_t)(pk2(q * 0.08838834764831845f * eg, 0.f) & 0xffffu);
                pr[512 + tid] = (bf16_t)(pk2(k * frcp(eg), 0.f) & 0xffffu);
            }
        }
        DEC[(size_t)cg * 512 + tid] = __expf(gc);
    }
}
__device__ __forceinline__ bf16x8 col8(const bf16_t* p, int stride) {
    bf16x8 r;
#pragma unroll
    for (int j = 0; j < 8; ++j) r[j] = (short)p[(size_t)j * stride];
    return r;
}
__device__ __forceinline__ bf16x8 tr8(const LAS unsigned char* p) {
    const s16x4 lo = __builtin_bit_cast(s16x4, __builtin_amdgcn_ds_read_tr16_b64_v4i16((LAS s16x4*)p));
    const s16x4 hi = __builtin_bit_cast(s16x4, __builtin_amdgcn_ds_read_tr16_b64_v4i16((LAS s16x4*)(p + 128)));
    return (bf16x8){lo[0], lo[1], lo[2], lo[3], hi[0], hi[1], hi[2], hi[3]};
}
__device__ __forceinline__ void phase_gla_b(const Args& a, unsigned char* const ws_, float* const out_, LAS unsigned char* lds, int G, int vcu, int gw, int NGW, int wid, int lane) {
    const bf16_t* P = (const bf16_t*)(ws_ + WS_BIG); const float* DEC = (const float*)(ws_ + WS_DEC);
    bf16_t* SBP = (bf16_t*)((unsigned char*)out_ + OS_SBUFP); bf16_t* SBS = (bf16_t*)(ws_ + WS_SBUFS);
    const int fr = lane & 15, fq = lane >> 4, tid = wid * 64 + lane;
    LAS unsigned char* wl = lds + wid * 8192;
    const int troff = (8 * fq + (fr >> 2)) * 32 + (fr & 3) * 8;
    for (int item = vcu; item < 256; item += G) {
        const int seq = item >> 4, rect = item & 15, dkt = 2 * (rect >> 2) + (wid >> 2), dvs = 4 * (rect & 3) + (wid & 3), b = seq >> 2, h = seq & 3;
        const int krow = tid >> 2, kch = tid & 3, vrow_ = tid >> 3, vch = tid & 7;
        const bf16_t* kp = P + (size_t)(b * LPP + krow) * GIN_LD + 512 + h * 128 + 32 * (rect >> 2) + 8 * kch;
        const bf16_t* vp = P + (size_t)(b * LPP + vrow_) * GIN_LD + 1024 + h * 256 + 64 * (rect & 3) + 8 * vch;
        const int kdst = (kch >> 1) * 2048 + krow * 32 + (kch & 1) * 16, vdst = 8192 + (vch >> 1) * 2048 + vrow_ * 32 + (vch & 1) * 16;
        const int ksrc = (wid >> 2) * 2048 + troff, vsrc = 8192 + (wid & 3) * 2048 + troff;
        const float* dp = DEC + (size_t)(b * NCH) * 512 + h * 128 + 16 * dkt + 4 * fq;
        f32x4 S = (f32x4){0.f, 0.f, 0.f, 0.f};
        u32x4 rk[4], rv[4]; f32x4 rd[4];
#define GB_LOAD(c, I) do { const size_t o_ = (size_t)(64 * (c)) * GIN_LD; if (tid < 256) rk[I] = *(const u32x4*)(kp + o_); rv[I] = *(const u32x4*)(vp + o_); rd[I] = *(const f32x4*)(dp + (size_t)(c) * 512); } while (0)
#define GB_STEP(c, I) do { LAS unsigned char* bb_ = lds + (((c) & 1) ? 16384 : 0); const f32x4 dcur_ = rd[I]; \
            if (tid < 256) *(LAS u32x4*)(bb_ + kdst) = rk[I]; *(LAS u32x4*)(bb_ + vdst) = rv[I]; \
            if ((c) + 4 < NCH) GB_LOAD((c) + 4, I); \
            if ((c) >= 1) { u32x2 w_; w_.x = pk2(S[0], S[1]); w_.y = pk2(S[2], S[3]); \
                *(u32x2*)(SBP + ((size_t)(seq * 64 + ((c) - 1)) * 256 + 16 * dvs + fr) * 128 + 16 * dkt + 4 * fq) = w_; } \
            __syncthreads(); \
            const bf16x8 ka0_ = tr8(bb_ + ksrc), ka1_ = tr8(bb_ + ksrc + 1024), va0_ = tr8(bb_ + vsrc), va1_ = tr8(bb_ + vsrc + 1024); \
            S = mfma16(ka0_, va0_, S); S = mfma16(ka1_, va1_, S); \
            S = S * dcur_; } while (0)
        __syncthreads();
        GB_LOAD(0, 0); GB_LOAD(1, 1); GB_LOAD(2, 2); GB_LOAD(3, 3);
        for (int c = 0; c + 3 < NCH; c += 4) { GB_STEP(c, 0); GB_STEP(c + 1, 1); GB_STEP(c + 2, 2); GB_STEP(c + 3, 3); }
        GB_STEP(NCH - 1, 0);
#undef GB_LOAD
#undef GB_STEP
        float* og = out_ + OUT_GP + ((size_t)seq * 128 + 16 * dkt + 4 * fq) * 256 + 16 * dvs + fr;
#pragma unroll
        for (int r = 0; r < 4; ++r) og[(size_t)r * 256] = S[r];
    }
    __syncthreads();
    for (int rep_ = 0; rep_ < (GB_P2 ? 2 : 1); ++rep_)
    for (int it = gw; it < 128 * 16; it += NGW) {
        const int seq = it >> 4, dkt = (it >> 1) & 7, dvh = it & 1, bs = seq >> 2, h = seq & 3;
        const int lrow = lane & 31;
        const bf16_t* kp = P + (size_t)(ROWS_P + 32 * bs + lrow) * GIN_LD + 512 + h * 128 + 16 * dkt;
        const bf16_t* vp = P + (size_t)(ROWS_P + 32 * bs + lrow) * GIN_LD + 1024 + h * 256 + 128 * dvh;
        { const u32x4 k0 = *(const u32x4*)kp, k1 = *(const u32x4*)(kp + 8);
          if (lane < 32) { *(LAS u32x4*)(wl + lane * 32) = k0; *(LAS u32x4*)(wl + lane * 32 + 16) = k1; } }
        const bf16x8 ka = tr8(wl + troff);
        const f32x4 d = *(const f32x4*)(DEC + (size_t)(260 + bs) * 512 + h * 128 + 16 * dkt + 4 * fq);
#pragma unroll 2
        for (int q = 0; q < 8; ++q) {
            const int dvs = 8 * dvh + q;
            { const u32x4 v0 = *(const u32x4*)(vp + 16 * q), v1 = *(const u32x4*)(vp + 16 * q + 8);
              if (lane < 32) { *(LAS u32x4*)(wl + 4096 + (q & 1) * 2048 + lane * 32) = v0; *(LAS u32x4*)(wl + 4096 + (q & 1) * 2048 + lane * 32 + 16) = v1; } }
            const size_t so = ((size_t)seq * 128 + 16 * dkt + 4 * fq) * 256 + 16 * dvs + fr;
            f32x4 S;
#pragma unroll
            for (int r = 0; r < 4; ++r) S[r] = a.in[2][so + (size_t)r * 256];
            { u32x2 w; w.x = pk2(S[0], S[1]); w.y = pk2(S[2], S[3]); *(u32x2*)(SBS + ((size_t)seq * 256 + 16 * dvs + fr) * 128 + 16 * dkt + 4 * fq) = w; }
            S = mfma16(ka, tr8(wl + 4096 + (q & 1) * 2048 + troff), S);
            S = S * d;
            float* og = out_ + OUT_GS + so;
#pragma unroll
            for (int r = 0; r < 4; ++r) og[(size_t)r * 256] = S[r];
        }
    }
}
template <int NI>
__device__ __forceinline__ void gla_c_item(LAS unsigned char* abuf, LAS float* red, bf16_t* P, const bf16_t* ST, const float* hn, int row0, int h, int wid, int lane) {
    { int zz = 0; asm volatile("" : "+v"(zz)); lane = (int)__builtin_amdgcn_mbcnt_hi(~0u, __builtin_amdgcn_mbcnt_lo(~0u, 0u)) + zz; }
    const int fr = lane & 15, fq = lane >> 4;
    constexpr int ASTR = 144;
    constexpr int NTILE = NI * NI, PERW = NTILE >= 8 ? NTILE / 8 : 1;
#pragma unroll
    for (int q = 0; q < PERW; ++q) {
        const int idx = wid * PERW + q;
        if (idx < NTILE) {
            const int it = idx / NI, jt = idx % NI;
            const bf16_t* kq = P + (size_t)(row0 + 16 * jt + fr) * GIN_LD + 512 + h * 128 + 8 * fq;
            const bf16_t* qq = P + (size_t)(row0 + 16 * it + fr) * GIN_LD + h * 128 + 8 * fq;
            f32x4 d = (f32x4){0.f, 0.f, 0.f, 0.f};
#pragma unroll
            for (int s = 0; s < 4; ++s) d = mfma16(*(const bf16x8*)(kq + 32 * s), *(const bf16x8*)(qq + 32 * s), d);
            const int i = 16 * it + fr, j0 = 16 * jt + 4 * fq;
#pragma unroll
            for (int r = 0; r < 4; ++r) if (j0 + r > i) d[r] = 0.f;
            u32x2 w; w.x = pk2(d[0], d[1]); w.y = pk2(d[2], d[3]);
            *(LAS u32x2*)(abuf + i * ASTR + j0 * 2) = w;
        }
    }
    __syncthreads();
    f32x4 o[2][NI];
#pragma unroll
    for (int dt = 0; dt < 2; ++dt)
#pragma unroll
        for (int it = 0; it < NI; ++it) o[dt][it] = (f32x4){0.f, 0.f, 0.f, 0.f};
    const int dv0 = 32 * wid;
    if (ST) {
#pragma unroll
        for (int s = 0; s < 4; ++s) {
            const bf16x8 s0 = *(const bf16x8*)(ST + (size_t)(dv0 + fr) * 128 + 32 * s + 8 * fq), s1 = *(const bf16x8*)(ST + (size_t)(dv0 + 16 + fr) * 128 + 32 * s + 8 * fq);
#pragma unroll
            for (int it = 0; it < NI; ++it) { const bf16x8 qf = *(const bf16x8*)(P + (size_t)(row0 + 16 * it + fr) * GIN_LD + h * 128 + 32 * s + 8 * fq);
                o[0][it] = mfma16(s0, qf, o[0][it]); o[1][it] = mfma16(s1, qf, o[1][it]); }
        }
    }
#pragma unroll
    for (int s = 0; s < NI / 2; ++s) {
        const bf16_t* vp = P + (size_t)(row0 + 32 * s + 8 * fq) * GIN_LD + 1024 + h * 256 + dv0 + fr;
        const bf16x8 v0 = col8(vp, GIN_LD), v1 = col8(vp + 16, GIN_LD);
#pragma unroll
        for (int it = 2 * s; it < NI; ++it) { const bf16x8 af = *(const LAS bf16x8*)(abuf + (16 * it + fr) * ASTR + (32 * s + 8 * fq) * 2);
            o[0][it] = mfma16(v0, af, o[0][it]); o[1][it] = mfma16(v1, af, o[1][it]); }
    }
#pragma unroll
    for (int it = 0; it < NI; ++it) { float s = 0.f;
#pragma unroll
        for (int dt = 0; dt < 2; ++dt) s += (o[dt][it][0] * o[dt][it][0] + o[dt][it][1] * o[dt][it][1]) + (o[dt][it][2] * o[dt][it][2] + o[dt][it][3] * o[dt][it][3]);
        s += __shfl_xor(s, 16); s += __shfl_xor(s, 32);
        if (fq == 0) red[wid * 64 + 16 * it + fr] = s; }
    __syncthreads();
#pragma unroll
    for (int it = 0; it < NI; ++it) { float tot = 0.f;
#pragma unroll
        for (int w = 0; w < 8; ++w) tot += red[w * 64 + 16 * it + fr];
        const float rs = __builtin_amdgcn_rsqf(tot * (1.0f / 256.0f) + EPS);
#pragma unroll
        for (int dt = 0; dt < 2; ++dt) { const int dv = dv0 + 16 * dt + 4 * fq;
            bf16_t* rp = P + (size_t)(row0 + 16 * it + fr) * GIN_LD + 2048 + h * 256 + dv;
            const u32x2 rr = *(const u32x2*)rp; const f32x4 hw = *(const f32x4*)(hn + dv);
            const float r0 = bflo(rr.x), r1 = bfhi(rr.x), r2 = bflo(rr.y), r3 = bfhi(rr.y);
            u32x2 w; w.x = pk2(o[dt][it][0] * rs * hw[0] * silu_f(r0), o[dt][it][1] * rs * hw[1] * silu_f(r1)); w.y = pk2(o[dt][it][2] * rs * hw[2] * silu_f(r2), o[dt][it][3] * rs * hw[3] * silu_f(r3));
            *(u32x2*)rp = w; }
    }
}
__device__ __forceinline__ void phase_gla_c(const Args& a, unsigned char* const ws_, float* const out_, LAS unsigned char* lds, int G, int bx, int wid, int lane) {
    bf16_t* P = (bf16_t*)(ws_ + WS_BIG);
    const bf16_t* SBP = (const bf16_t*)((unsigned char*)out_ + OS_SBUFP); const bf16_t* SBS = (const bf16_t*)(ws_ + WS_SBUFS);
    int par = 0;
    for (int it = bx; it < 1040 + 128; it += G, par ^= 1) {
        LAS unsigned char* abuf = lds + par * 16384; LAS float* red = (LAS float*)(lds + 32768 + par * 4096);
        if (it < 1040) { const int h = it & 3, c = (it >> 2) % NCH, b = it / 260, seq = b * 4 + h;
            gla_c_item<4>(abuf, red, P, c >= 1 ? SBP + (size_t)(seq * 64 + (c - 1)) * 32768 : nullptr, a.in[14], b * LPP + 64 * c, h, wid, lane);
        } else { const int j = it - 1040, h = j & 3, bs = j >> 2;
            gla_c_item<2>(abuf, red, P, SBS + (size_t)(bs * 4 + h) * 32768, a.in[14], ROWS_P + 32 * bs, h, wid, lane); }
    }
}

__device__ __forceinline__ void phase_mla_prep(const Args& a, unsigned char* const ws_, float* const out_, int gw, int NGW, int lane) {
    const float* DN = (const float*)((unsigned char*)out_ + OS_DN); bf16_t* KP = (bf16_t*)((unsigned char*)out_ + OS_KP);
    bf16_t* KS = (bf16_t*)(ws_ + WS_KS); bf16_t* CQB = (bf16_t*)(ws_ + WS_CQB); float* SSQ = (float*)(ws_ + WS_SS) + 7 * T;
    const f32x2* rt = (const f32x2*)(ws_ + WS_ROPE); const float* kvn = a.in[19];
    for (int row = gw; row < T; row += NGW) {
        const float* d = DN + (size_t)row * MDN_N;
        const f32x2 c0 = *(const f32x2*)(d + 6 * lane), c1 = *(const f32x2*)(d + 6 * lane + 2), c2 = *(const f32x2*)(d + 6 * lane + 4);
        const f32x4 kv = *(const f32x4*)(d + 384 + 4 * lane); const float kr = d[640 + lane];
        float sq = (c0.x * c0.x + c0.y * c0.y) + (c1.x * c1.x + c1.y * c1.y) + (c2.x * c2.x + c2.y * c2.y);
        float sk = (kv[0] * kv[0] + kv[1] * kv[1]) + (kv[2] * kv[2] + kv[3] * kv[3]);
        sq = wave_sum(sq); sk = wave_sum(sk);
        if (lane == 0) SSQ[row] = sq;
        unsigned* cq = (unsigned*)(CQB + (size_t)row * 384 + 6 * lane); cq[0] = pk2(c0.x, c0.y); cq[1] = pk2(c1.x, c1.y); cq[2] = pk2(c2.x, c2.y);
        const float rs = __builtin_amdgcn_rsqf(sk * (1.0f / 256.0f) + EPS); const f32x4 w = *(const f32x4*)(kvn + 4 * lane);
        const f32x4 lat = kv * rs * w;
        int pidx, valid; float* ol; float* orp; bf16_t* krow;
        if (row < ROWS_P) { const int b = row / LPP, p = row % LPP, t = p - 48; valid = p >= 48; pidx = valid ? t : 0;
            ol = out_ + OUT_LP + ((size_t)b * LP + pidx) * 256; orp = out_ + OUT_RP + ((size_t)b * LP + pidx) * 64; krow = KP + (size_t)row * KLD; }
        else { const int j = row - ROWS_P; valid = 1; pidx = LP + (j & 31); ol = out_ + OUT_LS + (size_t)j * 256; orp = out_ + OUT_RS + (size_t)j * 64; krow = KS + ((size_t)(j >> 5) * (PAST + SL) + PAST + (j & 31)) * KLD; }
        const float other = __shfl_xor(kr, 32); const f32x2 cs = rt[(size_t)pidx * 32 + (lane & 31)];
        const float ro = lane < 32 ? kr * cs.x - other * cs.y : kr * cs.x + other * cs.y;
        if (valid) { *(f32x4*)(ol + 4 * lane) = lat; orp[lane] = ro; }
        u32x2 lw; lw.x = pk2(lat[0], lat[1]); lw.y = pk2(lat[2], lat[3]); *(u32x2*)(krow + 4 * lane) = lw;
        krow[256 + lane] = (bf16_t)(pk2(ro, 0.f) & 0xffffu);
    }
    const float* clat = a.in[3]; const float* crope = a.in[4];
    for (int r = gw; r < SB * PAST + 32; r += NGW) {
        if (r < SB * PAST) { const int bs = r >> 11, k = r & (PAST - 1); bf16_t* kd = KS + ((size_t)bs * (PAST + SL) + k) * KLD;
            const f32x4 v = *(const f32x4*)(clat + (size_t)r * 256 + 4 * lane); const float rp = crope[(size_t)r * 64 + lane];
            u32x2 w; w.x = pk2(v[0], v[1]); w.y = pk2(v[2], v[3]); *(u32x2*)(kd + 4 * lane) = w; kd[256 + lane] = (bf16_t)(pk2(rp, 0.f) & 0xffffu);
        } else { bf16_t* kd = KS + ((size_t)SB * (PAST + SL) + (r - SB * PAST)) * KLD; *(u32x2*)(kd + 4 * lane) = (u32x2){0u, 0u}; kd[256 + lane] = 0; }
    }
}

constexpr int KROW = 640, KSTAGE = 64 * KROW;
__device__ __forceinline__ void glds16_asm(const void* gsrc, unsigned lds_dst) { unsigned keep;
    asm volatile("s_mov_b32 %0, m0\n\ts_mov_b32 m0, %2\n\ts_nop 0\n\tglobal_load_lds_dwordx4 %1, off\n\ts_mov_b32 m0, %0" : "=&s"(keep) : "v"(gsrc), "s"(lds_dst) : "memory"); }
__device__ __forceinline__ float xred_max(float v) {
    auto a = __builtin_amdgcn_permlane16_swap(__float_as_uint(v), __float_as_uint(v), false, false); v = fmaxf(__uint_as_float(a[0]), __uint_as_float(a[1]));
    auto b = __builtin_amdgcn_permlane32_swap(__float_as_uint(v), __float_as_uint(v), false, false); return fmaxf(__uint_as_float(b[0]), __uint_as_float(b[1]));
}
__device__ __forceinline__ float xred_sum(float v) {
    auto a = __builtin_amdgcn_permlane16_swap(__float_as_uint(v), __float_as_uint(v), false, false); v = __uint_as_float(a[0]) + __uint_as_float(a[1]);
    auto b = __builtin_amdgcn_permlane32_swap(__float_as_uint(v), __float_as_uint(v), false, false); return __uint_as_float(b[0]) + __uint_as_float(b[1]);
}
__device__ __forceinline__ void attn_unit(LAS unsigned char* lds, const bf16_t* Qb, const bf16_t* Kb, const bf16_t* WuvT, const f32x2* rope, bf16_t* Ob, int qrow0, int NT, int klo0, int khiL, int wid) {
    int lane; { int zz = 0; asm volatile("" : "+v"(zz)); lane = (int)__builtin_amdgcn_mbcnt_hi(~0u, __builtin_amdgcn_mbcnt_lo(~0u, 0u)) + zz; }
    const int fr = lane & 15, fq = lane >> 4, h = wid;
    bf16x8 qf[10];
    { const bf16_t* qp = Qb + (size_t)(qrow0 + fr) * QLD + h * 320 + 8 * fq;
#pragma unroll
      for (int s = 0; s < 10; ++s) qf[s] = *(const bf16x8*)(qp + 32 * s);
      const int row = qrow0 + fr; int pidx;
      if (row < ROWS_P) { const int p = row % LPP; pidx = p >= 48 ? p - 48 : 0; } else pidx = LP + ((row - ROWS_P) & 31);
      const f32x2* cs = rope + (size_t)pidx * 32 + 8 * fq;
      float o1[8], o2[8];
#pragma unroll
      for (int j = 0; j < 8; ++j) { const f32x2 c = cs[j]; const float x1 = bf2f((unsigned short)qf[8][j]), x2 = bf2f((unsigned short)qf[9][j]); o1[j] = x1 * c.x - x2 * c.y; o2[j] = x2 * c.x + x1 * c.y; }
      u32x4 w1, w2; w1.x = pk2(o1[0], o1[1]); w1.y = pk2(o1[2], o1[3]); w1.z = pk2(o1[4], o1[5]); w1.w = pk2(o1[6], o1[7]);
      w2.x = pk2(o2[0], o2[1]); w2.y = pk2(o2[2], o2[3]); w2.z = pk2(o2[4], o2[5]); w2.w = pk2(o2[6], o2[7]);
      qf[8] = __builtin_bit_cast(bf16x8, w1); qf[9] = __builtin_bit_cast(bf16x8, w2); }
    f32x4 o[16];
#pragma unroll
    for (int d = 0; d < 16; ++d) o[d] = (f32x4){0.f, 0.f, 0.f, 0.f};
    float mrun = -INFINITY, lsum = 0.f;
    int crow[5], cdat[5];
#pragma unroll
    for (int i = 0; i < 5; ++i) { const int pos = (8 * i + wid) * 64 + lane; crow[i] = pos / 40; cdat[i] = (pos % 40) ^ (crow[i] & 6); }
#define ATT_DMA(t, stg) do { const unsigned sb_ = (unsigned)__builtin_amdgcn_readfirstlane((int)(unsigned)(unsigned long)((stg) + wid * 1024)); _Pragma("unroll") for (int i = 0; i < 5; ++i) \
        glds16_asm(Kb + ((size_t)(64 * (t) + crow[i]) * KLD + cdat[i] * 8), sb_ + i * 8192); } while (0)
    const int f6 = fr & 6;
    const int kbe = fr * KROW + ((fq ^ (f6 & 2)) * 16) + ((f6 & 4) ? 64 : 0), kbo = fr * KROW + ((fq ^ (f6 & 2)) * 16) - ((f6 & 4) ? 64 : 0);
    const int vrow = 4 * fq + (fr >> 2), g2 = (vrow & 6) >> 1;
    int vbs[4];
#pragma unroll
    for (int e = 0; e < 4; ++e) vbs[e] = vrow * KROW + 32 * (e ^ g2) + 16 * ((fr >> 1) & 1) + 8 * (fr & 1);
    bf16x8 pf[2] = {(bf16x8){0, 0, 0, 0, 0, 0, 0, 0}, (bf16x8){0, 0, 0, 0, 0, 0, 0, 0}};
    auto qk_sm = [&](LAS unsigned char* stg, int klo, int khi, bool masked) {
        f32x4 st[4];
#pragma unroll
        for (int Tt = 0; Tt < 4; ++Tt) st[Tt] = (f32x4){0.f, 0.f, 0.f, 0.f};
        const LAS unsigned char* kE = stg + kbe; const LAS unsigned char* kO = stg + kbo;
        constexpr int KD = 3;
        bf16x8 kf[KD][4];
#define ATT_KLOAD(s) do { _Pragma("unroll") for (int Tt = 0; Tt < 4; ++Tt) kf[(s) % KD][Tt] = *(const LAS bf16x8*)((((s) & 1) ? kO : kE) + Tt * (16 * KROW) + (s) * 64); } while (0)
#pragma unroll
        for (int s = 0; s < KD - 1; ++s) ATT_KLOAD(s);
#pragma unroll
        for (int s = 0; s < 10; ++s) {
            if (s + KD - 1 < 10) ATT_KLOAD(s + KD - 1);
#pragma unroll
            for (int Tt = 0; Tt < 4; ++Tt) st[Tt] = mfma16(kf[s % KD][Tt], qf[s], st[Tt]);
            __builtin_amdgcn_sched_barrier(0);
        }
#undef ATT_KLOAD
        if (masked) {
#pragma unroll
            for (int Tt = 0; Tt < 4; ++Tt)
#pragma unroll
                for (int r = 0; r < 4; ++r) { const int kk = 16 * Tt + 4 * fq + r; if (kk < klo || kk >= khi) st[Tt][r] = -INFINITY; }
        }
        if (ATT_P1) {
            f32x4 s2[4];
#pragma unroll
            for (int Tt = 0; Tt < 4; ++Tt) { s2[Tt] = st[Tt]; asm volatile("" : "+v"(s2[Tt])); }
            float m2 = fmaxf(fmaxf(s2[0][0], s2[0][1]), fmaxf(s2[0][2], s2[0][3]));
#pragma unroll
            for (int Tt = 1; Tt < 4; ++Tt) m2 = fmaxf(m2, fmaxf(fmaxf(s2[Tt][0], s2[Tt][1]), fmaxf(s2[Tt][2], s2[Tt][3])));
            m2 = xred_max(m2); float p2 = 0.f;
#pragma unroll
            for (int Tt = 0; Tt < 4; ++Tt)
#pragma unroll
                for (int r = 0; r < 4; ++r) { s2[Tt][r] = fexp2(s2[Tt][r] - m2); p2 += s2[Tt][r]; }
            unsigned q2 = 0;
#pragma unroll
            for (int s = 0; s < 2; ++s) { q2 ^= pk2(s2[2 * s][0], s2[2 * s][1]) ^ pk2(s2[2 * s][2], s2[2 * s][3]) ^ pk2(s2[2 * s + 1][0], s2[2 * s + 1][1]) ^ pk2(s2[2 * s + 1][2], s2[2 * s + 1][3]); }
            asm volatile("" :: "v"(p2), "v"(q2));
        }
        float mx = fmaxf(fmaxf(st[0][0], st[0][1]), fmaxf(st[0][2], st[0][3]));
#pragma unroll
        for (int Tt = 1; Tt < 4; ++Tt) mx = fmaxf(mx, fmaxf(fmaxf(st[Tt][0], st[Tt][1]), fmaxf(st[Tt][2], st[Tt][3])));
        mx = xred_max(mx);
        if (__any(mx > mrun + 8.0f)) {
            const float mnew = fmaxf(mrun, mx), alpha = fexp2(mrun - mnew); mrun = mnew;
            lsum *= alpha;
#pragma unroll
            for (int d = 0; d < 16; ++d) o[d] = o[d] * alpha;
        }
        float ps = 0.f;
#pragma unroll
        for (int Tt = 0; Tt < 4; ++Tt)
#pragma unroll
            for (int r = 0; r < 4; ++r) { st[Tt][r] = fexp2(st[Tt][r] - mrun); ps += st[Tt][r]; }
        lsum += ps;
#pragma unroll
        for (int s = 0; s < 2; ++s) { u32x4 w; w.x = pk2(st[2 * s][0], st[2 * s][1]); w.y = pk2(st[2 * s][2], st[2 * s][3]); w.z = pk2(st[2 * s + 1][0], st[2 * s + 1][1]); w.w = pk2(st[2 * s + 1][2], st[2 * s + 1][3]); pf[s] = __builtin_bit_cast(bf16x8, w); }
    };
    auto pv = [&](LAS unsigned char* stg) {
        constexpr int VD = 4;
        s16x4 vl[VD], vh[VD];
#define ATT_VLOAD(p) do { const int d_ = (p) >> 1, s_ = (p) & 1; \
            vl[(p) % VD] = __builtin_bit_cast(s16x4, __builtin_amdgcn_ds_read_tr16_b64_v4i16((LAS s16x4*)(stg + vbs[d_ & 3] + (32 * s_) * KROW + (d_ >> 2) * 128))); \
            vh[(p) % VD] = __builtin_bit_cast(s16x4, __builtin_amdgcn_ds_read_tr16_b64_v4i16((LAS s16x4*)(stg + vbs[d_ & 3] + (32 * s_ + 16) * KROW + (d_ >> 2) * 128))); } while (0)
#pragma unroll
        for (int p = 0; p < VD; ++p) ATT_VLOAD(p);
#pragma unroll
        for (int p = 0; p < 32; ++p) {
            const s16x4 lo = vl[p % VD], hi = vh[p % VD];
            const bf16x8 vf = (bf16x8){lo[0], lo[1], lo[2], lo[3], hi[0], hi[1], hi[2], hi[3]};
            o[p >> 1] = mfma16(vf, pf[p & 1], o[p >> 1]);
            if (p + VD < 32) ATT_VLOAD(p + VD);
            __builtin_amdgcn_sched_barrier(0);
        }
#undef ATT_VLOAD
    };
    ATT_DMA(0, lds);
    if (NT > 1) { ATT_DMA(1, lds + KSTAGE); asm volatile("s_waitcnt vmcnt(5)" ::: "memory"); } else asm volatile("s_waitcnt vmcnt(0)" ::: "memory");
    __syncthreads();
    int sc = 0;
    for (int t = 0; t < NT; ++t) {
        const int sn = sc == 2 ? 0 : sc + 1, sp = sc == 0 ? 2 : sc - 1;
        const bool more = t + 2 < NT;
        if (more) ATT_DMA(t + 2, lds + sp * KSTAGE);
        const bool msk = (t == 0 && klo0 > 0) || (t == NT - 1 && khiL < 64);
        const int klo = t == 0 ? klo0 : 0, khi = t == NT - 1 ? khiL : 64;
        qk_sm(lds + sc * KSTAGE, klo, khi, msk);
        pv(lds + sc * KSTAGE);
        if (more) asm volatile("s_waitcnt vmcnt(5)" ::: "memory"); else asm volatile("s_waitcnt vmcnt(0)" ::: "memory");
        __syncthreads();
        sc = sn;
    }
#undef ATT_DMA
    lsum = xred_sum(lsum);
    const float inv = frcp(lsum);
    bf16x8 bfr[8];
#pragma unroll
    for (int s = 0; s < 8; ++s) { u32x4 w; w.x = pk2(o[2 * s][0] * inv, o[2 * s][1] * inv); w.y = pk2(o[2 * s][2] * inv, o[2 * s][3] * inv); w.z = pk2(o[2 * s + 1][0] * inv, o[2 * s + 1][1] * inv); w.w = pk2(o[2 * s + 1][2] * inv, o[2 * s + 1][3] * inv); bfr[s] = __builtin_bit_cast(bf16x8, w); }
    const bf16_t* wu = WuvT + (size_t)h * 32768 + lane * 8;
    bf16_t* op = Ob + (size_t)(qrow0 + fr) * DM + h * 128 + 4 * fq;
    bf16x8 wa[2][16];
#define EP_LOAD(g) do { _Pragma("unroll") for (int i = 0; i < 16; ++i) wa[(g) & 1][i] = *(const bf16x8*)(wu + ((g) * 16 + i) * 512); } while (0)
#define EP_COMP(g) do { _Pragma("unroll") for (int vv = 0; vv < 2; ++vv) { f32x4 acc = (f32x4){0.f, 0.f, 0.f, 0.f}; \
        _Pragma("unroll") for (int s = 0; s < 8; ++s) acc = mfma16(wa[(g) & 1][vv * 8 + s], bfr[s], acc); \
        u32x2 w; w.x = pk2(acc[0], acc[1]); w.y = pk2(acc[2], acc[3]); *(u32x2*)(op + 16 * (2 * (g) + vv)) = w; } } while (0)
    EP_LOAD(0); EP_LOAD(1); __builtin_amdgcn_sched_barrier(0);
    EP_COMP(0); __builtin_amdgcn_sched_barrier(0); EP_LOAD(2); __builtin_amdgcn_sched_barrier(0);
    EP_COMP(1); __builtin_amdgcn_sched_barrier(0); EP_LOAD(3); __builtin_amdgcn_sched_barrier(0);
    EP_COMP(2); __builtin_amdgcn_sched_barrier(0); EP_COMP(3);
#undef EP_LOAD
#undef EP_COMP
}
__device__ __forceinline__ void phase_attn(const Args& a, unsigned char* const ws_, float* const out_, LAS unsigned char* lds, int G, int bx, int tid, int wid, int lane) {
    const bf16_t* Qb = (const bf16_t*)(ws_ + WS_BIG); const bf16_t* KP = (const bf16_t*)((unsigned char*)out_ + OS_KP); const bf16_t* KS = (const bf16_t*)(ws_ + WS_KS);
    const bf16_t* WU = (const bf16_t*)(ws_ + WS_WUVT); bf16_t* Ob = (bf16_t*)((unsigned char*)out_ + OS_DN);
    for (int rd = 0;; ++rd) {
        const int j = (rd & 1) ? (rd + 1) * G - 1 - bx : rd * G + bx;
        if (rd * G >= 1092) break;
        if (j >= 1092) continue;
        const bf16_t* Kb; int qrow0, NT, klo0, khiL;
        if (j >= 512 && j < 576) { const int s = j - 512, bs = s >> 1, half = s & 1; Kb = KS + (size_t)bs * (PAST + SL) * KLD; qrow0 = ROWS_P + 32 * bs + 16 * half; NT = 33; klo0 = 0; khiL = 32; }
        else {
            int b, m, qt;
            if (j < 512) { m = 64 - (j >> 4); b = (j & 15) >> 2; qt = j & 3; }
            else if (j < 1088) { const int jj = j - 576; m = 32 - (jj >> 4); b = (jj & 15) >> 2; qt = jj & 3; }
            else { m = 0; b = j - 1088; qt = 3; }
            Kb = KP + (size_t)b * LPP * KLD; qrow0 = b * LPP + 64 * m + 16 * qt; NT = m + 1; klo0 = 48; khiL = 64;
        }
        attn_unit(lds, Qb, Kb, WU, (const f32x2*)(ws_ + WS_ROPE), Ob, qrow0, NT, klo0, khiL, wid);
    }
}

__device__ __forceinline__ void phase_final(const Args& a, unsigned char* const ws_, float* const out_, int gw, int NGW, int lane) {
    const float* H = (const float*)(ws_ + WS_H); const float* SS = (const float*)(ws_ + WS_SS) + 6 * T; const float* fn = a.in[27];
    for (int row = gw; row < T; row += NGW) {
        float* dst;
        if (row < ROWS_P) { const int b = row / LPP, p = row % LPP; if (p < 64) continue; dst = out_ + OUT_YP + ((size_t)b * SEQ + (p - 64)) * DM; }
        else dst = out_ + OUT_YS + (size_t)(row - ROWS_P) * DM;
        const float rs = __builtin_amdgcn_rsqf(SS[row] * (1.0f / DM) + EPS);
#pragma unroll
        for (int j = 0; j < 4; ++j) { f32x4 v; const f32x4 w = *(const f32x4*)(fn + 256 * j + 4 * lane);
            if (RESID_BF16) { const u32x2 hv = *(const u32x2*)((const bf16_t*)(ws_ + WS_HB) + (size_t)row * DM + 256 * j + 4 * lane); v = (f32x4){bflo(hv.x), bfhi(hv.x), bflo(hv.y), bfhi(hv.y)}; }
            else v = *(const f32x4*)(H + (size_t)row * DM + 256 * j + 4 * lane);
            *(f32x4*)(dst + 256 * j + 4 * lane) = v * rs * w; }
    }
}

__device__ __forceinline__ void resid_fix(const pg8::SplitOrder& S, float* H, bf16_t* HB, float* ssn, float scale, const unsigned char* part, int gw, int NGW, int lane) {
    if (S.S <= 1) return;
    const int nitem = S.rem * 128, fr = lane & 15, fq = lane >> 4;
    for (int it = gw; it < nitem; it += NGW) {
        const int j = it >> 7, q = it & 127, w = q >> 4, ai = (q >> 3) & 1, m = (q >> 1) & 3, bj = q & 1; int pm, pn; S.tile(S.full * S.G + j, pm, pn);
        const unsigned char* p = part + (size_t)(j * S.S) * 131072 + (size_t)q * 1024 + lane * 16;
        f32x4 a0 = {0.f, 0.f, 0.f, 0.f}, a1 = {0.f, 0.f, 0.f, 0.f};
#define RF_ACC(v) do { a0[0] += bflo(v.x); a0[1] += bfhi(v.x); a0[2] += bflo(v.y); a0[3] += bfhi(v.y); a1[0] += bflo(v.z); a1[1] += bfhi(v.z); a1[2] += bflo(v.w); a1[3] += bfhi(v.w); } while (0)
        int s = 0;
        for (; s + 4 <= S.S; s += 4) { const u32x4 x0 = *(const u32x4*)(p + (size_t)s * 131072), x1 = *(const u32x4*)(p + (size_t)(s + 1) * 131072), x2 = *(const u32x4*)(p + (size_t)(s + 2) * 131072), x3 = *(const u32x4*)(p + (size_t)(s + 3) * 131072);
            RF_ACC(x0); RF_ACC(x1); RF_ACC(x2); RF_ACC(x3); }
        for (; s < S.S; ++s) { const u32x4 x0 = *(const u32x4*)(p + (size_t)s * 131072); RF_ACC(x0); }
#undef RF_ACC
        const int row = pm * 256 + ai * 128 + (w >> 2) * 64 + m * 16 + fr;
        const size_t off = (size_t)row * DM + pn * 256 + bj * 128 + (w & 3) * 32 + 4 * fq;
        f32x4 v0, v1;
        if (RESID_BF16) { const u32x2 h0 = *(const u32x2*)(HB + off), h1 = *(const u32x2*)(HB + off + 16);
            v0 = (f32x4){bflo(h0.x), bfhi(h0.x), bflo(h0.y), bfhi(h0.y)} + a0 * scale; v1 = (f32x4){bflo(h1.x), bfhi(h1.x), bflo(h1.y), bfhi(h1.y)} + a1 * scale; }
        else { v0 = *(const f32x4*)(H + off) + a0 * scale; v1 = *(const f32x4*)(H + off + 16) + a1 * scale; *(f32x4*)(H + off) = v0; *(f32x4*)(H + off + 16) = v1; }
        u32x2 w0; w0.x = pk2(v0[0], v0[1]); w0.y = pk2(v0[2], v0[3]); *(u32x2*)(HB + off) = w0;
        u32x2 w1; w1.x = pk2(v1[0], v1[1]); w1.y = pk2(v1[2], v1[3]); *(u32x2*)(HB + off + 16) = w1;
        float sq = ((v0[0] * v0[0] + v0[1] * v0[1]) + (v0[2] * v0[2] + v0[3] * v0[3])) + ((v1[0] * v1[0] + v1[1] * v1[1]) + (v1[2] * v1[2] + v1[3] * v1[3]));
        sq += __shfl_xor(sq, 16); sq += __shfl_xor(sq, 32);
        if (fq == 0) atomicAdd(ssn + row, sq);
    }
}

constexpr int NPHASE = 20;
constexpr int LDS_BYTES = 147456;
__global__ void __launch_bounds__(512, 2) mk_fwd(Args args0) {
    __shared__ __attribute__((aligned(16))) unsigned char lds_raw[LDS_BYTES];
    LAS unsigned char* lds = (LAS unsigned char*)lds_raw;
    const int tid0 = threadIdx.x; const int wave0 = __builtin_amdgcn_readfirstlane(tid0 >> 6);
    const int G0 = gridDim.x, bx0 = blockIdx.x;
    unsigned char* ws0 = args0.ws;
    volatile LAS unsigned* MISC = (volatile LAS unsigned*)(lds + 131072 + 8192);
    if (tid0 < 16) MISC[tid0] = 0u;
    __syncthreads();
    XcdBarrier bar; bar.bar = (unsigned*)(ws0 + WS_CTL) + CW_BAR; bar.x = 0; bar.st = nullptr;
    const bool one_launch = (args0.ph_hi - args0.ph_lo) > 1;
    if (one_launch) bar = xcd_barrier_post((unsigned*)(ws0 + WS_CTL) + CW_BAR, MISC + 8);

    const int nsteps = (args0.ph_hi - args0.ph_lo) + (one_launch ? __builtin_popcount(DUP_MASK) : 0);
    for (int step = 0; step < nsteps; ++step) {
        int ph = args0.ph_lo + step;
        if (DUP_MASK != 0u && one_launch) { int p = 0, accn = 0; for (;;) { const int cnt = 1 + (int)((DUP_MASK >> p) & 1u); if (step < accn + cnt) break; accn += cnt; ++p; } ph = p; }
        long z = 0; int bx = bx0, G = G0;
        asm volatile("" : "+s"(z), "+s"(bx), "+s"(G));
        const int NGW = G * 8;
        unsigned char* ws = ws0 + z; float* outp = args0.out + z;
        int lane = (int)__builtin_amdgcn_mbcnt_hi(~0u, __builtin_amdgcn_mbcnt_lo(~0u, 0u)) + (int)z;
        const int wave = wave0, tid = wave * 64 + lane;
        const int vcu = (G % 8 == 0) ? (bx % 8) * (G / 8) + bx / 8 : bx, gw = vcu * 8 + wave;
        float* SS = (float*)(ws + WS_SS);
        float* H = (float*)(ws + WS_H); bf16_t* HB = (bf16_t*)(ws + WS_HB); bf16_t* BIG = (bf16_t*)(ws + WS_BIG);
        switch (ph) {
        case 0: phase_prep(args0, ws, outp, lds, gw, NGW, wave, lane); break;
        case 1: case 8: case 10: case 17: {
            const int fi = ph == 1 ? 0 : ph == 8 ? 1 : ph == 10 ? 2 : 3;
            const int ssi = ph == 1 ? 0 : ph == 8 ? 2 : ph == 10 ? 3 : 5;
            pg8::Gemm g{HB, (const bf16_t*)(ws + ws_wup(fi)), T, 5632, DM, DM};
            pg8::StaticOrder S; S.init(T, 5632, G, bx);
            pg8::EpiSwiglu E{BIG, SS + (size_t)ssi * T};
            pg8::gemm_phase<pg8::EpiSwiglu, pg8::StaticOrder, true>(lds, g, S, E, tid);
        } break;
        case 2: case 9: case 11: case 18: case 7: case 16: {
            const bf16_t* A; const bf16_t* Bt; int K, lda, sso; float scale;
            if (ph == 7) { A = BIG + 2048; lda = GIN_LD; K = DM; Bt = (const bf16_t*)(ws + WS_WGOUT); sso = 2; scale = 1.0f; }
            else if (ph == 16) { A = (const bf16_t*)((unsigned char*)outp + OS_DN); lda = DM; K = DM; Bt = (const bf16_t*)(ws + WS_WMOUT); sso = 5; scale = 1.0f; }
            else { const int fi = ph == 2 ? 0 : ph == 9 ? 1 : ph == 11 ? 2 : 3; A = BIG; lda = DFF; K = DFF; Bt = (const bf16_t*)(ws + ws_wdn(fi)); sso = ph == 2 ? 1 : ph == 9 ? 3 : ph == 11 ? 4 : 6; scale = 0.5f; }
            unsigned char* part = ph == 16 ? (unsigned char*)BIG : (unsigned char*)outp;
            pg8::Gemm g{A, Bt, T, DM, K, lda};
            pg8::SplitOrder S; S.init(T, DM, K, G, bx);
            unsigned* cnt = (unsigned*)(ws + WS_CTL) + CW_SPLIT + ph;
            pg8::EpiResid E{H, HB, SS + (size_t)sso * T, scale, part, cnt};
            pg8::gemm_phase<pg8::EpiResid, pg8::SplitOrder, true>(lds, g, S, E, tid);
            if (S.S > 1) {
                if (tid == 0) { const unsigned need = (unsigned)(S.rem * S.S); unsigned sp = 0;
                    while (__hip_atomic_load(cnt, __ATOMIC_RELAXED, __HIP_MEMORY_SCOPE_AGENT) < need) { __builtin_amdgcn_s_sleep(2); if (++sp > (1u << 22)) break; }
                    __builtin_amdgcn_fence(__ATOMIC_ACQUIRE, "agent"); }
                __syncthreads();
                resid_fix(S, H, HB, SS + (size_t)sso * T, scale, part, gw, NGW, lane);
            }
        } break;
        case 3: {
            pg8::Gemm g{HB, (const bf16_t*)(ws + WS_WGIN), T, GIN_N, DM, DM};
            pg8::StaticOrder S; S.init(T, GIN_N, G, bx);
            pg8::EpiScaleBf16 E{BIG, GIN_LD, SS + (size_t)1 * T};
            pg8::gemm_phase<pg8::EpiScaleBf16, pg8::StaticOrder, true>(lds, g, S, E, tid);
        } break;
        case 4: phase_gla_a(args0, ws, outp, lds, G, bx, tid); break;
        case 5: phase_gla_b(args0, ws, outp, lds, G, vcu, gw, NGW, wave, lane); break;
        case 6: phase_gla_c(args0, ws, outp, lds, G, bx, wave, lane); break;
        case 12: {
            pg8::Gemm g{HB, (const bf16_t*)(ws + WS_WMDN), T, MDN_N, DM, DM};
            pg8::StaticOrder S; S.init(T, MDN_N, G, bx);
            pg8::EpiScaleF32 E{(float*)((unsigned char*)outp + OS_DN), MDN_N, SS + (size_t)4 * T};
            pg8::gemm_phase<pg8::EpiScaleF32, pg8::StaticOrder, true>(lds, g, S, E, tid);
        } break;
        case 13: phase_mla_prep(args0, ws, outp, gw, NGW, lane); break;
        case 14: {
            pg8::Gemm g{(const bf16_t*)(ws + WS_CQB), (const bf16_t*)(ws + WS_WQ), T, QN, 384, 384};
            pg8::StaticOrder S; S.init(T, QN, G, bx);
            pg8::EpiQ E{BIG, SS + (size_t)7 * T, 0.07216878364870322f * LOG2E};
            pg8::gemm_phase<pg8::EpiQ, pg8::StaticOrder, true>(lds, g, S, E, tid);
        } break;
        case 15: phase_attn(args0, ws, outp, lds, G, bx, tid, wave, lane); break;
        case 19: phase_final(args0, ws, outp, gw, NGW, lane); break;
        default: break;
        }
        if (step + 1 < nsteps) xcd_barrier(bar);
    }
}

extern "C" void kernel_launch(void* const* d_in, const int* in_sizes, int n_in, void* d_out, int out_size, void* d_ws, size_t ws_size, hipStream_t stream) {
    static int grid = 0;
    if (grid == 0) {
        if (n_in != 28 || out_size != (int)OUT_END || ws_size < WS_END) { fprintf(stderr, "kernel_launch: unexpected sizes n_in %d out %d ws %zu (need %zu)\n", n_in, out_size, ws_size, (size_t)WS_END); grid = -1; return; }
        int dev = 0, cus = 0;
        if (hipGetDevice(&dev) != hipSuccess || hipDeviceGetAttribute(&cus, hipDeviceAttributeMultiprocessorCount, dev) != hipSuccess || cus < 8) { fprintf(stderr, "kernel_launch: device query failed\n"); grid = -1; return; }
        grid = cus;
    }
    if (grid < 0) return;
    (void)hipMemsetAsync((char*)d_ws + WS_CTL, 0, CTL_ZERO_BYTES, stream);
    Args a{};
    for (int i = 0; i < 28; ++i) a.in[i] = (const float*)d_in[i];
    a.out = (float*)d_out; a.ws = (unsigned char*)d_ws;
#if MK_N_LAUNCHES == 1
    a.ph_lo = 0; a.ph_hi = NPHASE;
    hipLaunchKernelGGL(mk_fwd, dim3(grid), dim3(512), 0, stream, a);
#else
    for (int p = 0; p < NPHASE; ++p) { a.ph_lo = p; a.ph_hi = p + 1; hipLaunchKernelGGL(mk_fwd, dim3(grid), dim3(512), 0, stream, a); }
#endif
}
```

```cpp
#include <hip/hip_runtime.h>
#include <cstdio>
#include <cstdint>

#ifndef MK_N_LAUNCHES
#define MK_N_LAUNCHES 1
#endif

#ifndef GB_P1
#define GB_P1 0
#endif
#ifndef GB_P2
#define GB_P2 0
#endif
#ifndef ATT_P1
#define ATT_P1 0
#endif
#ifndef ATT_P2
#define ATT_P2 0
#endif
#ifndef ATT_P3
#define ATT_P3 0
#endif
#ifndef ATT_PROBEBASE
#define ATT_PROBEBASE 0
#endif
#ifndef ATT_DUPQK
#define ATT_DUPQK 0
#endif
#ifndef ATT_DUPPV
#define ATT_DUPPV 0
#endif
#ifndef RESID_BF16
#define RESID_BF16 1
#endif
#ifndef DUP_MASK
#define DUP_MASK 0u
#endif

#define LAS __attribute__((address_space(3)))
#define GAS __attribute__((address_space(1)))
typedef unsigned short bf16_t;
typedef short bf16x8 __attribute__((ext_vector_type(8)));
typedef short s16x4 __attribute__((ext_vector_type(4)));
typedef float f32x4 __attribute__((ext_vector_type(4)));
typedef float f32x2 __attribute__((ext_vector_type(2)));
typedef unsigned u32x4 __attribute__((ext_vector_type(4)));
typedef unsigned u32x2 __attribute__((ext_vector_type(2)));
typedef __bf16 bf16x2_t __attribute__((ext_vector_type(2)));

constexpr int DM = 1024, DFF = 2816, NB = 4, SEQ = 4096, NMETA = 16, LP = 4112, LPP = 4160, NCH = 65;
constexpr int SB = 32, SL = 32, PAST = 2048;
constexpr int ROWS_P = NB * LPP;
constexpr int T = ROWS_P + SB * SL;
constexpr int GIN_N = 3328, GIN_LD = 3328;
constexpr int MDN_N = 768;
constexpr int QN = 2560, QLD = 2560;
constexpr int KLD = 320;
constexpr float EPS = 1e-6f;
constexpr float LOG2E = 1.4426950408889634f;

constexpr size_t OUT_YP = 0, OUT_YS = 16777216, OUT_GP = 17825792, OUT_GS = 18350080, OUT_LP = 22544384, OUT_RP = 26755072, OUT_LS = 27807744, OUT_RS = 28069888, OUT_END = 28135424;
constexpr size_t MiB = 1u << 20;
constexpr size_t OS_SBUFP = 0;
constexpr size_t OS_DN = 0;
constexpr size_t OS_KP = 52 * MiB;

constexpr size_t WS_CTL = 0, CTL_ZERO_BYTES = 1 * MiB;
constexpr size_t WS_SS = 256 * 1024;
constexpr size_t WS_L0 = 1 * MiB;
constexpr size_t WS_KS = WS_L0;
constexpr size_t WS_WGIN = WS_L0 + 33 * MiB;
constexpr size_t WS_WGOUT = WS_WGIN + 6 * MiB + 512 * 1024;
constexpr size_t WS_L1 = 43 * MiB;
constexpr size_t WS_WMDN = WS_L1 + 33 * MiB;
constexpr size_t WS_WMOUT = WS_WMDN + 1 * MiB + 512 * 1024;
constexpr size_t WS_WQ = WS_WMOUT + 2 * MiB;
constexpr size_t WS_WUVT = WS_WQ + 2 * MiB;
constexpr size_t WS_ROPE = WS_WUVT + 512 * 1024;
constexpr size_t WS_DEC = WS_ROPE + 1 * MiB + 256 * 1024;
constexpr size_t WS_SBUFS = WS_DEC + 1 * MiB;
__host__ __device__ constexpr size_t ws_wup(int fi) { return (fi < 2 ? WS_L0 : WS_L1) + (size_t)(fi & 1) * 11 * MiB; }
__host__ __device__ constexpr size_t ws_wdn(int fi) { return (fi < 2 ? WS_L0 : WS_L1) + 22 * MiB + (size_t)(fi & 1) * (5 * MiB + 512 * 1024); }
static_assert((size_t)(SB * (PAST + SL) + 32) * KLD * 2 <= 41 * MiB + 512 * 1024, "KS fits the layer-0 weight block");
constexpr size_t WS_H = WS_SBUFS + 8 * MiB;
constexpr size_t WS_HB = WS_H + 69 * MiB;
constexpr size_t WS_BIG = WS_HB + 34 * MiB + 512 * 1024;
constexpr size_t WS_CQB = WS_BIG + 87 * MiB;
constexpr size_t WS_END = WS_BIG + 112 * MiB + 128 * 1024;
static_assert(WS_CQB + 13 * MiB <= WS_END, "ws map");
static_assert((size_t)T * QLD * 2 <= 87 * MiB, "Q fits");

constexpr int CW_BAR = 4096;
constexpr int CW_SPLIT = 8192;

__device__ __forceinline__ unsigned pk2(float lo, float hi) { f32x2 v = {lo, hi}; bf16x2_t b = __builtin_convertvector(v, bf16x2_t); return __builtin_bit_cast(unsigned, b); }
__device__ __forceinline__ float bf2f(unsigned short x) { return __uint_as_float((unsigned)x << 16); }
__device__ __forceinline__ float bflo(unsigned x) { return __uint_as_float(x << 16); }
__device__ __forceinline__ float bfhi(unsigned x) { return __uint_as_float(x & 0xffff0000u); }
__device__ __forceinline__ float wave_sum(float v) {
#pragma unroll
    for (int o = 1; o < 64; o <<= 1) v += __shfl_xor(v, o);
    return v;
}
__device__ __forceinline__ float fexp2(float x) { return __builtin_amdgcn_exp2f(x); }
__device__ __forceinline__ float frcp(float x) { return __builtin_amdgcn_rcpf(x); }
__device__ __forceinline__ float silu_f(float g) { return g * frcp(1.0f + fexp2(-g * LOG2E)); }
__device__ __forceinline__ f32x4 mfma16(bf16x8 a, bf16x8 b, f32x4 c) { return __builtin_amdgcn_mfma_f32_16x16x32_bf16(a, b, c, 0, 0, 0); }

namespace pg8 {
constexpr int BM = 256, BK = 64, HALF = 128, HTB = HALF * BK * 2, STAGE_BYTES = 8 * HTB, NXCD = 8, WGM = 8;
__host__ __device__ __forceinline__ int lds_byte(int r, int c) { const int st = (r >> 4) * 2 + (c >> 5), rr = r & 15, cc = c & 31, ob = rr * 64 + cc * 2; return st * 1024 + (ob ^ (((ob >> 9) & 1) << 5)); }
__host__ __device__ __forceinline__ void stage_rc(int b, int& R, int& C) { const int st = b / 1024, sb = b % 1024, swz = sb ^ (((sb >> 9) & 1) << 5); R = (st >> 1) * 16 + swz / 64; C = (st & 1) * 32 + (swz % 64) / 2; }
__host__ __device__ __forceinline__ int perm32(int rho) { const int n = rho >> 4, i = rho & 15; return 8 * (i >> 2) + 4 * n + (i & 3); }

struct Unit { int pm, pn, k0, nt, part; };
struct Gemm { const bf16_t* A; const bf16_t* Bt; int M, N, K, lda; };

struct StaticOrder {
    static constexpr bool SPLIT = false;
    int nM, nN, nwg, G, c;
    __device__ void init(int M, int N, int G_, int c_) { nM = M / BM; nN = N / BM; nwg = nM * nN; G = G_; c = c_; }
    __device__ bool next(int i, Unit& u) const {
        const long L = (long)i * G + c; if (L >= nwg) return false;
        int wgid = (int)L; { const int q = nwg / NXCD, r = nwg % NXCD, xcd = wgid % NXCD, off = wgid / NXCD; wgid = (xcd < r ? xcd * (q + 1) : r * (q + 1) + (xcd - r) * q) + off; }
        const int nig = WGM * nN, gid = wgid / nig, fm = gid * WGM, gsz = (nM - fm) < WGM ? (nM - fm) : WGM;
        u.pm = fm + ((wgid % nig) % gsz); u.pn = (wgid % nig) / gsz; return true;
    }
};

struct SplitOrder {
    static constexpr bool SPLIT = true;
    int nM, nN, nwg, G, c, full, rem, S, ntf, per;
    __device__ void init(int M, int N, int K, int G_, int c_) {
        nM = M / BM; nN = N / BM; nwg = nM * nN; G = G_; c = c_; full = nwg / G; rem = nwg % G; ntf = K / BK; S = 1;
        if (rem > 0) { const int pairs = ntf / 2, lim = G / rem; for (int d = 2; d <= pairs && d <= lim; ++d) if (pairs % d == 0) S = d; }
        per = ntf / S;
    }
    __device__ void tile(int L, int& pm, int& pn) const {
        int wgid = L; { const int q = nwg / NXCD, r = nwg % NXCD, xcd = wgid % NXCD, off = wgid / NXCD; wgid = (xcd < r ? xcd * (q + 1) : r * (q + 1) + (xcd - r) * q) + off; }
        const int nig = WGM * nN, gid = wgid / nig, fm = gid * WGM, gsz = (nM - fm) < WGM ? (nM - fm) : WGM;
        pm = fm + ((wgid % nig) % gsz); pn = (wgid % nig) / gsz;
    }
    __device__ bool next(int i, Unit& u) const {
        int r = i;
        if (S > 1 && c < rem * S) {
            if (i == 0) { const int j = c / S, s = c - j * S; tile(full * G + j, u.pm, u.pn); u.k0 = s * per; u.nt = per; u.part = c; return true; }
            r = i - 1;
        }
        if (r < full) { tile(r * G + c, u.pm, u.pn); u.k0 = 0; u.nt = ntf; u.part = -1; return true; }
        if (S == 1 && r == full && c < rem) { tile(full * G + c, u.pm, u.pn); u.k0 = 0; u.nt = ntf; u.part = -1; return true; }
        return false;
    }
};

template <class Epi, class Sched, bool ALIGN_EPI>
__device__ __forceinline__ void gemm_phase(LAS unsigned char* lds, const Gemm g, const Sched& S, const Epi& E, const int tid) {
    const int wid = __builtin_amdgcn_readfirstlane(tid >> 6), lane = tid & 63, wr = wid >> 2, wc = wid & 3, fr = lane & 15, fq = lane >> 4;
    int K_ = g.K, lda_ = g.lda; asm volatile("" : "+s"(K_), "+s"(lda_));
    const int K = K_, lda = lda_, nt = K / BK;
    unsigned voffA[2], voffB[2];
#pragma unroll
    for (int i = 0; i < 2; ++i) { int R, C; stage_rc(tid * 16 + i * 8192, R, C); const int Rb = Epi::PERM ? ((R & ~31) + perm32(R & 31)) : R;
        voffA[i] = (unsigned)(R * lda + C) * 2u; voffB[i] = (unsigned)(Rb * K + C) * 2u; }
    const size_t kstep = (size_t)(BK * 2);
    const size_t hstepA = (size_t)HALF * lda * 2, hstepB = (size_t)HALF * K * 2;
    const size_t tstepA = 2 * hstepA, tstepB = 2 * hstepB;
    const unsigned ldsw = (unsigned)wid * 1024u;
    const int aoff = lds_byte(wr * 64 + fr, fq * 8), boff = lds_byte(wc * 32 + fr, fq * 8);
#define PG8_SA(b, h) (((b) * 2 + (h)) * HTB)
#define PG8_SB(b, h) ((4 + (b) * 2 + (h)) * HTB)
#define PG8_STAGE(bufoff, gbase, voff) do { _Pragma("unroll") for (int _i = 0; _i < 2; ++_i) \
        __builtin_amdgcn_global_load_lds((const unsigned*)((const char*)(gbase) + (voff)[_i]), (LAS unsigned*)(lds + (bufoff) + ldsw + _i * 8192), 16, 0, 0); } while (0)
#define PG8_LDA(dst, b, h) do { _Pragma("unroll") for (int m = 0; m < 4; ++m) _Pragma("unroll") for (int k = 0; k < 2; ++k) dst[m][k] = *(const LAS bf16x8*)(lds + PG8_SA(b, h) + aoff + m * 2048 + k * 1024); } while (0)
#define PG8_LDB(dst, b, h) do { _Pragma("unroll") for (int n = 0; n < 2; ++n) _Pragma("unroll") for (int k = 0; k < 2; ++k) dst[n][k] = *(const LAS bf16x8*)(lds + PG8_SB(b, h) + boff + n * 2048 + k * 1024); } while (0)
#define PG8_MMA(ai, bj, At, Bt) do { __builtin_amdgcn_s_setprio(1); _Pragma("unroll") for (int m = 0; m < 4; ++m) _Pragma("unroll") for (int n = 0; n < 2; ++n) _Pragma("unroll") for (int k = 0; k < 2; ++k) \
        acc[ai][bj][m][n] = __builtin_amdgcn_mfma_f32_16x16x32_bf16(Bt[n][k], At[m][k], acc[ai][bj][m][n], 0, 0, 0); __builtin_amdgcn_s_setprio(0); } while (0)
#define PG8_WAIT_V(n) asm volatile("s_waitcnt vmcnt(" #n ")" ::: "memory")
#define PG8_WAIT_L(n) asm volatile("s_waitcnt lgkmcnt(" #n ")" ::: "memory")
#define PG8_BAR __builtin_amdgcn_s_barrier()
#define PG8_SCHED __builtin_amdgcn_sched_barrier(0)
    Unit cur, nxt; int ui = 0;
    if (!S.next(0, cur)) return;
    f32x4 acc[2][2][4][2];
#pragma unroll
    for (int a = 0; a < 2; ++a)
#pragma unroll
        for (int b = 0; b < 2; ++b)
#pragma unroll
            for (int m = 0; m < 4; ++m)
#pragma unroll
                for (int n = 0; n < 2; ++n) acc[a][b][m][n] = (f32x4){0.f, 0.f, 0.f, 0.f};
    bf16x8 At[4][2], B0[2][2], B1[2][2];
    const char* cA = (const char*)g.A + (size_t)cur.pm * tstepA; const char* cB = (const char*)g.Bt + (size_t)cur.pn * tstepB;
    int ntc = nt;
    if constexpr (Sched::SPLIT) { cA += (size_t)cur.k0 * kstep; cB += (size_t)cur.k0 * kstep; ntc = cur.nt; }
    PG8_STAGE(PG8_SB(0, 0), cB, voffB); PG8_STAGE(PG8_SB(0, 1), cB + hstepB, voffB); PG8_STAGE(PG8_SA(0, 0), cA, voffA); PG8_STAGE(PG8_SA(0, 1), cA + hstepA, voffA);
    if (wr == 1) PG8_BAR;
    PG8_WAIT_V(2); PG8_BAR;
    PG8_STAGE(PG8_SB(1, 0), cB + kstep, voffB); PG8_STAGE(PG8_SA(1, 0), cA + kstep, voffA); PG8_STAGE(PG8_SB(1, 1), cB + hstepB + kstep, voffB);
    PG8_WAIT_V(6); PG8_BAR;
    for (;;) {
        const bool has_next = S.next(ui + 1, nxt);
        const char* nA = has_next ? (const char*)g.A + (size_t)nxt.pm * tstepA : cA; const char* nB = has_next ? (const char*)g.Bt + (size_t)nxt.pn * tstepB : cB;
        if constexpr (Sched::SPLIT) { if (has_next) { nA += (size_t)nxt.k0 * kstep; nB += (size_t)nxt.k0 * kstep; } }
        for (int t = 0; t < ntc; t += 2) {
            const bool last = (t == ntc - 2);
            const char* a1 = cA + (size_t)(t + 1) * kstep;
            const char* a2 = last ? nA : cA + (size_t)(t + 2) * kstep; const char* b2 = last ? nB : cB + (size_t)(t + 2) * kstep;
            const char* a3 = a2 + kstep; const char* b3 = b2 + kstep;
            PG8_LDB(B0, 0, 0); PG8_LDB(B1, 0, 1); PG8_SCHED; PG8_LDA(At, 0, 0); PG8_STAGE(PG8_SA(1, 1), a1 + hstepA, voffA);
            PG8_WAIT_V(8); PG8_WAIT_L(0); PG8_BAR; PG8_MMA(0, 0, At, B0); PG8_MMA(0, 1, At, B1); PG8_BAR; PG8_SCHED;
            PG8_LDA(At, 0, 1); PG8_STAGE(PG8_SB(0, 0), b2, voffB); PG8_STAGE(PG8_SB(0, 1), b2 + hstepB, voffB); PG8_STAGE(PG8_SA(0, 0), a2, voffA);
            PG8_WAIT_V(8); PG8_WAIT_L(0); PG8_BAR; PG8_MMA(1, 0, At, B0); PG8_MMA(1, 1, At, B1); PG8_BAR; PG8_SCHED;
            PG8_LDB(B0, 1, 0); PG8_LDB(B1, 1, 1); PG8_SCHED; PG8_LDA(At, 1, 0); PG8_STAGE(PG8_SA(0, 1), a2 + hstepA, voffA);
            PG8_WAIT_V(8); PG8_WAIT_L(0); PG8_BAR; PG8_MMA(0, 0, At, B0); PG8_MMA(0, 1, At, B1); PG8_BAR; PG8_SCHED;
            PG8_LDA(At, 1, 1); PG8_STAGE(PG8_SB(1, 0), b3, voffB); PG8_STAGE(PG8_SB(1, 1), b3 + hstepB, voffB); PG8_STAGE(PG8_SA(1, 0), a3, voffA);
            PG8_WAIT_V(8); PG8_WAIT_L(0); PG8_BAR; PG8_MMA(1, 0, At, B0); PG8_MMA(1, 1, At, B1); PG8_BAR; PG8_SCHED;
        }
        if constexpr (ALIGN_EPI) { if (wr == 0) PG8_BAR; }
        if constexpr (Sched::SPLIT) {
            if (cur.part >= 0) {
                E.partial(acc, cur.part, wr, wc, fr, fq);
                PG8_WAIT_V(0); PG8_BAR;
                if (tid == 0) E.signal();
            } else E(acc, cur, wr, wc, fr, fq);
        }
        else E(acc, cur, wr, wc, fr, fq);
        if (!has_next) break;
#pragma unroll
        for (int a = 0; a < 2; ++a)
#pragma unroll
            for (int b = 0; b < 2; ++b)
#pragma unroll
                for (int m = 0; m < 4; ++m)
#pragma unroll
                    for (int n = 0; n < 2; ++n) acc[a][b][m][n] = (f32x4){0.f, 0.f, 0.f, 0.f};
        cur = nxt; cA = nA; cB = nB; ++ui;
        if constexpr (Sched::SPLIT) ntc = nxt.nt;
        if constexpr (ALIGN_EPI) { if (wr == 1) PG8_BAR; }
    }
    PG8_WAIT_V(0);
    if constexpr (!ALIGN_EPI) { if (wr == 0) PG8_BAR; }
    PG8_BAR;
#undef PG8_SA
#undef PG8_SB
#undef PG8_STAGE
#undef PG8_LDA
#undef PG8_LDB
#undef PG8_MMA
#undef PG8_WAIT_V
#undef PG8_WAIT_L
#undef PG8_BAR
#undef PG8_SCHED
}

struct EpiSwiglu {
    static constexpr bool PERM = true;
    bf16_t* O; const float* ss;
    __device__ __forceinline__ void operator()(const f32x4 (&acc)[2][2][4][2], const Unit& u, int wr, int wc, int fr, int fq) const {
        const int row0 = u.pm * BM + wr * 64 + fr, col0 = u.pn * 128 + wc * 32 + 8 * fq;
#pragma unroll
        for (int ai = 0; ai < 2; ++ai)
#pragma unroll
            for (int m = 0; m < 4; ++m) {
                const int row = row0 + ai * HALF + m * 16;
                const float rs = __builtin_amdgcn_rsqf(ss[row] * (1.0f / DM) + EPS);
                float a[8];
#pragma unroll
                for (int n = 0; n < 2; ++n)
#pragma unroll
                    for (int e = 0; e < 4; ++e) { const float gg = acc[ai][0][m][n][e] * rs, uu = acc[ai][1][m][n][e] * rs; a[n * 4 + e] = silu_f(gg) * uu; }
                u32x4 w; w.x = pk2(a[0], a[1]); w.y = pk2(a[2], a[3]); w.z = pk2(a[4], a[5]); w.w = pk2(a[6], a[7]);
                *(u32x4*)(O + (size_t)row * DFF + col0) = w;
            }
    }
};
struct EpiResid {
    static constexpr bool PERM = false;
    float* h; bf16_t* hb; float* ssn; float scale; unsigned char* part; unsigned* cnt;
    __device__ __forceinline__ void signal() const { __builtin_amdgcn_fence(__ATOMIC_RELEASE, "agent"); __hip_atomic_fetch_add(cnt, 1u, __ATOMIC_RELAXED, __HIP_MEMORY_SCOPE_AGENT); }
    __device__ __forceinline__ void partial(const f32x4 (&acc)[2][2][4][2], int slot, int wr, int wc, int fr, int fq) const {
        unsigned char* P = part + (size_t)slot * 131072 + (size_t)(wr * 4 + wc) * 16384 + (size_t)(fq * 16 + fr) * 16;
#pragma unroll
        for (int ai = 0; ai < 2; ++ai)
#pragma unroll
            for (int m = 0; m < 4; ++m)
#pragma unroll
                for (int bj = 0; bj < 2; ++bj) { const f32x4 v0 = acc[ai][bj][m][0], v1 = acc[ai][bj][m][1];
                    u32x4 w; w.x = pk2(v0[0], v0[1]); w.y = pk2(v0[2], v0[3]); w.z = pk2(v1[0], v1[1]); w.w = pk2(v1[2], v1[3]);
                    *(u32x4*)(P + ((ai * 4 + m) * 2 + bj) * 1024) = w; }
    }
    __device__ __forceinline__ void operator()(const f32x4 (&acc)[2][2][4][2], const Unit& u, int wr, int wc, int fr, int fq) const {
        const int row0 = u.pm * BM + wr * 64 + fr, col0 = u.pn * BM + wc * 32 + 4 * fq;
#pragma unroll
        for (int ai = 0; ai < 2; ++ai)
#pragma unroll
            for (int m = 0; m < 4; ++m) {
                const int row = row0 + ai * HALF + m * 16; float s = 0.f;
#pragma unroll
                for (int bj = 0; bj < 2; ++bj)
#pragma unroll
                    for (int n = 0; n < 2; ++n) {
                        const size_t off = (size_t)row * DM + col0 + bj * HALF + n * 16;
                        f32x4 v;
                        if (RESID_BF16) { const u32x2 hv = *(const u32x2*)(hb + off); v = (f32x4){bflo(hv.x), bfhi(hv.x), bflo(hv.y), bfhi(hv.y)} + acc[ai][bj][m][n] * scale; }
                        else { v = *(const f32x4*)(h + off) + acc[ai][bj][m][n] * scale; *(f32x4*)(h + off) = v; }
                        u32x2 w; w.x = pk2(v[0], v[1]); w.y = pk2(v[2], v[3]); *(u32x2*)(hb + off) = w;
                        s += (v[0] * v[0] + v[1] * v[1]) + (v[2] * v[2] + v[3] * v[3]);
                    }
                s += __shfl_xor(s, 16); s += __shfl_xor(s, 32);
                if (fq == 0) atomicAdd(ssn + row, s);
            }
    }
};
struct EpiScaleBf16 {
    static constexpr bool PERM = true;
    bf16_t* O; int ldc; const float* ss;
    __device__ __forceinline__ void operator()(const f32x4 (&acc)[2][2][4][2], const Unit& u, int wr, int wc, int fr, int fq) const {
        const int row0 = u.pm * BM + wr * 64 + fr, col0 = u.pn * BM + wc * 32 + 8 * fq;
#pragma unroll
        for (int ai = 0; ai < 2; ++ai)
#pragma unroll
            for (int m = 0; m < 4; ++m) {
                const int row = row0 + ai * HALF + m * 16;
                const float rs = __builtin_amdgcn_rsqf(ss[row] * (1.0f / DM) + EPS);
#pragma unroll
                for (int bj = 0; bj < 2; ++bj) { const f32x4 v0 = acc[ai][bj][m][0] * rs, v1 = acc[ai][bj][m][1] * rs;
                    u32x4 w; w.x = pk2(v0[0], v0[1]); w.y = pk2(v0[2], v0[3]); w.z = pk2(v1[0], v1[1]); w.w = pk2(v1[2], v1[3]);
                    *(u32x4*)(O + (size_t)row * ldc + col0 + bj * HALF) = w; }
            }
    }
};
struct EpiScaleF32 {
    static constexpr bool PERM = false;
    float* O; int ldc; const float* ss;
    __device__ __forceinline__ void operator()(const f32x4 (&acc)[2][2][4][2], const Unit& u, int wr, int wc, int fr, int fq) const {
        const int row0 = u.pm * BM + wr * 64 + fr, col0 = u.pn * BM + wc * 32 + 4 * fq;
#pragma unroll
        for (int ai = 0; ai < 2; ++ai)
#pragma unroll
            for (int m = 0; m < 4; ++m) {
                const int row = row0 + ai * HALF + m * 16;
                const float rs = __builtin_amdgcn_rsqf(ss[row] * (1.0f / DM) + EPS);
#pragma unroll
                for (int bj = 0; bj < 2; ++bj)
#pragma unroll
                    for (int n = 0; n < 2; ++n) *(f32x4*)(O + (size_t)row * ldc + col0 + bj * HALF + n * 16) = acc[ai][bj][m][n] * rs;
            }
    }
};
struct EpiQ {
    static constexpr bool PERM = true;
    bf16_t* Q; const float* ssq; float c2;
    __device__ __forceinline__ void operator()(const f32x4 (&acc)[2][2][4][2], const Unit& u, int wr, int wc, int fr, int fq) const {
        const int row0 = u.pm * BM + wr * 64 + fr;
        const int hs0 = u.pn < 8 ? u.pn * 10 + wc : (4 * (u.pn - 8) + (wc >> 1)) * 10 + 8 + (wc & 1);
        const int hsstep = u.pn < 8 ? 4 : 20;
#pragma unroll
        for (int ai = 0; ai < 2; ++ai)
#pragma unroll
            for (int m = 0; m < 4; ++m) {
                const int row = row0 + ai * HALF + m * 16;
                const float rs = __builtin_amdgcn_rsqf(ssq[row] * (1.0f / 384.0f) + EPS) * c2;
#pragma unroll
                for (int bj = 0; bj < 2; ++bj) { const f32x4 v0 = acc[ai][bj][m][0] * rs, v1 = acc[ai][bj][m][1] * rs;
                    u32x4 w; w.x = pk2(v0[0], v0[1]); w.y = pk2(v0[2], v0[3]); w.z = pk2(v1[0], v1[1]); w.w = pk2(v1[2], v1[3]);
                    *(u32x4*)(Q + ((size_t)(row >> 4) * 80 + hs0 + bj * hsstep) * 512 + (fq * 16 + fr) * 8) = w; }
            }
    }
};
}

#define XB_TMO      128
#define XB_XCNT(j)  (256  + 64 * (j))
#define XB_XSUB(j)  (1280 + 64 * (j))
#define XB_XGEN(j)  (2304 + 64 * (j))
#define XB_TOP      3328
#define XB_TOPGEN   3392
#define XCD_BAR_WORDS 3456
#define XB_SPIN_CAP (1u << 18)
__device__ __forceinline__ unsigned xb_ld(unsigned* p)              { return __hip_atomic_load(p, __ATOMIC_RELAXED, __HIP_MEMORY_SCOPE_AGENT); }
__device__ __forceinline__ unsigned xb_add(unsigned* p, unsigned v) { return __hip_atomic_fetch_add(p, v, __ATOMIC_RELAXED, __HIP_MEMORY_SCOPE_AGENT); }
__device__ __forceinline__ unsigned xb_xcc_id() { return (unsigned)__builtin_amdgcn_s_getreg((3 << 11) | 20) & 0xFu; }
#define XB_SPIN(cond, bar) do { unsigned _sp = 0; while (cond) { __builtin_amdgcn_s_sleep(1); \
    if ((++_sp & 255u) == 0u) { if (xb_ld(&(bar)[XB_TMO])) break; if (_sp > XB_SPIN_CAP) { atomicAdd(&(bar)[XB_TMO], 1u); break; } } } } while (0)
struct XcdBarrier { unsigned* bar; unsigned x; volatile LAS unsigned* st; };
__device__ __forceinline__ XcdBarrier xcd_barrier_post(unsigned* bar, volatile LAS unsigned* st) {
    XcdBarrier b; b.bar = bar; b.x = xb_xcc_id(); b.st = st;
    if (threadIdx.x == 0) (void)xb_add(&bar[XB_XCNT(b.x)], 1u);
    return b;
}
__device__ __forceinline__ void xcd_barrier_complete(unsigned* bar, unsigned x, unsigned& nloc, unsigned& nx) {
    const unsigned G = gridDim.x * gridDim.y * gridDim.z;
    unsigned sum, cnt, mine, sp = 0u;
    for (;;) {
        sum = 0u; cnt = 0u; mine = 0u;
#pragma unroll
        for (unsigned j = 0; j < 16; ++j) { const unsigned c = xb_ld(&bar[XB_XCNT(j)]); sum += c; cnt += (c > 0u) ? 1u : 0u; mine = (j == x) ? c : mine; }
        if (sum == G) break;
        __builtin_amdgcn_s_sleep(1);
        if ((++sp & 255u) == 0u) { if (xb_ld(&bar[XB_TMO])) break; if (sp > XB_SPIN_CAP) { atomicAdd(&bar[XB_TMO], 1u); break; } }
    }
    nloc = mine > 0u ? mine : 1u; nx = cnt > 0u ? cnt : 1u;
}
__device__ __forceinline__ void xcd_barrier(const XcdBarrier& b) {
    asm volatile("s_waitcnt vmcnt(0)" ::: "memory");
    __syncthreads();
    if (threadIdx.x == 0) {
        unsigned* bar = b.bar;
        __builtin_amdgcn_s_waitcnt(0);
        unsigned nloc = b.st[0], nx = b.st[1];
        if (nloc == 0u) { xcd_barrier_complete(bar, b.x, nloc, nx); b.st[0] = nloc; b.st[1] = nx; }
        const unsigned old = xb_add(&bar[XB_XSUB(b.x)], 1u);
        const unsigned gen = old / nloc;
        if (old + 1u == (gen + 1u) * nloc) {
            __builtin_amdgcn_fence(__ATOMIC_RELEASE, "agent");
            asm volatile("s_waitcnt vmcnt(0)" ::: "memory");
            const unsigned og = xb_add(&bar[XB_TOP], 1u);
            const unsigned tg = og / nx;
            if (og + 1u == (tg + 1u) * nx) xb_add(&bar[XB_TOPGEN], 1u);
            else XB_SPIN(xb_ld(&bar[XB_TOPGEN]) == tg, bar);
            __builtin_amdgcn_fence(__ATOMIC_ACQUIRE, "agent");
            xb_add(&bar[XB_XGEN(b.x)], 1u);
            asm volatile("s_waitcnt vmcnt(0)" ::: "memory");
        } else {
            XB_SPIN(xb_ld(&bar[XB_XGEN(b.x)]) == gen, bar);
            __builtin_amdgcn_fence(__ATOMIC_ACQUIRE, "agent");
            asm volatile("s_waitcnt vmcnt(0)" ::: "memory");
        }
    }
    __syncthreads();
}

struct Args { const float* in[28]; float* out; unsigned char* ws; int ph_lo, ph_hi; };

__device__ __forceinline__ void tr_item(const float* W, int ldw, int Nvalid, const float* kscale, bf16_t* WT, int Kd, int k0, int n0, int drow0, LAS float* scr, int lane) {
    const int n = n0 + 4 * (lane & 15);
    f32x4 v[16];
#pragma unroll
    for (int i = 0; i < 16; ++i) { const int kk = 4 * i + (lane >> 4); v[i] = (f32x4){0.f, 0.f, 0.f, 0.f}; if (n < Nvalid) v[i] = *(const f32x4*)(W + (size_t)(k0 + kk) * ldw + n); }
#pragma unroll
    for (int i = 0; i < 16; ++i) { const int kk = 4 * i + (lane >> 4); f32x4 x = v[i]; if (kscale) x = x * kscale[k0 + kk];
        LAS float* d = scr + kk * 65 + 4 * (lane & 15); d[0] = x[0]; d[1] = x[1]; d[2] = x[2]; d[3] = x[3]; }
    asm volatile("s_waitcnt lgkmcnt(0)" ::: "memory");
    const int c = lane & 7;
#pragma unroll
    for (int j = 0; j < 8; ++j) { const int nn = (lane >> 3) + 8 * j; const LAS float* s = scr + (8 * c) * 65 + nn;
        u32x4 o; o.x = pk2(s[0 * 65], s[1 * 65]); o.y = pk2(s[2 * 65], s[3 * 65]); o.z = pk2(s[4 * 65], s[5 * 65]); o.w = pk2(s[6 * 65], s[7 * 65]);
        *(u32x4*)(WT + (size_t)(drow0 + nn) * Kd + k0 + 8 * c) = o; }
    asm volatile("s_waitcnt lgkmcnt(0)" ::: "memory");
}
__device__ __forceinline__ void split8(const f32x4 x0, const f32x4 x1, bf16x8& hi, bf16x8& lo) {
    u32x4 h; h.x = pk2(x0[0], x0[1]); h.y = pk2(x0[2], x0[3]); h.z = pk2(x1[0], x1[1]); h.w = pk2(x1[2], x1[3]);
    u32x4 l; l.x = pk2(x0[0] - bflo(h.x), x0[1] - bfhi(h.x)); l.y = pk2(x0[2] - bflo(h.y), x0[3] - bfhi(h.y)); l.z = pk2(x1[0] - bflo(h.z), x1[1] - bfhi(h.z)); l.w = pk2(x1[2] - bflo(h.w), x1[3] - bfhi(h.w));
    hi = __builtin_bit_cast(bf16x8, h); lo = __builtin_bit_cast(bf16x8, l);
}
__device__ __forceinline__ void phase_prep(const Args& a, unsigned char* const ws_, float* const out_, LAS unsigned char* lds, int gw, int NGW, int wave, int lane) {
    unsigned char* ws = ws_;
    LAS float* scr = (LAS float*)(lds + wave * 16640);
    constexpr int I_UP = 16 * 44, I_DN = 44 * 16, I_GIN = 16 * 52, I_SQ = 16 * 16, I_MDN = 16 * 12;
    constexpr int I_FFN = 2 * I_UP + I_DN;
    constexpr int NITEMS = 4 * I_FFN + I_GIN + I_SQ + I_MDN + I_SQ;
    for (int it = gw; it < NITEMS; it += NGW) {
        int r = it;
        if (r < 4 * I_FFN) {
            const int fi = r / I_FFN; r -= fi * I_FFN; const int layer = fi >> 1, which = fi & 1;
            const float* nrm = a.in[which ? 23 : 6] + layer * DM;
            if (r < 2 * I_UP) { const int isup = r >= I_UP; if (isup) r -= I_UP;
                const float* W = a.in[(which ? 24 : 7) + isup] + (size_t)layer * DM * DFF;
                const int kb = r / 44, nb = r % 44, n0 = nb * 64;
                tr_item(W, DFF, DFF, nrm, (bf16_t*)(ws + ws_wup(fi)), DM, kb * 64, n0, 256 * (n0 >> 7) + (n0 & 127) + 128 * isup, scr, lane);
            } else { r -= 2 * I_UP;
                const float* W = a.in[which ? 26 : 9] + (size_t)layer * DFF * DM;
                const int kb = r / 16, nb = r % 16;
                tr_item(W, DM, DM, nullptr, (bf16_t*)(ws + ws_wdn(fi)), DFF, kb * 64, nb * 64, nb * 64, scr, lane);
            }
            continue;
        }
        r -= 4 * I_FFN;
        if (r < I_GIN) { const int kb = r / 52, nb = r % 52; tr_item(a.in[11], 3088, 3088, a.in[10], (bf16_t*)(ws + WS_WGIN), DM, kb * 64, nb * 64, nb * 64, scr, lane); continue; }
        r -= I_GIN;
        if (r < I_SQ) { const int kb = r / 16, nb = r % 16; tr_item(a.in[15], DM, DM, nullptr, (bf16_t*)(ws + WS_WGOUT), DM, kb * 64, nb * 64, nb * 64, scr, lane); continue; }
        r -= I_SQ;
        if (r < I_MDN) { const int kb = r / 12, nb = r % 12; tr_item(a.in[16], 704, 704, a.in[10] + DM, (bf16_t*)(ws + WS_WMDN), DM, kb * 64, nb * 64, nb * 64, scr, lane); continue; }
        r -= I_MDN;
        { const int kb = r / 16, nb = r % 16; tr_item(a.in[22], DM, DM, nullptr, (bf16_t*)(ws + WS_WMOUT), DM, kb * 64, nb * 64, nb * 64, scr, lane); }
    }
    const int gt = gw * 64 + lane, NGT = NGW * 64;
    {   const float* wuq = a.in[18]; const float* wuk = a.in[20]; const float* qn = a.in[17]; bf16_t* WQ = (bf16_t*)(ws + WS_WQ);
        {   const int fr = lane & 15, fq = lane >> 4;
            for (int it = gw; it < 8 * 24 * 4; it += NGW) {
                const int h = it / 96, ct = (it % 96) >> 2, rg = it & 3;
                const float* ap = wuq + (size_t)(16 * ct + fr) * 1536 + h * 192 + 8 * fq;
                bf16x8 ah[4], al[4];
#pragma unroll
                for (int s = 0; s < 4; ++s) split8(*(const f32x4*)(ap + 32 * s), *(const f32x4*)(ap + 32 * s + 4), ah[s], al[s]);
                const f32x4 qs = *(const f32x4*)(qn + 16 * ct + 4 * fq);
#pragma unroll
                for (int q = 0; q < 4; ++q) { const int rt = rg * 4 + q;
                    const float* bp = wuk + (size_t)(16 * rt + fr) * 1024 + h * 128 + 8 * fq;
                    f32x4 acc = (f32x4){0.f, 0.f, 0.f, 0.f};
#pragma unroll
                    for (int s = 0; s < 4; ++s) { bf16x8 bh, bl; split8(*(const f32x4*)(bp + 32 * s), *(const f32x4*)(bp + 32 * s + 4), bh, bl);
                        acc = mfma16(al[s], bh, acc); acc = mfma16(ah[s], bl, acc); acc = mfma16(ah[s], bh, acc); }
                    acc = acc * qs;
                    u32x2 w; w.x = pk2(acc[0], acc[1]); w.y = pk2(acc[2], acc[3]);
                    *(u32x2*)(WQ + (size_t)(h * 256 + 16 * rt + fr) * 384 + 16 * ct + 4 * fq) = w; }
            }
        }
        for (int i = gt; i < 512 * 384; i += NGT) {
            const int c = i % 384, rr = i / 384, head = rr >> 6, j = rr & 63;
            WQ[(size_t)(2048 + rr) * 384 + c] = (bf16_t)(pk2(wuq[(size_t)c * 1536 + head * 192 + 128 + j] * qn[c], 0.f) & 0xffffu);
        }
    }
    {   const float* wuv = a.in[21]; bf16_t* WU = (bf16_t*)(ws + WS_WUVT);
        for (int i = gt; i < 8 * 128 * 256; i += NGT) { const int j = i & 7, ln = (i >> 3) & 63, s = (i >> 9) & 7, vt = (i >> 12) & 7, h = i >> 15;
            const int dv = 32 * s + 16 * (j >> 2) + 4 * (ln >> 4) + (j & 3), v = 16 * vt + (ln & 15);
            WU[i] = (bf16_t)(pk2(wuv[(size_t)dv * 1024 + h * 128 + v], 0.f) & 0xffffu); }
    }
    {   f32x2* rt = (f32x2*)(ws + WS_ROPE);
        for (int i = gt; i < 4144 * 32; i += NGT) { const int idx = i >> 5, k = i & 31; const float pos = idx < LP ? (float)idx : (float)(PAST + idx - LP);
            const float inv = fexp2(-(float)k * 0.41524101186092029f); const float ang = pos * inv;
            const float kq = rintf(ang * 0.63661977236758134f);
            float r = ang - kq * 1.5703125f; r -= kq * 4.837512969970703125e-4f; r -= kq * 7.54978995489188216e-8f;
            const float r2 = r * r;
            const float sr = r + r * r2 * (-1.6666654611e-1f + r2 * (8.3321608736e-3f + r2 * -1.9515295891e-4f));
            const float cr = 1.0f - 0.5f * r2 + r2 * r2 * (4.166664568298827e-2f + r2 * (-1.388731625493765e-3f + r2 * 2.443315711809948e-5f));
            const int qd = (int)kq & 3;
            const float cs = qd == 0 ? cr : qd == 1 ? -sr : qd == 2 ? -cr : sr, sn = qd == 0 ? sr : qd == 1 ? cr : qd == 2 ? -sr : -cr;
            rt[i] = (f32x2){cs, sn}; }
    }
    {   float* H = (float*)(ws + WS_H); bf16_t* HB = (bf16_t*)(ws + WS_HB); float* SS0 = (float*)(ws + WS_SS);
        for (int row = gw; row < T; row += NGW) {
            const float* src = nullptr;
            if (row < ROWS_P) { const int b = row / LPP, p = row % LPP; if (p >= 64) src = a.in[0] + ((size_t)b * SEQ + (p - 64)) * DM; else if (p >= 48) src = a.in[5] + (size_t)(p - 48) * DM; }
            else src = a.in[1] + (size_t)(row - ROWS_P) * DM;
            float s = 0.f;
#pragma unroll
            for (int j = 0; j < 4; ++j) { f32x4 v = (f32x4){0.f, 0.f, 0.f, 0.f}; if (src) v = *(const f32x4*)(src + 256 * j + 4 * lane);
                if (!RESID_BF16) *(f32x4*)(H + (size_t)row * DM + 256 * j + 4 * lane) = v;
                u32x2 w; w.x = pk2(v[0], v[1]); w.y = pk2(v[2], v[3]); *(u32x2*)(HB + (size_t)row * DM + 256 * j + 4 * lane) = w;
                s += (v[0] * v[0] + v[1] * v[1]) + (v[2] * v[2] + v[3] * v[3]); }
            s = wave_sum(s); if (lane == 0) SS0[row] = s;
        }
    }
}

__device__ __forceinline__ void phase_gla_a(const Args& a, unsigned char* const ws_, float* const out_, LAS unsigned char* lds, int G, int bx, int tid) {
    bf16_t* P = (bf16_t*)(ws_ + WS_BIG); float* DEC = (float*)(ws_ + WS_DEC);
    const float* wg = a.in[12]; const float* bg = a.in[13];
    LAS float* gd = (LAS float*)lds;
    float w[16];
#pragma unroll
    for (int r = 0; r < 16; ++r) w[r] = wg[r * 512 + tid];
    const float bias = bg[tid];
    for (int cg = bx; cg < 260 + SB; cg += G) {
        int row0, nrows, npad;
        if (cg < 260) { const int b = cg / NCH, c = cg % NCH; row0 = b * LPP + 64 * c; nrows = 64; npad = c == 0 ? 48 : 0; }
        else { row0 = ROWS_P + 32 * (cg - 260); nrows = 32; npad = 0; }
        __syncthreads();
        for (int i = tid; i < nrows * 16; i += 512) gd[i] = bf2f(P[(size_t)(row0 + (i >> 4)) * GIN_LD + 3072 + (i & 15)]);
        __syncthreads();
        unsigned short qv[64], kv[64];
#pragma unroll
        for (int i = 0; i < 64; ++i) { qv[i] = 0; kv[i] = 0; if (i < nrows) { const bf16_t* pr = P + (size_t)(row0 + i) * GIN_LD; qv[i] = pr[tid]; kv[i] = pr[512 + tid]; } }
        float gc = 0.f;
#pragma unroll
        for (int i = 0; i < 64; ++i) {
            if (i < nrows) {
                bf16_t* pr = P + (size_t)(row0 + i) * GIN_LD;
                if (i >= npad) {
                    float g = bias;
#pragma unroll
                    for (int r = 0; r < 16; ++r) g += gd[i * 16 + r] * w[r];
                    const float ls = fminf(g, 0.f) - __logf(1.0f + __expf(-fabsf(g)));
                    gc += ls * (1.0f / 16.0f);
                }
                const float q = bf2f(qv[i]), k = bf2f(kv[i]);
                const float eg = __expf(gc);
                pr[tid] = (bf16_t)(pk2(q * 0.08838834764831845f * eg, 0.f) & 0xffffu);
                pr[512 + tid] = (bf16_t)(pk2(k * frcp(eg), 0.f) & 0xffffu);
            }
        }
        DEC[(size_t)cg * 512 + tid] = __expf(gc);
    }
}
__device__ __forceinline__ bf16x8 col8(const bf16_t* p, int stride) {
    bf16x8 r;
#pragma unroll
    for (int j = 0; j < 8; ++j) r[j] = (short)p[(size_t)j * stride];
    return r;
}
__device__ __forceinline__ bf16x8 tr8(const LAS unsigned char* p) {
    const s16x4 lo = __builtin_bit_cast(s16x4, __builtin_amdgcn_ds_read_tr16_b64_v4i16((LAS s16x4*)p));
    const s16x4 hi = __builtin_bit_cast(s16x4, __builtin_amdgcn_ds_read_tr16_b64_v4i16((LAS s16x4*)(p + 128)));
    return (bf16x8){lo[0], lo[1], lo[2], lo[3], hi[0], hi[1], hi[2], hi[3]};
}
__device__ __forceinline__ void phase_gla_b(const Args& a, unsigned char* const ws_, float* const out_, LAS unsigned char* lds, int G, int vcu, int gw, int NGW, int wid, int lane) {
    const bf16_t* P = (const bf16_t*)(ws_ + WS_BIG); const float* DEC = (const float*)(ws_ + WS_DEC);
    bf16_t* SBP = (bf16_t*)((unsigned char*)out_ + OS_SBUFP); bf16_t* SBS = (bf16_t*)(ws_ + WS_SBUFS);
    const int fr = lane & 15, fq = lane >> 4, tid = wid * 64 + lane;
    LAS unsigned char* wl = lds + wid * 8192;
    const int troff = (8 * fq + (fr >> 2)) * 32 + (fr & 3) * 8;
    for (int item = vcu; item < 256; item += G) {
        const int seq = item >> 4, rect = item & 15, dkt = 2 * (rect >> 2) + (wid >> 2), dvs = 4 * (rect & 3) + (wid & 3), b = seq >> 2, h = seq & 3;
        const int krow = tid >> 2, kch = tid & 3, vrow_ = tid >> 3, vch = tid & 7;
        const bf16_t* kp = P + (size_t)(b * LPP + krow) * GIN_LD + 512 + h * 128 + 32 * (rect >> 2) + 8 * kch;
        const bf16_t* vp = P + (size_t)(b * LPP + vrow_) * GIN_LD + 1024 + h * 256 + 64 * (rect & 3) + 8 * vch;
        const int kdst = (kch >> 1) * 2048 + krow * 32 + (kch & 1) * 16, vdst = 8192 + (vch >> 1) * 2048 + vrow_ * 32 + (vch & 1) * 16;
        const int ksrc = (wid >> 2) * 2048 + troff, vsrc = 8192 + (wid & 3) * 2048 + troff;
        const float* dp = DEC + (size_t)(b * NCH) * 512 + h * 128 + 16 * dkt + 4 * fq;
        f32x4 S = (f32x4){0.f, 0.f, 0.f, 0.f};
        u32x4 rk[4], rv[4]; f32x4 rd[4];
#define GB_LOAD(c, I) do { const size_t o_ = (size_t)(64 * (c)) * GIN_LD; if (tid < 256) rk[I] = *(const u32x4*)(kp + o_); rv[I] = *(const u32x4*)(vp + o_); rd[I] = *(const f32x4*)(dp + (size_t)(c) * 512); } while (0)
#define GB_STEP(c, I) do { LAS unsigned char* bb_ = lds + (((c) & 1) ? 16384 : 0); const f32x4 dcur_ = rd[I]; \
            if (tid < 256) *(LAS u32x4*)(bb_ + kdst) = rk[I]; *(LAS u32x4*)(bb_ + vdst) = rv[I]; \
            if ((c) + 4 < NCH) GB_LOAD((c) + 4, I); \
            if ((c) >= 1) { u32x2 w_; w_.x = pk2(S[0], S[1]); w_.y = pk2(S[2], S[3]); \
                *(u32x2*)(SBP + ((size_t)(seq * 64 + ((c) - 1)) * 256 + 16 * dvs + fr) * 128 + 16 * dkt + 4 * fq) = w_; } \
            __syncthreads(); \
            const bf16x8 ka0_ = tr8(bb_ + ksrc), ka1_ = tr8(bb_ + ksrc + 1024), va0_ = tr8(bb_ + vsrc), va1_ = tr8(bb_ + vsrc + 1024); \
            S = mfma16(ka0_, va0_, S); S = mfma16(ka1_, va1_, S); \
            S = S * dcur_; } while (0)
        __syncthreads();
        GB_LOAD(0, 0); GB_LOAD(1, 1); GB_LOAD(2, 2); GB_LOAD(3, 3);
        for (int c = 0; c + 3 < NCH; c += 4) { GB_STEP(c, 0); GB_STEP(c + 1, 1); GB_STEP(c + 2, 2); GB_STEP(c + 3, 3); }
        GB_STEP(NCH - 1, 0);
#undef GB_LOAD
#undef GB_STEP
        float* og = out_ + OUT_GP + ((size_t)seq * 128 + 16 * dkt + 4 * fq) * 256 + 16 * dvs + fr;
#pragma unroll
        for (int r = 0; r < 4; ++r) og[(size_t)r * 256] = S[r];
    }
    __syncthreads();
    for (int rep_ = 0; rep_ < (GB_P2 ? 2 : 1); ++rep_)
    for (int it = gw; it < 128 * 16; it += NGW) {
        const int seq = it >> 4, dkt = (it >> 1) & 7, dvh = it & 1, bs = seq >> 2, h = seq & 3;
        const int lrow = lane & 31;
        const bf16_t* kp = P + (size_t)(ROWS_P + 32 * bs + lrow) * GIN_LD + 512 + h * 128 + 16 * dkt;
        const bf16_t* vp = P + (size_t)(ROWS_P + 32 * bs + lrow) * GIN_LD + 1024 + h * 256 + 128 * dvh;
        { const u32x4 k0 = *(const u32x4*)kp, k1 = *(const u32x4*)(kp + 8);
          if (lane < 32) { *(LAS u32x4*)(wl + lane * 32) = k0; *(LAS u32x4*)(wl + lane * 32 + 16) = k1; } }
        const bf16x8 ka = tr8(wl + troff);
        const f32x4 d = *(const f32x4*)(DEC + (size_t)(260 + bs) * 512 + h * 128 + 16 * dkt + 4 * fq);
#pragma unroll 2
        for (int q = 0; q < 8; ++q) {
            const int dvs = 8 * dvh + q;
            { const u32x4 v0 = *(const u32x4*)(vp + 16 * q), v1 = *(const u32x4*)(vp + 16 * q + 8);
              if (lane < 32) { *(LAS u32x4*)(wl + 4096 + (q & 1) * 2048 + lane * 32) = v0; *(LAS u32x4*)(wl + 4096 + (q & 1) * 2048 + lane * 32 + 16) = v1; } }
            const size_t so = ((size_t)seq * 128 + 16 * dkt + 4 * fq) * 256 + 16 * dvs + fr;
            f32x4 S;
#pragma unroll
            for (int r = 0; r < 4; ++r) S[r] = a.in[2][so + (size_t)r * 256];
            { u32x2 w; w.x = pk2(S[0], S[1]); w.y = pk2(S[2], S[3]); *(u32x2*)(SBS + ((size_t)seq * 256 + 16 * dvs + fr) * 128 + 16 * dkt + 4 * fq) = w; }
            S = mfma16(ka, tr8(wl + 4096 + (q & 1) * 2048 + troff), S);
            S = S * d;
            float* og = out_ + OUT_GS + so;
#pragma unroll
            for (int r = 0; r < 4; ++r) og[(size_t)r * 256] = S[r];
        }
    }
}
template <int NI>
__device__ __forceinline__ void gla_c_item(LAS unsigned char* abuf, LAS float* red, bf16_t* P, const bf16_t* ST, const float* hn, int row0, int h, int wid, int lane) {
    { int zz = 0; asm volatile("" : "+v"(zz)); lane = (int)__builtin_amdgcn_mbcnt_hi(~0u, __builtin_amdgcn_mbcnt_lo(~0u, 0u)) + zz; }
    const int fr = lane & 15, fq = lane >> 4;
    constexpr int ASTR = 144;
    constexpr int NTILE = NI * NI, PERW = NTILE >= 8 ? NTILE / 8 : 1;
#pragma unroll
    for (int q = 0; q < PERW; ++q) {
        const int idx = wid * PERW + q;
        if (idx < NTILE) {
            const int it = idx / NI, jt = idx % NI;
            const bf16_t* kq = P + (size_t)(row0 + 16 * jt + fr) * GIN_LD + 512 + h * 128 + 8 * fq;
            const bf16_t* qq = P + (size_t)(row0 + 16 * it + fr) * GIN_LD + h * 128 + 8 * fq;
            f32x4 d = (f32x4){0.f, 0.f, 0.f, 0.f};
#pragma unroll
            for (int s = 0; s < 4; ++s) d = mfma16(*(const bf16x8*)(kq + 32 * s), *(const bf16x8*)(qq + 32 * s), d);
            const int i = 16 * it + fr, j0 = 16 * jt + 4 * fq;
#pragma unroll
            for (int r = 0; r < 4; ++r) if (j0 + r > i) d[r] = 0.f;
            u32x2 w; w.x = pk2(d[0], d[1]); w.y = pk2(d[2], d[3]);
            *(LAS u32x2*)(abuf + i * ASTR + j0 * 2) = w;
        }
    }
    __syncthreads();
    f32x4 o[2][NI];
#pragma unroll
    for (int dt = 0; dt < 2; ++dt)
#pragma unroll
        for (int it = 0; it < NI; ++it) o[dt][it] = (f32x4){0.f, 0.f, 0.f, 0.f};
    const int dv0 = 32 * wid;
    if (ST) {
#pragma unroll
        for (int s = 0; s < 4; ++s) {
            const bf16x8 s0 = *(const bf16x8*)(ST + (size_t)(dv0 + fr) * 128 + 32 * s + 8 * fq), s1 = *(const bf16x8*)(ST + (size_t)(dv0 + 16 + fr) * 128 + 32 * s + 8 * fq);
#pragma unroll
            for (int it = 0; it < NI; ++it) { const bf16x8 qf = *(const bf16x8*)(P + (size_t)(row0 + 16 * it + fr) * GIN_LD + h * 128 + 32 * s + 8 * fq);
                o[0][it] = mfma16(s0, qf, o[0][it]); o[1][it] = mfma16(s1, qf, o[1][it]); }
        }
    }
#pragma unroll
    for (int s = 0; s < NI / 2; ++s) {
        const bf16_t* vp = P + (size_t)(row0 + 32 * s + 8 * fq) * GIN_LD + 1024 + h * 256 + dv0 + fr;
        const bf16x8 v0 = col8(vp, GIN_LD), v1 = col8(vp + 16, GIN_LD);
#pragma unroll
        for (int it = 2 * s; it < NI; ++it) { const bf16x8 af = *(const LAS bf16x8*)(abuf + (16 * it + fr) * ASTR + (32 * s + 8 * fq) * 2);
            o[0][it] = mfma16(v0, af, o[0][it]); o[1][it] = mfma16(v1, af, o[1][it]); }
    }
#pragma unroll
    for (int it = 0; it < NI; ++it) { float s = 0.f;
#pragma unroll
        for (int dt = 0; dt < 2; ++dt) s += (o[dt][it][0] * o[dt][it][0] + o[dt][it][1] * o[dt][it][1]) + (o[dt][it][2] * o[dt][it][2] + o[dt][it][3] * o[dt][it][3]);
        s += __shfl_xor(s, 16); s += __shfl_xor(s, 32);
        if (fq == 0) red[wid * 64 + 16 * it + fr] = s; }
    __syncthreads();
#pragma unroll
    for (int it = 0; it < NI; ++it) { float tot = 0.f;
#pragma unroll
        for (int w = 0; w < 8; ++w) tot += red[w * 64 + 16 * it + fr];
        const float rs = __builtin_amdgcn_rsqf(tot * (1.0f / 256.0f) + EPS);
#pragma unroll
        for (int dt = 0; dt < 2; ++dt) { const int dv = dv0 + 16 * dt + 4 * fq;
            bf16_t* rp = P + (size_t)(row0 + 16 * it + fr) * GIN_LD + 2048 + h * 256 + dv;
            const u32x2 rr = *(const u32x2*)rp; const f32x4 hw = *(const f32x4*)(hn + dv);
            const float r0 = bflo(rr.x), r1 = bfhi(rr.x), r2 = bflo(rr.y), r3 = bfhi(rr.y);
            u32x2 w; w.x = pk2(o[dt][it][0] * rs * hw[0] * silu_f(r0), o[dt][it][1] * rs * hw[1] * silu_f(r1)); w.y = pk2(o[dt][it][2] * rs * hw[2] * silu_f(r2), o[dt][it][3] * rs * hw[3] * silu_f(r3));
            *(u32x2*)rp = w; }
    }
}
__device__ __forceinline__ void phase_gla_c(const Args& a, unsigned char* const ws_, float* const out_, LAS unsigned char* lds, int G, int bx, int wid, int lane) {
    bf16_t* P = (bf16_t*)(ws_ + WS_BIG);
    const bf16_t* SBP = (const bf16_t*)((unsigned char*)out_ + OS_SBUFP); const bf16_t* SBS = (const bf16_t*)(ws_ + WS_SBUFS);
    int par = 0;
    for (int it = bx; it < 1040 + 128; it += G, par ^= 1) {
        LAS unsigned char* abuf = lds + par * 16384; LAS float* red = (LAS float*)(lds + 32768 + par * 4096);
        if (it < 1040) { const int h = it & 3, c = (it >> 2) % NCH, b = it / 260, seq = b * 4 + h;
            gla_c_item<4>(abuf, red, P, c >= 1 ? SBP + (size_t)(seq * 64 + (c - 1)) * 32768 : nullptr, a.in[14], b * LPP + 64 * c, h, wid, lane);
        } else { const int j = it - 1040, h = j & 3, bs = j >> 2;
            gla_c_item<2>(abuf, red, P, SBS + (size_t)(bs * 4 + h) * 32768, a.in[14], ROWS_P + 32 * bs, h, wid, lane); }
    }
}

__device__ __forceinline__ void phase_mla_prep(const Args& a, unsigned char* const ws_, float* const out_, int gw, int NGW, int lane) {
    const float* DN = (const float*)((unsigned char*)out_ + OS_DN); bf16_t* KP = (bf16_t*)((unsigned char*)out_ + OS_KP);
    bf16_t* KS = (bf16_t*)(ws_ + WS_KS); bf16_t* CQB = (bf16_t*)(ws_ + WS_CQB); float* SSQ = (float*)(ws_ + WS_SS) + 7 * T;
    const f32x2* rt = (const f32x2*)(ws_ + WS_ROPE); const float* kvn = a.in[19];
    for (int row = gw; row < T; row += NGW) {
        const float* d = DN + (size_t)row * MDN_N;
        const f32x2 c0 = *(const f32x2*)(d + 6 * lane), c1 = *(const f32x2*)(d + 6 * lane + 2), c2 = *(const f32x2*)(d + 6 * lane + 4);
        const f32x4 kv = *(const f32x4*)(d + 384 + 4 * lane); const float kr = d[640 + lane];
        float sq = (c0.x * c0.x + c0.y * c0.y) + (c1.x * c1.x + c1.y * c1.y) + (c2.x * c2.x + c2.y * c2.y);
        float sk = (kv[0] * kv[0] + kv[1] * kv[1]) + (kv[2] * kv[2] + kv[3] * kv[3]);
        sq = wave_sum(sq); sk = wave_sum(sk);
        if (lane == 0) SSQ[row] = sq;
        unsigned* cq = (unsigned*)(CQB + (size_t)row * 384 + 6 * lane); cq[0] = pk2(c0.x, c0.y); cq[1] = pk2(c1.x, c1.y); cq[2] = pk2(c2.x, c2.y);
        const float rs = __builtin_amdgcn_rsqf(sk * (1.0f / 256.0f) + EPS); const f32x4 w = *(const f32x4*)(kvn + 4 * lane);
        const f32x4 lat = kv * rs * w;
        int pidx, valid; float* ol; float* orp; bf16_t* krow;
        if (row < ROWS_P) { const int b = row / LPP, p = row % LPP, t = p - 48; valid = p >= 48; pidx = valid ? t : 0;
            ol = out_ + OUT_LP + ((size_t)b * LP + pidx) * 256; orp = out_ + OUT_RP + ((size_t)b * LP + pidx) * 64; krow = KP + (size_t)row * KLD; }
        else { const int j = row - ROWS_P; valid = 1; pidx = LP + (j & 31); ol = out_ + OUT_LS + (size_t)j * 256; orp = out_ + OUT_RS + (size_t)j * 64; krow = KS + ((size_t)(j >> 5) * (PAST + SL) + PAST + (j & 31)) * KLD; }
        const float other = __shfl_xor(kr, 32); const f32x2 cs = rt[(size_t)pidx * 32 + (lane & 31)];
        const float ro = lane < 32 ? kr * cs.x - other * cs.y : kr * cs.x + other * cs.y;
        if (valid) { *(f32x4*)(ol + 4 * lane) = lat; orp[lane] = ro; }
        u32x2 lw; lw.x = pk2(lat[0], lat[1]); lw.y = pk2(lat[2], lat[3]); *(u32x2*)(krow + 4 * lane) = lw;
        krow[256 + lane] = (bf16_t)(pk2(ro, 0.f) & 0xffffu);
    }
    const float* clat = a.in[3]; const float* crope = a.in[4];
    for (int r = gw; r < SB * PAST + 32; r += NGW) {
        if (r < SB * PAST) { const int bs = r >> 11, k = r & (PAST - 1); bf16_t* kd = KS + ((size_t)bs * (PAST + SL) + k) * KLD;
            const f32x4 v = *(const f32x4*)(clat + (size_t)r * 256 + 4 * lane); const float rp = crope[(size_t)r * 64 + lane];
            u32x2 w; w.x = pk2(v[0], v[1]); w.y = pk2(v[2], v[3]); *(u32x2*)(kd + 4 * lane) = w; kd[256 + lane] = (bf16_t)(pk2(rp, 0.f) & 0xffffu);
        } else { bf16_t* kd = KS + ((size_t)SB * (PAST + SL) + (r - SB * PAST)) * KLD; *(u32x2*)(kd + 4 * lane) = (u32x2){0u, 0u}; kd[256 + lane] = 0; }
    }
}

constexpr int KROW = 640, KSTAGE = 64 * KROW;
__device__ __forceinline__ void glds16_asm(const void* gsrc, unsigned lds_dst) { unsigned keep;
    asm volatile("s_mov_b32 %0, m0\n\ts_mov_b32 m0, %2\n\ts_nop 0\n\tglobal_load_lds_dwordx4 %1, off\n\ts_mov_b32 m0, %0" : "=&s"(keep) : "v"(gsrc), "s"(lds_dst) : "memory"); }
__device__ __forceinline__ float xred_max(float v) {
    auto a = __builtin_amdgcn_permlane16_swap(__float_as_uint(v), __float_as_uint(v), false, false); v = fmaxf(__uint_as_float(a[0]), __uint_as_float(a[1]));
    auto b = __builtin_amdgcn_permlane32_swap(__float_as_uint(v), __float_as_uint(v), false, false); return fmaxf(__uint_as_float(b[0]), __uint_as_float(b[1]));
}
__device__ __forceinline__ float xred_sum(float v) {
    auto a = __builtin_amdgcn_permlane16_swap(__float_as_uint(v), __float_as_uint(v), false, false); v = __uint_as_float(a[0]) + __uint_as_float(a[1]);
    auto b = __builtin_amdgcn_permlane32_swap(__float_as_uint(v), __float_as_uint(v), false, false); return __uint_as_float(b[0]) + __uint_as_float(b[1]);
}
__device__ __forceinline__ void attn_unit(LAS unsigned char* lds, const bf16_t* Qb, const bf16_t* Kb, const bf16_t* WuvT, const f32x2* rope, bf16_t* Ob, int qrow0, int NT, int klo0, int khiL, int wid) {
    int lane; { int zz = 0; asm volatile("" : "+v"(zz)); lane = (int)__builtin_amdgcn_mbcnt_hi(~0u, __builtin_amdgcn_mbcnt_lo(~0u, 0u)) + zz; }
    const int fr = lane & 15, fq = lane >> 4, h = wid;
    bf16x8 qf[10];
    { const bf16_t* qp = Qb + ((size_t)(qrow0 >> 4) * 80 + h * 10) * 512 + lane * 8;
#pragma unroll
      for (int s = 0; s < 10; ++s) qf[s] = *(const bf16x8*)(qp + 512 * s);
      const int row = qrow0 + fr; int pidx;
      if (row < ROWS_P) { const int p = row % LPP; pidx = p >= 48 ? p - 48 : 0; } else pidx = LP + ((row - ROWS_P) & 31);
      const f32x2* cs = rope + (size_t)pidx * 32 + 8 * fq;
      float o1[8], o2[8];
#pragma unroll
      for (int j = 0; j < 8; ++j) { const f32x2 c = cs[j]; const float x1 = bf2f((unsigned short)qf[8][j]), x2 = bf2f((unsigned short)qf[9][j]); o1[j] = x1 * c.x - x2 * c.y; o2[j] = x2 * c.x + x1 * c.y; }
      u32x4 w1, w2; w1.x = pk2(o1[0], o1[1]); w1.y = pk2(o1[2], o1[3]); w1.z = pk2(o1[4], o1[5]); w1.w = pk2(o1[6], o1[7]);
      w2.x = pk2(o2[0], o2[1]); w2.y = pk2(o2[2], o2[3]); w2.z = pk2(o2[4], o2[5]); w2.w = pk2(o2[6], o2[7]);
      qf[8] = __builtin_bit_cast(bf16x8, w1); qf[9] = __builtin_bit_cast(bf16x8, w2); }
    f32x4 o[16];
#pragma unroll
    for (int d = 0; d < 16; ++d) o[d] = (f32x4){0.f, 0.f, 0.f, 0.f};
    float mrun = -INFINITY, lsum = 0.f;
    int crow[5], cdat[5];
#pragma unroll
    for (int i = 0; i < 5; ++i) { const int pos = (8 * i + wid) * 64 + lane; crow[i] = pos / 40; cdat[i] = (pos % 40) ^ (crow[i] & 6); }
#define ATT_DMA(t, stg) do { const unsigned sb_ = (unsigned)__builtin_amdgcn_readfirstlane((int)(unsigned)(unsigned long)((stg) + wid * 1024)); _Pragma("unroll") for (int i = 0; i < 5; ++i) \
        glds16_asm(Kb + ((size_t)(64 * (t) + crow[i]) * KLD + cdat[i] * 8), sb_ + i * 8192); } while (0)
    const int f6 = fr & 6;
    const int kbe = fr * KROW + ((fq ^ (f6 & 2)) * 16) + ((f6 & 4) ? 64 : 0), kbo = fr * KROW + ((fq ^ (f6 & 2)) * 16) - ((f6 & 4) ? 64 : 0);
    const int vrow = 4 * fq + (fr >> 2), g2 = (vrow & 6) >> 1;
    int vbs[4];
#pragma unroll
    for (int e = 0; e < 4; ++e) vbs[e] = vrow * KROW + 32 * (e ^ g2) + 16 * ((fr >> 1) & 1) + 8 * (fr & 1);
    bf16x8 pf[2] = {(bf16x8){0, 0, 0, 0, 0, 0, 0, 0}, (bf16x8){0, 0, 0, 0, 0, 0, 0, 0}};
    auto qk_sm = [&](LAS unsigned char* stg, int klo, int khi, bool masked) {
        f32x4 st[4];
#pragma unroll
        for (int Tt = 0; Tt < 4; ++Tt) st[Tt] = (f32x4){0.f, 0.f, 0.f, 0.f};
        const LAS unsigned char* kE = stg + kbe; const LAS unsigned char* kO = stg + kbo;
        constexpr int KD = 3;
        bf16x8 kf[KD][4];
#define ATT_KLOAD(s) do { _Pragma("unroll") for (int Tt = 0; Tt < 4; ++Tt) kf[(s) % KD][Tt] = *(const LAS bf16x8*)((((s) & 1) ? kO : kE) + Tt * (16 * KROW) + (s) * 64); } while (0)
#pragma unroll
        for (int s = 0; s < KD - 1; ++s) ATT_KLOAD(s);
#pragma unroll
        for (int s = 0; s < 10; ++s) {
            if (s + KD - 1 < 10) ATT_KLOAD(s + KD - 1);
#pragma unroll
            for (int Tt = 0; Tt < 4; ++Tt) st[Tt] = mfma16(kf[s % KD][Tt], qf[s], st[Tt]);
            __builtin_amdgcn_sched_barrier(0);
        }
#undef ATT_KLOAD
        if (masked) {
#pragma unroll
            for (int Tt = 0; Tt < 4; ++Tt)
#pragma unroll
                for (int r = 0; r < 4; ++r) { const int kk = 16 * Tt + 4 * fq + r; if (kk < klo || kk >= khi) st[Tt][r] = -INFINITY; }
        }
        if (ATT_P1) {
            f32x4 s2[4];
#pragma unroll
            for (int Tt = 0; Tt < 4; ++Tt) { s2[Tt] = st[Tt]; asm volatile("" : "+v"(s2[Tt])); }
            float m2 = fmaxf(fmaxf(s2[0][0], s2[0][1]), fmaxf(s2[0][2], s2[0][3]));
#pragma unroll
            for (int Tt = 1; Tt < 4; ++Tt) m2 = fmaxf(m2, fmaxf(fmaxf(s2[Tt][0], s2[Tt][1]), fmaxf(s2[Tt][2], s2[Tt][3])));
            m2 = xred_max(m2); float p2 = 0.f;
#pragma unroll
            for (int Tt = 0; Tt < 4; ++Tt)
#pragma unroll
                for (int r = 0; r < 4; ++r) { s2[Tt][r] = fexp2(s2[Tt][r] - m2); p2 += s2[Tt][r]; }
            unsigned q2 = 0;
#pragma unroll
            for (int s = 0; s < 2; ++s) { q2 ^= pk2(s2[2 * s][0], s2[2 * s][1]) ^ pk2(s2[2 * s][2], s2[2 * s][3]) ^ pk2(s2[2 * s + 1][0], s2[2 * s + 1][1]) ^ pk2(s2[2 * s + 1][2], s2[2 * s + 1][3]); }
            asm volatile("" :: "v"(p2), "v"(q2));
        }
        float mx = fmaxf(fmaxf(st[0][0], st[0][1]), fmaxf(st[0][2], st[0][3]));
#pragma unroll
        for (int Tt = 1; Tt < 4; ++Tt) mx = fmaxf(mx, fmaxf(fmaxf(st[Tt][0], st[Tt][1]), fmaxf(st[Tt][2], st[Tt][3])));
        mx = xred_max(mx);
        if (__any(mx > mrun + 8.0f)) {
            const float mnew = fmaxf(mrun, mx), alpha = fexp2(mrun - mnew); mrun = mnew;
            lsum *= alpha;
#pragma unroll
            for (int d = 0; d < 16; ++d) o[d] = o[d] * alpha;
        }
        float ps = 0.f;
#pragma unroll
        for (int Tt = 0; Tt < 4; ++Tt)
#pragma unroll
            for (int r = 0; r < 4; ++r) { st[Tt][r] = fexp2(st[Tt][r] - mrun); ps += st[Tt][r]; }
        lsum += ps;
#pragma unroll
        for (int s = 0; s < 2; ++s) { u32x4 w; w.x = pk2(st[2 * s][0], st[2 * s][1]); w.y = pk2(st[2 * s][2], st[2 * s][3]); w.z = pk2(st[2 * s + 1][0], st[2 * s + 1][1]); w.w = pk2(st[2 * s + 1][2], st[2 * s + 1][3]); pf[s] = __builtin_bit_cast(bf16x8, w); }
    };
    auto pv = [&](LAS unsigned char* stg) {
        constexpr int VD = 4;
        s16x4 vl[VD], vh[VD];
#define ATT_VLOAD(p) do { const int d_ = (p) >> 1, s_ = (p) & 1; \
            vl[(p) % VD] = __builtin_bit_cast(s16x4, __builtin_amdgcn_ds_read_tr16_b64_v4i16((LAS s16x4*)(stg + vbs[d_ & 3] + (32 * s_) * KROW + (d_ >> 2) * 128))); \
            vh[(p) % VD] = __builtin_bit_cast(s16x4, __builtin_amdgcn_ds_read_tr16_b64_v4i16((LAS s16x4*)(stg + vbs[d_ & 3] + (32 * s_ + 16) * KROW + (d_ >> 2) * 128))); } while (0)
#pragma unroll
        for (int p = 0; p < VD; ++p) ATT_VLOAD(p);
#pragma unroll
        for (int p = 0; p < 32; ++p) {
            const s16x4 lo = vl[p % VD], hi = vh[p % VD];
            const bf16x8 vf = (bf16x8){lo[0], lo[1], lo[2], lo[3], hi[0], hi[1], hi[2], hi[3]};
            o[p >> 1] = mfma16(vf, pf[p & 1], o[p >> 1]);
            if (p + VD < 32) ATT_VLOAD(p + VD);
            __builtin_amdgcn_sched_barrier(0);
        }
#undef ATT_VLOAD
    };
    ATT_DMA(0, lds);
    if (NT > 1) { ATT_DMA(1, lds + KSTAGE); asm volatile("s_waitcnt vmcnt(5)" ::: "memory"); } else asm volatile("s_waitcnt vmcnt(0)" ::: "memory");
    __syncthreads();
    int sc = 0;
    for (int t = 0; t < NT; ++t) {
        const int sn = sc == 2 ? 0 : sc + 1, sp = sc == 0 ? 2 : sc - 1;
        const bool more = t + 2 < NT;
        if (more) ATT_DMA(t + 2, lds + sp * KSTAGE);
        const bool msk = (t == 0 && klo0 > 0) || (t == NT - 1 && khiL < 64);
        const int klo = t == 0 ? klo0 : 0, khi = t == NT - 1 ? khiL : 64;
        qk_sm(lds + sc * KSTAGE, klo, khi, msk);
        pv(lds + sc * KSTAGE);
        if (more) asm volatile("s_waitcnt vmcnt(5)" ::: "memory"); else asm volatile("s_waitcnt vmcnt(0)" ::: "memory");
        __syncthreads();
        sc = sn;
    }
#undef ATT_DMA
    lsum = xred_sum(lsum);
    const float inv = frcp(lsum);
    bf16x8 bfr[8];
#pragma unroll
    for (int s = 0; s < 8; ++s) { u32x4 w; w.x = pk2(o[2 * s][0] * inv, o[2 * s][1] * inv); w.y = pk2(o[2 * s][2] * inv, o[2 * s][3] * inv); w.z = pk2(o[2 * s + 1][0] * inv, o[2 * s + 1][1] * inv); w.w = pk2(o[2 * s + 1][2] * inv, o[2 * s + 1][3] * inv); bfr[s] = __builtin_bit_cast(bf16x8, w); }
    const bf16_t* wu = WuvT + (size_t)h * 32768 + lane * 8;
    bf16_t* op = Ob + (size_t)(qrow0 + fr) * DM + h * 128 + 4 * fq;
    bf16x8 wa[2][16];
#define EP_LOAD(g) do { _Pragma("unroll") for (int i = 0; i < 16; ++i) wa[(g) & 1][i] = *(const bf16x8*)(wu + ((g) * 16 + i) * 512); } while (0)
#define EP_COMP(g) do { _Pragma("unroll") for (int vv = 0; vv < 2; ++vv) { f32x4 acc = (f32x4){0.f, 0.f, 0.f, 0.f}; \
        _Pragma("unroll") for (int s = 0; s < 8; ++s) acc = mfma16(wa[(g) & 1][vv * 8 + s], bfr[s], acc); \
        u32x2 w; w.x = pk2(acc[0], acc[1]); w.y = pk2(acc[2], acc[3]); *(u32x2*)(op + 16 * (2 * (g) + vv)) = w; } } while (0)
    EP_LOAD(0); EP_LOAD(1); __builtin_amdgcn_sched_barrier(0);
    EP_COMP(0); __builtin_amdgcn_sched_barrier(0); EP_LOAD(2); __builtin_amdgcn_sched_barrier(0);
    EP_COMP(1); __builtin_amdgcn_sched_barrier(0); EP_LOAD(3); __builtin_amdgcn_sched_barrier(0);
    EP_COMP(2); __builtin_amdgcn_sched_barrier(0); EP_COMP(3);
#undef EP_LOAD
#undef EP_COMP
}
__device__ __forceinline__ void phase_attn(const Args& a, unsigned char* const ws_, float* const out_, LAS unsigned char* lds, int G, int bx, int tid, int wid, int lane) {
    const bf16_t* Qb = (const bf16_t*)(ws_ + WS_BIG); const bf16_t* KP = (const bf16_t*)((unsigned char*)out_ + OS_KP); const bf16_t* KS = (const bf16_t*)(ws_ + WS_KS);
    const bf16_t* WU = (const bf16_t*)(ws_ + WS_WUVT); bf16_t* Ob = (bf16_t*)((unsigned char*)out_ + OS_DN);
    for (int rd = 0;; ++rd) {
        const int j = (rd & 1) ? (rd + 1) * G - 1 - bx : rd * G + bx;
        if (rd * G >= 1092) break;
        if (j >= 1092) continue;
        const bf16_t* Kb; int qrow0, NT, klo0, khiL;
        if (j >= 512 && j < 576) { const int s = j - 512, bs = s >> 1, half = s & 1; Kb = KS + (size_t)bs * (PAST + SL) * KLD; qrow0 = ROWS_P + 32 * bs + 16 * half; NT = 33; klo0 = 0; khiL = 32; }
        else {
            int b, m, qt;
            if (j < 512) { m = 64 - (j >> 4); b = (j & 15) >> 2; qt = j & 3; }
            else if (j < 1088) { const int jj = j - 576; m = 32 - (jj >> 4); b = (jj & 15) >> 2; qt = jj & 3; }
            else { m = 0; b = j - 1088; qt = 3; }
            Kb = KP + (size_t)b * LPP * KLD; qrow0 = b * LPP + 64 * m + 16 * qt; NT = m + 1; klo0 = 48; khiL = 64;
        }
        attn_unit(lds, Qb, Kb, WU, (const f32x2*)(ws_ + WS_ROPE), Ob, qrow0, NT, klo0, khiL, wid);
    }
}

__device__ __forceinline__ void phase_final(const Args& a, unsigned char* const ws_, float* const out_, int gw, int NGW, int lane) {
    const float* H = (const float*)(ws_ + WS_H); const float* SS = (const float*)(ws_ + WS_SS) + 6 * T; const float* fn = a.in[27];
    for (int row = gw; row < T; row += NGW) {
        float* dst;
        if (row < ROWS_P) { const int b = row / LPP, p = row % LPP; if (p < 64) continue; dst = out_ + OUT_YP + ((size_t)b * SEQ + (p - 64)) * DM; }
        else dst = out_ + OUT_YS + (size_t)(row - ROWS_P) * DM;
        const float rs = __builtin_amdgcn_rsqf(SS[row] * (1.0f / DM) + EPS);
#pragma unroll
        for (int j = 0; j < 4; ++j) { f32x4 v; const f32x4 w = *(const f32x4*)(fn + 256 * j + 4 * lane);
            if (RESID_BF16) { const u32x2 hv = *(const u32x2*)((const bf16_t*)(ws_ + WS_HB) + (size_t)row * DM + 256 * j + 4 * lane); v = (f32x4){bflo(hv.x), bfhi(hv.x), bflo(hv.y), bfhi(hv.y)}; }
            else v = *(const f32x4*)(H + (size_t)row * DM + 256 * j + 4 * lane);
            *(f32x4*)(dst + 256 * j + 4 * lane) = v * rs * w; }
    }
}

__device__ __forceinline__ void resid_fix(const pg8::SplitOrder& S, float* H, bf16_t* HB, float* ssn, float scale, const unsigned char* part, int gw, int NGW, int lane) {
    if (S.S <= 1) return;
    const int nitem = S.rem * 128, fr = lane & 15, fq = lane >> 4;
    for (int it = gw; it < nitem; it += NGW) {
        const int j = it >> 7, q = it & 127, w = q >> 4, ai = (q >> 3) & 1, m = (q >> 1) & 3, bj = q & 1; int pm, pn; S.tile(S.full * S.G + j, pm, pn);
        const unsigned char* p = part + (size_t)(j * S.S) * 131072 + (size_t)q * 1024 + lane * 16;
        f32x4 a0 = {0.f, 0.f, 0.f, 0.f}, a1 = {0.f, 0.f, 0.f, 0.f};
#define RF_ACC(v) do { a0[0] += bflo(v.x); a0[1] += bfhi(v.x); a0[2] += bflo(v.y); a0[3] += bfhi(v.y); a1[0] += bflo(v.z); a1[1] += bfhi(v.z); a1[2] += bflo(v.w); a1[3] += bfhi(v.w); } while (0)
        int s = 0;
        for (; s + 4 <= S.S; s += 4) { const u32x4 x0 = *(const u32x4*)(p + (size_t)s * 131072), x1 = *(const u32x4*)(p + (size_t)(s + 1) * 131072), x2 = *(const u32x4*)(p + (size_t)(s + 2) * 131072), x3 = *(const u32x4*)(p + (size_t)(s + 3) * 131072);
            RF_ACC(x0); RF_ACC(x1); RF_ACC(x2); RF_ACC(x3); }
        for (; s < S.S; ++s) { const u32x4 x0 = *(const u32x4*)(p + (size_t)s * 131072); RF_ACC(x0); }
#undef RF_ACC
        const int row = pm * 256 + ai * 128 + (w >> 2) * 64 + m * 16 + fr;
        const size_t off = (size_t)row * DM + pn * 256 + bj * 128 + (w & 3) * 32 + 4 * fq;
        f32x4 v0, v1;
        if (RESID_BF16) { const u32x2 h0 = *(const u32x2*)(HB + off), h1 = *(const u32x2*)(HB + off + 16);
            v0 = (f32x4){bflo(h0.x), bfhi(h0.x), bflo(h0.y), bfhi(h0.y)} + a0 * scale; v1 = (f32x4){bflo(h1.x), bfhi(h1.x), bflo(h1.y), bfhi(h1.y)} + a1 * scale; }
        else { v0 = *(const f32x4*)(H + off) + a0 * scale; v1 = *(const f32x4*)(H + off + 16) + a1 * scale; *(f32x4*)(H + off) = v0; *(f32x4*)(H + off + 16) = v1; }
        u32x2 w0; w0.x = pk2(v0[0], v0[1]); w0.y = pk2(v0[2], v0[3]); *(u32x2*)(HB + off) = w0;
        u32x2 w1; w1.x = pk2(v1[0], v1[1]); w1.y = pk2(v1[2], v1[3]); *(u32x2*)(HB + off + 16) = w1;
        float sq = ((v0[0] * v0[0] + v0[1] * v0[1]) + (v0[2] * v0[2] + v0[3] * v0[3])) + ((v1[0] * v1[0] + v1[1] * v1[1]) + (v1[2] * v1[2] + v1[3] * v1[3]));
        sq += __shfl_xor(sq, 16); sq += __shfl_xor(sq, 32);
        if (fq == 0) atomicAdd(ssn + row, sq);
    }
}

constexpr int NPHASE = 20;
constexpr int LDS_BYTES = 147456;
__global__ void __launch_bounds__(512, 2) mk_fwd(Args args0) {
    __shared__ __attribute__((aligned(16))) unsigned char lds_raw[LDS_BYTES];
    LAS unsigned char* lds = (LAS unsigned char*)lds_raw;
    const int tid0 = threadIdx.x; const int wave0 = __builtin_amdgcn_readfirstlane(tid0 >> 6);
    const int G0 = gridDim.x, bx0 = blockIdx.x;
    unsigned char* ws0 = args0.ws;
    volatile LAS unsigned* MISC = (volatile LAS unsigned*)(lds + 131072 + 8192);
    if (tid0 < 16) MISC[tid0] = 0u;
    __syncthreads();
    XcdBarrier bar; bar.bar = (unsigned*)(ws0 + WS_CTL) + CW_BAR; bar.x = 0; bar.st = nullptr;
    const bool one_launch = (args0.ph_hi - args0.ph_lo) > 1;
    if (one_launch) bar = xcd_barrier_post((unsigned*)(ws0 + WS_CTL) + CW_BAR, MISC + 8);

    const int nsteps = (args0.ph_hi - args0.ph_lo) + (one_launch ? __builtin_popcount(DUP_MASK) : 0);
    for (int step = 0; step < nsteps; ++step) {
        int ph = args0.ph_lo + step;
        if (DUP_MASK != 0u && one_launch) { int p = 0, accn = 0; for (;;) { const int cnt = 1 + (int)((DUP_MASK >> p) & 1u); if (step < accn + cnt) break; accn += cnt; ++p; } ph = p; }
        long z = 0; int bx = bx0, G = G0;
        asm volatile("" : "+s"(z), "+s"(bx), "+s"(G));
        const int NGW = G * 8;
        unsigned char* ws = ws0 + z; float* outp = args0.out + z;
        int lane = (int)__builtin_amdgcn_mbcnt_hi(~0u, __builtin_amdgcn_mbcnt_lo(~0u, 0u)) + (int)z;
        const int wave = wave0, tid = wave * 64 + lane;
        const int vcu = (G % 8 == 0) ? (bx % 8) * (G / 8) + bx / 8 : bx, gw = vcu * 8 + wave;
        float* SS = (float*)(ws + WS_SS);
        float* H = (float*)(ws + WS_H); bf16_t* HB = (bf16_t*)(ws + WS_HB); bf16_t* BIG = (bf16_t*)(ws + WS_BIG);
        switch (ph) {
        case 0: phase_prep(args0, ws, outp, lds, gw, NGW, wave, lane); break;
        case 1: case 8: case 10: case 17: {
            const int fi = ph == 1 ? 0 : ph == 8 ? 1 : ph == 10 ? 2 : 3;
            const int ssi = ph == 1 ? 0 : ph == 8 ? 2 : ph == 10 ? 3 : 5;
            pg8::Gemm g{HB, (const bf16_t*)(ws + ws_wup(fi)), T, 5632, DM, DM};
            pg8::StaticOrder S; S.init(T, 5632, G, bx);
            pg8::EpiSwiglu E{BIG, SS + (size_t)ssi * T};
            pg8::gemm_phase<pg8::EpiSwiglu, pg8::StaticOrder, true>(lds, g, S, E, tid);
        } break;
        case 2: case 9: case 11: case 18: case 7: case 16: {
            const bf16_t* A; const bf16_t* Bt; int K, lda, sso; float scale;
            if (ph == 7) { A = BIG + 2048; lda = GIN_LD; K = DM; Bt = (const bf16_t*)(ws + WS_WGOUT); sso = 2; scale = 1.0f; }
            else if (ph == 16) { A = (const bf16_t*)((unsigned char*)outp + OS_DN); lda = DM; K = DM; Bt = (const bf16_t*)(ws + WS_WMOUT); sso = 5; scale = 1.0f; }
            else { const int fi = ph == 2 ? 0 : ph == 9 ? 1 : ph == 11 ? 2 : 3; A = BIG; lda = DFF; K = DFF; Bt = (const bf16_t*)(ws + ws_wdn(fi)); sso = ph == 2 ? 1 : ph == 9 ? 3 : ph == 11 ? 4 : 6; scale = 0.5f; }
            unsigned char* part = ph == 16 ? (unsigned char*)BIG : (unsigned char*)outp;
            pg8::Gemm g{A, Bt, T, DM, K, lda};
            pg8::SplitOrder S; S.init(T, DM, K, G, bx);
            unsigned* cnt = (unsigned*)(ws + WS_CTL) + CW_SPLIT + ph;
            pg8::EpiResid E{H, HB, SS + (size_t)sso * T, scale, part, cnt};
            pg8::gemm_phase<pg8::EpiResid, pg8::SplitOrder, true>(lds, g, S, E, tid);
            if (S.S > 1) {
                if (tid == 0) { const unsigned need = (unsigned)(S.rem * S.S); unsigned sp = 0;
                    while (__hip_atomic_load(cnt, __ATOMIC_RELAXED, __HIP_MEMORY_SCOPE_AGENT) < need) { __builtin_amdgcn_s_sleep(2); if (++sp > (1u << 22)) break; }
                    __builtin_amdgcn_fence(__ATOMIC_ACQUIRE, "agent"); }
                __syncthreads();
                resid_fix(S, H, HB, SS + (size_t)sso * T, scale, part, gw, NGW, lane);
            }
        } break;
        case 3: {
            pg8::Gemm g{HB, (const bf16_t*)(ws + WS_WGIN), T, GIN_N, DM, DM};
            pg8::StaticOrder S; S.init(T, GIN_N, G, bx);
            pg8::EpiScaleBf16 E{BIG, GIN_LD, SS + (size_t)1 * T};
            pg8::gemm_phase<pg8::EpiScaleBf16, pg8::StaticOrder, true>(lds, g, S, E, tid);
        } break;
        case 4: phase_gla_a(args0, ws, outp, lds, G, bx, tid); break;
        case 5: phase_gla_b(args0, ws, outp, lds, G, vcu, gw, NGW, wave, lane); break;
        case 6: phase_gla_c(args0, ws, outp, lds, G, bx, wave, lane); break;
        case 12: {
            pg8::Gemm g{HB, (const bf16_t*)(ws + WS_WMDN), T, MDN_N, DM, DM};
            pg8::StaticOrder S; S.init(T, MDN_N, G, bx);
            pg8::EpiScaleF32 E{(float*)((unsigned char*)outp + OS_DN), MDN_N, SS + (size_t)4 * T};
            pg8::gemm_phase<pg8::EpiScaleF32, pg8::StaticOrder, true>(lds, g, S, E, tid);
        } break;
        case 13: phase_mla_prep(args0, ws, outp, gw, NGW, lane); break;
        case 14: {
            pg8::Gemm g{(const bf16_t*)(ws + WS_CQB), (const bf16_t*)(ws + WS_WQ), T, QN, 384, 384};
            pg8::StaticOrder S; S.init(T, QN, G, bx);
            pg8::EpiQ E{BIG, SS + (size_t)7 * T, 0.07216878364870322f * LOG2E};
            pg8::gemm_phase<pg8::EpiQ, pg8::StaticOrder, true>(lds, g, S, E, tid);
        } break;
        case 15: phase_attn(args0, ws, outp, lds, G, bx, tid, wave, lane); break;
        case 19: phase_final(args0, ws, outp, gw, NGW, lane); break;
        default: break;
        }
        if (step + 1 < nsteps) xcd_barrier(bar);
    }
}

extern "C" void kernel_launch(void* const* d_in, const int* in_sizes, int n_in, void* d_out, int out_size, void* d_ws, size_t ws_size, hipStream_t stream) {
    static int grid = 0;
    if (grid == 0) {
        if (n_in != 28 || out_size != (int)OUT_END || ws_size < WS_END) { fprintf(stderr, "kernel_launch: unexpected sizes n_in %d out %d ws %zu (need %zu)\n", n_in, out_size, ws_size, (size_t)WS_END); grid = -1; return; }
        int dev = 0, cus = 0;
        if (hipGetDevice(&dev) != hipSuccess || hipDeviceGetAttribute(&cus, hipDeviceAttributeMultiprocessorCount, dev) != hipSuccess || cus < 8) { fprintf(stderr, "kernel_launch: device query failed\n"); grid = -1; return; }
        grid = cus;
    }
    if (grid < 0) return;
    (void)hipMemsetAsync((char*)d_ws + WS_CTL, 0, CTL_ZERO_BYTES, stream);
    Args a{};
    for (int i = 0; i < 28; ++i) a.in[i] = (const float*)d_in[i];
    a.out = (float*)d_out; a.ws = (unsigned char*)d_ws;
#if MK_N_LAUNCHES == 1
    a.ph_lo = 0; a.ph_hi = NPHASE;
    hipLaunchKernelGGL(mk_fwd, dim3(grid), dim3(512), 0, stream, a);
#else
    for (int p = 0; p < NPHASE; ++p) { a.ph_lo = p; a.ph_hi = p + 1; hipLaunchKernelGGL(mk_fwd, dim3(grid), dim3(512), 0, stream, a); }
#endif
}
```

```cpp
#include <hip/hip_runtime.h>
#include <cstdio>
#include <cstdint>

#ifndef MK_N_LAUNCHES
#define MK_N_LAUNCHES 1
#endif

#ifndef GB_P1
#define GB_P1 0
#endif
#ifndef GB_P2
#define GB_P2 0
#endif
#ifndef ATT_P1
#define ATT_P1 0
#endif
#ifndef ATT_P2
#define ATT_P2 0
#endif
#ifndef ATT_P3
#define ATT_P3 0
#endif
#ifndef ATT_PROBEBASE
#define ATT_PROBEBASE 0
#endif
#ifndef ATT_DUPQK
#define ATT_DUPQK 0
#endif
#ifndef ATT_DUPPV
#define ATT_DUPPV 0
#endif
#ifndef RESID_BF16
#define RESID_BF16 1
#endif
#ifndef DUP_MASK
#define DUP_MASK 0u
#endif

#define LAS __attribute__((address_space(3)))
#define GAS __attribute__((address_space(1)))
typedef unsigned short bf16_t;
typedef short bf16x8 __attribute__((ext_vector_type(8)));
typedef short s16x4 __attribute__((ext_vector_type(4)));
typedef float f32x4 __attribute__((ext_vector_type(4)));
typedef float f32x2 __attribute__((ext_vector_type(2)));
typedef unsigned u32x4 __attribute__((ext_vector_type(4)));
typedef unsigned u32x2 __attribute__((ext_vector_type(2)));
typedef __bf16 bf16x2_t __attribute__((ext_vector_type(2)));

constexpr int DM = 1024, DFF = 2816, NB = 4, SEQ = 4096, NMETA = 16, LP = 4112, LPP = 4160, NCH = 65;
constexpr int SB = 32, SL = 32, PAST = 2048;
constexpr int ROWS_P = NB * LPP;
constexpr int T = ROWS_P + SB * SL;
constexpr int GIN_N = 3328, GIN_LD = 3328;
constexpr int MDN_N = 768;
constexpr int QN = 2560, QLD = 2560;
constexpr int KLD = 320;
constexpr float EPS = 1e-6f;
constexpr float LOG2E = 1.4426950408889634f;

constexpr size_t OUT_YP = 0, OUT_YS = 16777216, OUT_GP = 17825792, OUT_GS = 18350080, OUT_LP = 22544384, OUT_RP = 26755072, OUT_LS = 27807744, OUT_RS = 28069888, OUT_END = 28135424;
constexpr size_t MiB = 1u << 20;
constexpr size_t OS_SBUFP = 0;
constexpr size_t OS_DN = 0;
constexpr size_t OS_KP = 52 * MiB;

constexpr size_t WS_CTL = 0, CTL_ZERO_BYTES = 1 * MiB;
constexpr size_t WS_SS = 256 * 1024;
constexpr size_t WS_L0 = 1 * MiB;
constexpr size_t WS_KS = WS_L0;
constexpr size_t WS_WGIN = WS_L0 + 33 * MiB;
constexpr size_t WS_WGOUT = WS_WGIN + 6 * MiB + 512 * 1024;
constexpr size_t WS_L1 = 43 * MiB;
constexpr size_t WS_WMDN = WS_L1 + 33 * MiB;
constexpr size_t WS_WMOUT = WS_WMDN + 1 * MiB + 512 * 1024;
constexpr size_t WS_WQ = WS_WMOUT + 2 * MiB;
constexpr size_t WS_WUVT = WS_WQ + 2 * MiB;
constexpr size_t WS_ROPE = WS_WUVT + 512 * 1024;
constexpr size_t WS_DEC = WS_ROPE + 1 * MiB + 256 * 1024;
constexpr size_t WS_SBUFS = WS_DEC + 1 * MiB;
__host__ __device__ constexpr size_t ws_wup(int fi) { return (fi < 2 ? WS_L0 : WS_L1) + (size_t)(fi & 1) * 11 * MiB; }
__host__ __device__ constexpr size_t ws_wdn(int fi) { return (fi < 2 ? WS_L0 : WS_L1) + 22 * MiB + (size_t)(fi & 1) * (5 * MiB + 512 * 1024); }
static_assert((size_t)(SB * (PAST + SL) + 32) * KLD * 2 <= 41 * MiB + 512 * 1024, "KS fits the layer-0 weight block");
constexpr size_t WS_H = WS_SBUFS + 8 * MiB;
constexpr size_t WS_HB = WS_H + 69 * MiB;
constexpr size_t WS_BIG = WS_HB + 34 * MiB + 512 * 1024;
constexpr size_t WS_CQB = WS_BIG + 87 * MiB;
constexpr size_t WS_END = WS_BIG + 112 * MiB + 128 * 1024;
static_assert(WS_CQB + 13 * MiB <= WS_END, "ws map");
static_assert((size_t)T * QLD * 2 <= 87 * MiB, "Q fits");

constexpr int CW_BAR = 4096;
constexpr int CW_SPLIT = 8192;

__device__ __forceinline__ unsigned pk2(float lo, float hi) { f32x2 v = {lo, hi}; bf16x2_t b = __builtin_convertvector(v, bf16x2_t); return __builtin_bit_cast(unsigned, b); }
__device__ __forceinline__ float bf2f(unsigned short x) { return __uint_as_float((unsigned)x << 16); }
__device__ __forceinline__ float bflo(unsigned x) { return __uint_as_float(x << 16); }
__device__ __forceinline__ float bfhi(unsigned x) { return __uint_as_float(x & 0xffff0000u); }
__device__ __forceinline__ float wave_sum(float v) {
#pragma unroll
    for (int o = 1; o < 64; o <<= 1) v += __shfl_xor(v, o);
    return v;
}
__device__ __forceinline__ float fexp2(float x) { return __builtin_amdgcn_exp2f(x); }
__device__ __forceinline__ float frcp(float x) { return __builtin_amdgcn_rcpf(x); }
__device__ __forceinline__ float silu_f(float g) { return g * frcp(1.0f + fexp2(-g * LOG2E)); }
__device__ __forceinline__ f32x4 mfma16(bf16x8 a, bf16x8 b, f32x4 c) { return __builtin_amdgcn_mfma_f32_16x16x32_bf16(a, b, c, 0, 0, 0); }

namespace pg8 {
constexpr int BM = 256, BK = 64, HALF = 128, HTB = HALF * BK * 2, STAGE_BYTES = 8 * HTB, NXCD = 8, WGM = 8;
__host__ __device__ __forceinline__ int lds_byte(int r, int c) { const int st = (r >> 4) * 2 + (c >> 5), rr = r & 15, cc = c & 31, ob = rr * 64 + cc * 2; return st * 1024 + (ob ^ (((ob >> 9) & 1) << 5)); }
__host__ __device__ __forceinline__ void stage_rc(int b, int& R, int& C) { const int st = b / 1024, sb = b % 1024, swz = sb ^ (((sb >> 9) & 1) << 5); R = (st >> 1) * 16 + swz / 64; C = (st & 1) * 32 + (swz % 64) / 2; }
__host__ __device__ __forceinline__ int perm32(int rho) { const int n = rho >> 4, i = rho & 15; return 8 * (i >> 2) + 4 * n + (i & 3); }

struct Unit { int pm, pn, k0, nt, part; };
struct Gemm { const bf16_t* A; const bf16_t* Bt; int M, N, K, lda; };

struct StaticOrder {
    static constexpr bool SPLIT = false;
    int nM, nN, nwg, G, c;
    __device__ void init(int M, int N, int G_, int c_) { nM = M / BM; nN = N / BM; nwg = nM * nN; G = G_; c = c_; }
    __device__ bool next(int i, Unit& u) const {
        const long L = (long)i * G + c; if (L >= nwg) return false;
        int wgid = (int)L; { const int q = nwg / NXCD, r = nwg % NXCD, xcd = wgid % NXCD, off = wgid / NXCD; wgid = (xcd < r ? xcd * (q + 1) : r * (q + 1) + (xcd - r) * q) + off; }
        const int nig = WGM * nN, gid = wgid / nig, fm = gid * WGM, gsz = (nM - fm) < WGM ? (nM - fm) : WGM;
        u.pm = fm + ((wgid % nig) % gsz); u.pn = (wgid % nig) / gsz; return true;
    }
};

struct SplitOrder {
    static constexpr bool SPLIT = true;
    int nM, nN, nwg, G, c, full, rem, S, ntf, per;
    __device__ void init(int M, int N, int K, int G_, int c_) {
        nM = M / BM; nN = N / BM; nwg = nM * nN; G = G_; c = c_; full = nwg / G; rem = nwg % G; ntf = K / BK; S = 1;
        if (rem > 0) { const int pairs = ntf / 2, lim = G / rem; for (int d = 2; d <= pairs && d <= lim; ++d) if (pairs % d == 0) S = d; }
        per = ntf / S;
    }
    __device__ void tile(int L, int& pm, int& pn) const {
        int wgid = L; { const int q = nwg / NXCD, r = nwg % NXCD, xcd = wgid % NXCD, off = wgid / NXCD; wgid = (xcd < r ? xcd * (q + 1) : r * (q + 1) + (xcd - r) * q) + off; }
        const int nig = WGM * nN, gid = wgid / nig, fm = gid * WGM, gsz = (nM - fm) < WGM ? (nM - fm) : WGM;
        pm = fm + ((wgid % nig) % gsz); pn = (wgid % nig) / gsz;
    }
    __device__ bool next(int i, Unit& u) const {
        int r = i;
        if (S > 1 && c < rem * S) {
            if (i == 0) { const int j = c / S, s = c - j * S; tile(full * G + j, u.pm, u.pn); u.k0 = s * per; u.nt = per; u.part = c; return true; }
            r = i - 1;
        }
        if (r < full) { tile(r * G + c, u.pm, u.pn); u.k0 = 0; u.nt = ntf; u.part = -1; return true; }
        if (S == 1 && r == full && c < rem) { tile(full * G + c, u.pm, u.pn); u.k0 = 0; u.nt = ntf; u.part = -1; return true; }
        return false;
    }
};

template <class Epi, class Sched, bool ALIGN_EPI>
__device__ __forceinline__ void gemm_phase(LAS unsigned char* lds, const Gemm g, const Sched& S, const Epi& E, const int tid) {
    const int wid = __builtin_amdgcn_readfirstlane(tid >> 6), lane = tid & 63, wr = wid >> 2, wc = wid & 3, fr = lane & 15, fq = lane >> 4;
    int K_ = g.K, lda_ = g.lda; asm volatile("" : "+s"(K_), "+s"(lda_));
    const int K = K_, lda = lda_, nt = K / BK;
    unsigned voffA[2], voffB[2];
#pragma unroll
    for (int i = 0; i < 2; ++i) { int R, C; stage_rc(tid * 16 + i * 8192, R, C); const int Rb = Epi::PERM ? ((R & ~31) + perm32(R & 31)) : R;
        voffA[i] = (unsigned)(R * lda + C) * 2u; voffB[i] = (unsigned)(Rb * K + C) * 2u; }
    const size_t kstep = (size_t)(BK * 2);
    const size_t hstepA = (size_t)HALF * lda * 2, hstepB = (size_t)HALF * K * 2;
    const size_t tstepA = 2 * hstepA, tstepB = 2 * hstepB;
    const unsigned ldsw = (unsigned)wid * 1024u;
    const int aoff = lds_byte(wr * 64 + fr, fq * 8), boff = lds_byte(wc * 32 + fr, fq * 8);
#define PG8_SA(b, h) (((b) * 2 + (h)) * HTB)
#define PG8_SB(b, h) ((4 + (b) * 2 + (h)) * HTB)
#define PG8_STAGE(bufoff, gbase, voff) do { _Pragma("unroll") for (int _i = 0; _i < 2; ++_i) \
        __builtin_amdgcn_global_load_lds((const unsigned*)((const char*)(gbase) + (voff)[_i]), (LAS unsigned*)(lds + (bufoff) + ldsw + _i * 8192), 16, 0, 0); } while (0)
#define PG8_LDA(dst, b, h) do { _Pragma("unroll") for (int m = 0; m < 4; ++m) _Pragma("unroll") for (int k = 0; k < 2; ++k) dst[m][k] = *(const LAS bf16x8*)(lds + PG8_SA(b, h) + aoff + m * 2048 + k * 1024); } while (0)
#define PG8_LDB(dst, b, h) do { _Pragma("unroll") for (int n = 0; n < 2; ++n) _Pragma("unroll") for (int k = 0; k < 2; ++k) dst[n][k] = *(const LAS bf16x8*)(lds + PG8_SB(b, h) + boff + n * 2048 + k * 1024); } while (0)
#define PG8_MMA(ai, bj, At, Bt) do { __builtin_amdgcn_s_setprio(1); _Pragma("unroll") for (int m = 0; m < 4; ++m) _Pragma("unroll") for (int n = 0; n < 2; ++n) _Pragma("unroll") for (int k = 0; k < 2; ++k) \
        acc[ai][bj][m][n] = __builtin_amdgcn_mfma_f32_16x16x32_bf16(Bt[n][k], At[m][k], acc[ai][bj][m][n], 0, 0, 0); __builtin_amdgcn_s_setprio(0); } while (0)
#define PG8_WAIT_V(n) asm volatile("s_waitcnt vmcnt(" #n ")" ::: "memory")
#define PG8_WAIT_L(n) asm volatile("s_waitcnt lgkmcnt(" #n ")" ::: "memory")
#define PG8_BAR __builtin_amdgcn_s_barrier()
#define PG8_SCHED __builtin_amdgcn_sched_barrier(0)
    Unit cur, nxt; int ui = 0;
    if (!S.next(0, cur)) return;
    float sv[8];
    if constexpr (Epi::PRE) E.pre(cur, wr, fr, sv);
    f32x4 acc[2][2][4][2];
#pragma unroll
    for (int a = 0; a < 2; ++a)
#pragma unroll
        for (int b = 0; b < 2; ++b)
#pragma unroll
            for (int m = 0; m < 4; ++m)
#pragma unroll
                for (int n = 0; n < 2; ++n) acc[a][b][m][n] = (f32x4){0.f, 0.f, 0.f, 0.f};
    bf16x8 At[4][2], B0[2][2], B1[2][2];
    const char* cA = (const char*)g.A + (size_t)cur.pm * tstepA; const char* cB = (const char*)g.Bt + (size_t)cur.pn * tstepB;
    int ntc = nt;
    if constexpr (Sched::SPLIT) { cA += (size_t)cur.k0 * kstep; cB += (size_t)cur.k0 * kstep; ntc = cur.nt; }
    PG8_STAGE(PG8_SB(0, 0), cB, voffB); PG8_STAGE(PG8_SB(0, 1), cB + hstepB, voffB); PG8_STAGE(PG8_SA(0, 0), cA, voffA); PG8_STAGE(PG8_SA(0, 1), cA + hstepA, voffA);
    if (wr == 1) PG8_BAR;
    PG8_WAIT_V(2); PG8_BAR;
    PG8_STAGE(PG8_SB(1, 0), cB + kstep, voffB); PG8_STAGE(PG8_SA(1, 0), cA + kstep, voffA); PG8_STAGE(PG8_SB(1, 1), cB + hstepB + kstep, voffB);
    PG8_WAIT_V(6); PG8_BAR;
    for (;;) {
        const bool has_next = S.next(ui + 1, nxt);
        const char* nA = has_next ? (const char*)g.A + (size_t)nxt.pm * tstepA : cA; const char* nB = has_next ? (const char*)g.Bt + (size_t)nxt.pn * tstepB : cB;
        if constexpr (Sched::SPLIT) { if (has_next) { nA += (size_t)nxt.k0 * kstep; nB += (size_t)nxt.k0 * kstep; } }
        for (int t = 0; t < ntc; t += 2) {
            const bool last = (t == ntc - 2);
            const char* a1 = cA + (size_t)(t + 1) * kstep;
            const char* a2 = last ? nA : cA + (size_t)(t + 2) * kstep; const char* b2 = last ? nB : cB + (size_t)(t + 2) * kstep;
            const char* a3 = a2 + kstep; const char* b3 = b2 + kstep;
            PG8_LDB(B0, 0, 0); PG8_LDB(B1, 0, 1); PG8_SCHED; PG8_LDA(At, 0, 0); PG8_STAGE(PG8_SA(1, 1), a1 + hstepA, voffA);
            PG8_WAIT_V(8); PG8_WAIT_L(0); PG8_BAR; PG8_MMA(0, 0, At, B0); PG8_MMA(0, 1, At, B1); PG8_BAR; PG8_SCHED;
            PG8_LDA(At, 0, 1); PG8_STAGE(PG8_SB(0, 0), b2, voffB); PG8_STAGE(PG8_SB(0, 1), b2 + hstepB, voffB); PG8_STAGE(PG8_SA(0, 0), a2, voffA);
            PG8_WAIT_V(8); PG8_WAIT_L(0); PG8_BAR; PG8_MMA(1, 0, At, B0); PG8_MMA(1, 1, At, B1); PG8_BAR; PG8_SCHED;
            PG8_LDB(B0, 1, 0); PG8_LDB(B1, 1, 1); PG8_SCHED; PG8_LDA(At, 1, 0); PG8_STAGE(PG8_SA(0, 1), a2 + hstepA, voffA);
            PG8_WAIT_V(8); PG8_WAIT_L(0); PG8_BAR; PG8_MMA(0, 0, At, B0); PG8_MMA(0, 1, At, B1); PG8_BAR; PG8_SCHED;
            PG8_LDA(At, 1, 1); PG8_STAGE(PG8_SB(1, 0), b3, voffB); PG8_STAGE(PG8_SB(1, 1), b3 + hstepB, voffB); PG8_STAGE(PG8_SA(1, 0), a3, voffA);
            PG8_WAIT_V(8); PG8_WAIT_L(0); PG8_BAR; PG8_MMA(1, 0, At, B0); PG8_MMA(1, 1, At, B1); PG8_BAR; PG8_SCHED;
        }
        if constexpr (ALIGN_EPI) { if (wr == 0) PG8_BAR; }
        if constexpr (Sched::SPLIT) {
            if (cur.part >= 0) {
                E.partial(acc, cur.part, wr, wc, fr, fq);
                PG8_WAIT_V(0); PG8_BAR;
                if (tid == 0) E.signal();
            } else E(acc, cur, wr, wc, fr, fq);
        }
        else { if constexpr (Epi::PRE) { float svn[8]; if (has_next) E.pre(nxt, wr, fr, svn);
                                         E(acc, cur, wr, wc, fr, fq, sv);
                                         if (has_next) { _Pragma("unroll") for (int i = 0; i < 8; ++i) sv[i] = svn[i]; } }
               else E(acc, cur, wr, wc, fr, fq); }
        if (!has_next) break;
#pragma unroll
        for (int a = 0; a < 2; ++a)
#pragma unroll
            for (int b = 0; b < 2; ++b)
#pragma unroll
                for (int m = 0; m < 4; ++m)
#pragma unroll
                    for (int n = 0; n < 2; ++n) acc[a][b][m][n] = (f32x4){0.f, 0.f, 0.f, 0.f};
        cur = nxt; cA = nA; cB = nB; ++ui;
        if constexpr (Sched::SPLIT) ntc = nxt.nt;
        if constexpr (ALIGN_EPI) { if (wr == 1) PG8_BAR; }
    }
    PG8_WAIT_V(0);
    if constexpr (!ALIGN_EPI) { if (wr == 0) PG8_BAR; }
    PG8_BAR;
#undef PG8_SA
#undef PG8_SB
#undef PG8_STAGE
#undef PG8_LDA
#undef PG8_LDB
#undef PG8_MMA
#undef PG8_WAIT_V
#undef PG8_WAIT_L
#undef PG8_BAR
#undef PG8_SCHED
}

struct EpiSwiglu {
    static constexpr bool PERM = true;
    static constexpr bool PRE = true;
    bf16_t* O; const float* ss;
    __device__ __forceinline__ void pre(const Unit& u, int wr, int fr, float (&sv)[8]) const {
        const int row0 = u.pm * BM + wr * 64 + fr;
#pragma unroll
        for (int ai = 0; ai < 2; ++ai)
#pragma unroll
            for (int m = 0; m < 4; ++m) sv[ai * 4 + m] = ss[row0 + ai * HALF + m * 16];
    }
    __device__ __forceinline__ void operator()(const f32x4 (&acc)[2][2][4][2], const Unit& u, int wr, int wc, int fr, int fq, const float (&sv)[8]) const {
        const int row0 = u.pm * BM + wr * 64 + fr, col0 = u.pn * 128 + wc * 32 + 8 * fq;
#pragma unroll
        for (int ai = 0; ai < 2; ++ai)
#pragma unroll
            for (int m = 0; m < 4; ++m) {
                const int row = row0 + ai * HALF + m * 16;
                const float rs = __builtin_amdgcn_rsqf(sv[ai * 4 + m] * (1.0f / DM) + EPS);
                float a[8];
#pragma unroll
                for (int n = 0; n < 2; ++n)
#pragma unroll
                    for (int e = 0; e < 4; ++e) { const float gg = acc[ai][0][m][n][e] * rs, uu = acc[ai][1][m][n][e] * rs; a[n * 4 + e] = silu_f(gg) * uu; }
                u32x4 w; w.x = pk2(a[0], a[1]); w.y = pk2(a[2], a[3]); w.z = pk2(a[4], a[5]); w.w = pk2(a[6], a[7]);
                *(u32x4*)(O + (size_t)row * DFF + col0) = w;
            }
    }
};
struct EpiResid {
    static constexpr bool PERM = true;
    static constexpr bool PRE = false;
    float* h; bf16_t* hb; float* ssn; float scale; unsigned char* part; unsigned* cnt;
    __device__ __forceinline__ void signal() const { __hip_atomic_fetch_add(cnt, 1u, __ATOMIC_RELAXED, __HIP_MEMORY_SCOPE_AGENT); }
    __device__ __forceinline__ void partial(const f32x4 (&acc)[2][2][4][2], int slot, int wr, int wc, int fr, int fq) const {
        const __amdgpu_buffer_rsrc_t rs = __builtin_amdgcn_make_buffer_rsrc(part, 0, 0x04000000, 0x00020000);
        const unsigned P = (unsigned)slot * 131072u + (unsigned)(wr * 4 + wc) * 16384u + (unsigned)(fq * 16 + fr) * 16u;
#pragma unroll
        for (int ai = 0; ai < 2; ++ai)
#pragma unroll
            for (int m = 0; m < 4; ++m)
#pragma unroll
                for (int bj = 0; bj < 2; ++bj) { const f32x4 v0 = acc[ai][bj][m][0], v1 = acc[ai][bj][m][1];
                    u32x4 w; w.x = pk2(v0[0], v0[1]); w.y = pk2(v0[2], v0[3]); w.z = pk2(v1[0], v1[1]); w.w = pk2(v1[2], v1[3]);
                    __builtin_amdgcn_raw_buffer_store_b128(w, rs, (int)(P + ((ai * 4 + m) * 2 + bj) * 1024), 0,   16); }
    }
    __device__ __forceinline__ void operator()(const f32x4 (&acc)[2][2][4][2], const Unit& u, int wr, int wc, int fr, int fq) const {
        const int row0 = u.pm * BM + wr * 64 + fr, col0 = u.pn * BM + wc * 32 + 8 * fq;
#pragma unroll
        for (int ai = 0; ai < 2; ++ai)
#pragma unroll
            for (int m = 0; m < 4; ++m) {
                const int row = row0 + ai * HALF + m * 16; float s = 0.f;
#pragma unroll
                for (int bj = 0; bj < 2; ++bj) {
                    const size_t off = (size_t)row * DM + col0 + bj * HALF;
                    f32x4 v0, v1;
                    if (RESID_BF16) { const u32x4 hv = *(const u32x4*)(hb + off);
                        v0 = (f32x4){bflo(hv.x), bfhi(hv.x), bflo(hv.y), bfhi(hv.y)} + acc[ai][bj][m][0] * scale; v1 = (f32x4){bflo(hv.z), bfhi(hv.z), bflo(hv.w), bfhi(hv.w)} + acc[ai][bj][m][1] * scale; }
                    else { v0 = *(const f32x4*)(h + off) + acc[ai][bj][m][0] * scale; v1 = *(const f32x4*)(h + off + 4) + acc[ai][bj][m][1] * scale; *(f32x4*)(h + off) = v0; *(f32x4*)(h + off + 4) = v1; }
                    u32x4 w; w.x = pk2(v0[0], v0[1]); w.y = pk2(v0[2], v0[3]); w.z = pk2(v1[0], v1[1]); w.w = pk2(v1[2], v1[3]); *(u32x4*)(hb + off) = w;
                    s += ((v0[0] * v0[0] + v0[1] * v0[1]) + (v0[2] * v0[2] + v0[3] * v0[3])) + ((v1[0] * v1[0] + v1[1] * v1[1]) + (v1[2] * v1[2] + v1[3] * v1[3]));
                }
                s += __shfl_xor(s, 16); s += __shfl_xor(s, 32);
                if (fq == 0) atomicAdd(ssn + row, s);
            }
    }
};
struct EpiScaleBf16 {
    static constexpr bool PERM = true;
    static constexpr bool PRE = false;
    bf16_t* O; int ldc; const float* ss;
    __device__ __forceinline__ void operator()(const f32x4 (&acc)[2][2][4][2], const Unit& u, int wr, int wc, int fr, int fq) const {
        const int row0 = u.pm * BM + wr * 64 + fr, col0 = u.pn * BM + wc * 32 + 8 * fq;
#pragma unroll
        for (int ai = 0; ai < 2; ++ai)
#pragma unroll
            for (int m = 0; m < 4; ++m) {
                const int row = row0 + ai * HALF + m * 16;
                const float rs = __builtin_amdgcn_rsqf(ss[row] * (1.0f / DM) + EPS);
#pragma unroll
                for (int bj = 0; bj < 2; ++bj) { const f32x4 v0 = acc[ai][bj][m][0] * rs, v1 = acc[ai][bj][m][1] * rs;
                    u32x4 w; w.x = pk2(v0[0], v0[1]); w.y = pk2(v0[2], v0[3]); w.z = pk2(v1[0], v1[1]); w.w = pk2(v1[2], v1[3]);
                    *(u32x4*)(O + (size_t)row * ldc + col0 + bj * HALF) = w; }
            }
    }
};
struct EpiScaleF32 {
    static constexpr bool PERM = false;
    static constexpr bool PRE = false;
    float* O; int ldc; const float* ss;
    __device__ __forceinline__ void operator()(const f32x4 (&acc)[2][2][4][2], const Unit& u, int wr, int wc, int fr, int fq) const {
        const int row0 = u.pm * BM + wr * 64 + fr, col0 = u.pn * BM + wc * 32 + 4 * fq;
#pragma unroll
        for (int ai = 0; ai < 2; ++ai)
#pragma unroll
            for (int m = 0; m < 4; ++m) {
                const int row = row0 + ai * HALF + m * 16;
                const float rs = __builtin_amdgcn_rsqf(ss[row] * (1.0f / DM) + EPS);
#pragma unroll
                for (int bj = 0; bj < 2; ++bj)
#pragma unroll
                    for (int n = 0; n < 2; ++n) *(f32x4*)(O + (size_t)row * ldc + col0 + bj * HALF + n * 16) = acc[ai][bj][m][n] * rs;
            }
    }
};
struct EpiQ {
    static constexpr bool PERM = true;
    static constexpr bool PRE = false;
    bf16_t* Q; const float* ssq; float c2;
    __device__ __forceinline__ void operator()(const f32x4 (&acc)[2][2][4][2], const Unit& u, int wr, int wc, int fr, int fq) const {
        const int row0 = u.pm * BM + wr * 64 + fr;
        const int hs0 = u.pn < 8 ? u.pn * 10 + wc : (4 * (u.pn - 8) + (wc >> 1)) * 10 + 8 + (wc & 1);
        const int hsstep = u.pn < 8 ? 4 : 20;
#pragma unroll
        for (int ai = 0; ai < 2; ++ai)
#pragma unroll
            for (int m = 0; m < 4; ++m) {
                const int row = row0 + ai * HALF + m * 16;
                const float rs = __builtin_amdgcn_rsqf(ssq[row] * (1.0f / 384.0f) + EPS) * c2;
#pragma unroll
                for (int bj = 0; bj < 2; ++bj) { const f32x4 v0 = acc[ai][bj][m][0] * rs, v1 = acc[ai][bj][m][1] * rs;
                    u32x4 w; w.x = pk2(v0[0], v0[1]); w.y = pk2(v0[2], v0[3]); w.z = pk2(v1[0], v1[1]); w.w = pk2(v1[2], v1[3]);
                    *(u32x4*)(Q + ((size_t)(row >> 4) * 80 + hs0 + bj * hsstep) * 512 + (fq * 16 + fr) * 8) = w; }
            }
    }
};
}

#define XB_TMO      128
#define XB_XCNT(j)  (256  + 64 * (j))
#define XB_XSUB(j)  (1280 + 64 * (j))
#define XB_XGEN(j)  (2304 + 64 * (j))
#define XB_TOP      3328
#define XB_TOPGEN   3392
#define XCD_BAR_WORDS 3456
#define XB_SPIN_CAP (1u << 18)
__device__ __forceinline__ unsigned xb_ld(unsigned* p)              { return __hip_atomic_load(p, __ATOMIC_RELAXED, __HIP_MEMORY_SCOPE_AGENT); }
__device__ __forceinline__ unsigned xb_add(unsigned* p, unsigned v) { return __hip_atomic_fetch_add(p, v, __ATOMIC_RELAXED, __HIP_MEMORY_SCOPE_AGENT); }
__device__ __forceinline__ unsigned xb_xcc_id() { return (unsigned)__builtin_amdgcn_s_getreg((3 << 11) | 20) & 0xFu; }
#define XB_SPIN(cond, bar) do { unsigned _sp = 0; while (cond) { __builtin_amdgcn_s_sleep(1); \
    if ((++_sp & 255u) == 0u) { if (xb_ld(&(bar)[XB_TMO])) break; if (_sp > XB_SPIN_CAP) { atomicAdd(&(bar)[XB_TMO], 1u); break; } } } } while (0)
struct XcdBarrier { unsigned* bar; unsigned x; volatile LAS unsigned* st; };
__device__ __forceinline__ XcdBarrier xcd_barrier_post(unsigned* bar, volatile LAS unsigned* st) {
    XcdBarrier b; b.bar = bar; b.x = xb_xcc_id(); b.st = st;
    if (threadIdx.x == 0) (void)xb_add(&bar[XB_XCNT(b.x)], 1u);
    return b;
}
__device__ __forceinline__ void xcd_barrier_complete(unsigned* bar, unsigned x, unsigned& nloc, unsigned& nx) {
    const unsigned G = gridDim.x * gridDim.y * gridDim.z;
    unsigned sum, cnt, mine, sp = 0u;
    for (;;) {
        sum = 0u; cnt = 0u; mine = 0u;
#pragma unroll
        for (unsigned j = 0; j < 16; ++j) { const unsigned c = xb_ld(&bar[XB_XCNT(j)]); sum += c; cnt += (c > 0u) ? 1u : 0u; mine = (j == x) ? c : mine; }
        if (sum == G) break;
        __builtin_amdgcn_s_sleep(1);
        if ((++sp & 255u) == 0u) { if (xb_ld(&bar[XB_TMO])) break; if (sp > XB_SPIN_CAP) { atomicAdd(&bar[XB_TMO], 1u); break; } }
    }
    nloc = mine > 0u ? mine : 1u; nx = cnt > 0u ? cnt : 1u;
}
__device__ __forceinline__ void xcd_barrier(const XcdBarrier& b) {
    asm volatile("s_waitcnt vmcnt(0)" ::: "memory");
    __syncthreads();
    if (threadIdx.x == 0) {
        unsigned* bar = b.bar;
        __builtin_amdgcn_s_waitcnt(0);
        unsigned nloc = b.st[0], nx = b.st[1];
        if (nloc == 0u) { xcd_barrier_complete(bar, b.x, nloc, nx); b.st[0] = nloc; b.st[1] = nx; }
        const unsigned old = xb_add(&bar[XB_XSUB(b.x)], 1u);
        const unsigned gen = old / nloc;
        if (old + 1u == (gen + 1u) * nloc) {
            __builtin_amdgcn_fence(__ATOMIC_RELEASE, "agent");
            asm volatile("s_waitcnt vmcnt(0)" ::: "memory");
            const unsigned og = xb_add(&bar[XB_TOP], 1u);
            const unsigned tg = og / nx;
            if (og + 1u == (tg + 1u) * nx) xb_add(&bar[XB_TOPGEN], 1u);
            else XB_SPIN(xb_ld(&bar[XB_TOPGEN]) == tg, bar);
            __builtin_amdgcn_fence(__ATOMIC_ACQUIRE, "agent");
            xb_add(&bar[XB_XGEN(b.x)], 1u);
            asm volatile("s_waitcnt vmcnt(0)" ::: "memory");
        } else {
            XB_SPIN(xb_ld(&bar[XB_XGEN(b.x)]) == gen, bar);
            __builtin_amdgcn_fence(__ATOMIC_ACQUIRE, "agent");
            asm volatile("s_waitcnt vmcnt(0)" ::: "memory");
        }
    }
    __syncthreads();
}

struct Args { const float* in[28]; float* out; unsigned char* ws; int ph_lo, ph_hi; };

__device__ __forceinline__ void tr_item(const float* W, int ldw, int Nvalid, const float* kscale, bf16_t* WT, int Kd, int k0, int n0, int drow0, LAS float* scr, int lane) {
    const int n = n0 + 4 * (lane & 15);
    f32x4 v[16];
#pragma unroll
    for (int i = 0; i < 16; ++i) { const int kk = 4 * i + (lane >> 4); v[i] = (f32x4){0.f, 0.f, 0.f, 0.f}; if (n < Nvalid) v[i] = __builtin_nontemporal_load((const f32x4*)(W + (size_t)(k0 + kk) * ldw + n)); }
#pragma unroll
    for (int i = 0; i < 16; ++i) { const int kk = 4 * i + (lane >> 4); f32x4 x = v[i]; if (kscale) x = x * kscale[k0 + kk];
        LAS float* d = scr + kk * 65 + 4 * (lane & 15); d[0] = x[0]; d[1] = x[1]; d[2] = x[2]; d[3] = x[3]; }
    asm volatile("s_waitcnt lgkmcnt(0)" ::: "memory");
    const int c = lane & 7;
#pragma unroll
    for (int j = 0; j < 8; ++j) { const int nn = (lane >> 3) + 8 * j; const LAS float* s = scr + (8 * c) * 65 + nn;
        u32x4 o; o.x = pk2(s[0 * 65], s[1 * 65]); o.y = pk2(s[2 * 65], s[3 * 65]); o.z = pk2(s[4 * 65], s[5 * 65]); o.w = pk2(s[6 * 65], s[7 * 65]);
        *(u32x4*)(WT + (size_t)(drow0 + nn) * Kd + k0 + 8 * c) = o; }
    asm volatile("s_waitcnt lgkmcnt(0)" ::: "memory");
}
__device__ __forceinline__ void split8(const f32x4 x0, const f32x4 x1, bf16x8& hi, bf16x8& lo) {
    u32x4 h; h.x = pk2(x0[0], x0[1]); h.y = pk2(x0[2], x0[3]); h.z = pk2(x1[0], x1[1]); h.w = pk2(x1[2], x1[3]);
    u32x4 l; l.x = pk2(x0[0] - bflo(h.x), x0[1] - bfhi(h.x)); l.y = pk2(x0[2] - bflo(h.y), x0[3] - bfhi(h.y)); l.z = pk2(x1[0] - bflo(h.z), x1[1] - bfhi(h.z)); l.w = pk2(x1[2] - bflo(h.w), x1[3] - bfhi(h.w));
    hi = __builtin_bit_cast(bf16x8, h); lo = __builtin_bit_cast(bf16x8, l);
}
__device__ __forceinline__ void phase_prep(const Args& a, unsigned char* const ws_, float* const out_, LAS unsigned char* lds, int gw, int NGW, int wave, int lane) {
    unsigned char* ws = ws_;
    LAS float* scr = (LAS float*)(lds + wave * 16640);
    constexpr int I_UP = 16 * 44, I_DN = 44 * 16, I_GIN = 16 * 52, I_SQ = 16 * 16, I_MDN = 16 * 12;
    constexpr int I_FFN = 2 * I_UP + I_DN;
    constexpr int NITEMS = 4 * I_FFN + I_GIN + I_SQ + I_MDN + I_SQ;
    for (int it = gw; it < NITEMS; it += NGW) {
        int r = it;
        if (r < 4 * I_FFN) {
            const int fi = r / I_FFN; r -= fi * I_FFN; const int layer = fi >> 1, which = fi & 1;
            const float* nrm = a.in[which ? 23 : 6] + layer * DM;
            if (r < 2 * I_UP) { const int isup = r >= I_UP; if (isup) r -= I_UP;
                const float* W = a.in[(which ? 24 : 7) + isup] + (size_t)layer * DM * DFF;
                const int kb = r / 44, nb = r % 44, n0 = nb * 64;
                tr_item(W, DFF, DFF, nrm, (bf16_t*)(ws + ws_wup(fi)), DM, kb * 64, n0, 256 * (n0 >> 7) + (n0 & 127) + 128 * isup, scr, lane);
            } else { r -= 2 * I_UP;
                const float* W = a.in[which ? 26 : 9] + (size_t)layer * DFF * DM;
                const int kb = r / 16, nb = r % 16;
                tr_item(W, DM, DM, nullptr, (bf16_t*)(ws + ws_wdn(fi)), DFF, kb * 64, nb * 64, nb * 64, scr, lane);
            }
            continue;
        }
        r -= 4 * I_FFN;
        if (r < I_GIN) { const int kb = r / 52, nb = r % 52; tr_item(a.in[11], 3088, 3088, a.in[10], (bf16_t*)(ws + WS_WGIN), DM, kb * 64, nb * 64, nb * 64, scr, lane); continue; }
        r -= I_GIN;
        if (r < I_SQ) { const int kb = r / 16, nb = r % 16; tr_item(a.in[15], DM, DM, nullptr, (bf16_t*)(ws + WS_WGOUT), DM, kb * 64, nb * 64, nb * 64, scr, lane); continue; }
        r -= I_SQ;
        if (r < I_MDN) { const int kb = r / 12, nb = r % 12; tr_item(a.in[16], 704, 704, a.in[10] + DM, (bf16_t*)(ws + WS_WMDN), DM, kb * 64, nb * 64, nb * 64, scr, lane); continue; }
        r -= I_MDN;
        { const int kb = r / 16, nb = r % 16; tr_item(a.in[22], DM, DM, nullptr, (bf16_t*)(ws + WS_WMOUT), DM, kb * 64, nb * 64, nb * 64, scr, lane); }
    }
    const int gt = gw * 64 + lane, NGT = NGW * 64;
    {   const float* wuq = a.in[18]; const float* wuk = a.in[20]; const float* qn = a.in[17]; bf16_t* WQ = (bf16_t*)(ws + WS_WQ);
        {   const int fr = lane & 15, fq = lane >> 4;
            for (int it = gw; it < 8 * 24 * 4; it += NGW) {
                const int h = it / 96, ct = (it % 96) >> 2, rg = it & 3;
                const float* ap = wuq + (size_t)(16 * ct + fr) * 1536 + h * 192 + 8 * fq;
                bf16x8 ah[4], al[4];
#pragma unroll
                for (int s = 0; s < 4; ++s) split8(*(const f32x4*)(ap + 32 * s), *(const f32x4*)(ap + 32 * s + 4), ah[s], al[s]);
                const f32x4 qs = *(const f32x4*)(qn + 16 * ct + 4 * fq);
#pragma unroll
                for (int q = 0; q < 4; ++q) { const int rt = rg * 4 + q;
                    const float* bp = wuk + (size_t)(16 * rt + fr) * 1024 + h * 128 + 8 * fq;
                    f32x4 acc = (f32x4){0.f, 0.f, 0.f, 0.f};
#pragma unroll
                    for (int s = 0; s < 4; ++s) { bf16x8 bh, bl; split8(*(const f32x4*)(bp + 32 * s), *(const f32x4*)(bp + 32 * s + 4), bh, bl);
                        acc = mfma16(al[s], bh, acc); acc = mfma16(ah[s], bl, acc); acc = mfma16(ah[s], bh, acc); }
                    acc = acc * qs;
                    u32x2 w; w.x = pk2(acc[0], acc[1]); w.y = pk2(acc[2], acc[3]);
                    *(u32x2*)(WQ + (size_t)(h * 256 + 16 * rt + fr) * 384 + 16 * ct + 4 * fq) = w; }
            }
        }
        for (int i = gt; i < 512 * 384; i += NGT) {
            const int c = i % 384, rr = i / 384, head = rr >> 6, j = rr & 63;
            WQ[(size_t)(2048 + rr) * 384 + c] = (bf16_t)(pk2(wuq[(size_t)c * 1536 + head * 192 + 128 + j] * qn[c], 0.f) & 0xffffu);
        }
    }
    {   const float* wuv = a.in[21]; bf16_t* WU = (bf16_t*)(ws + WS_WUVT);
        for (int i = gt; i < 8 * 128 * 256; i += NGT) { const int j = i & 7, ln = (i >> 3) & 63, s = (i >> 9) & 7, vt = (i >> 12) & 7, h = i >> 15;
            const int dv = 32 * s + 16 * (j >> 2) + 4 * (ln >> 4) + (j & 3), v = 32 * (vt >> 1) + 8 * ((ln & 15) >> 2) + 4 * (vt & 1) + (ln & 3);
            WU[i] = (bf16_t)(pk2(wuv[(size_t)dv * 1024 + h * 128 + v], 0.f) & 0xffffu); }
    }
    {   f32x2* rt = (f32x2*)(ws + WS_ROPE);
        for (int i = gt; i < 4144 * 32; i += NGT) { const int idx = i >> 5, k = i & 31; const float pos = idx < LP ? (float)idx : (float)(PAST + idx - LP);
            const float inv = fexp2(-(float)k * 0.41524101186092029f); const float ang = pos * inv;
            const float kq = rintf(ang * 0.63661977236758134f);
            float r = ang - kq * 1.5703125f; r -= kq * 4.837512969970703125e-4f; r -= kq * 7.54978995489188216e-8f;
            const float r2 = r * r;
            const float sr = r + r * r2 * (-1.6666654611e-1f + r2 * (8.3321608736e-3f + r2 * -1.9515295891e-4f));
            const float cr = 1.0f - 0.5f * r2 + r2 * r2 * (4.166664568298827e-2f + r2 * (-1.388731625493765e-3f + r2 * 2.443315711809948e-5f));
            const int qd = (int)kq & 3;
            const float cs = qd == 0 ? cr : qd == 1 ? -sr : qd == 2 ? -cr : sr, sn = qd == 0 ? sr : qd == 1 ? cr : qd == 2 ? -sr : -cr;
            rt[i] = (f32x2){cs, sn}; }
    }
    {   float* H = (float*)(ws + WS_H); bf16_t* HB = (bf16_t*)(ws + WS_HB); float* SS0 = (float*)(ws + WS_SS);
        for (int r0 = gw; r0 < T; r0 += 2 * NGW) {
            f32x4 v[2][4]; bool live[2];
#pragma unroll
            for (int q = 0; q < 2; ++q) { const int row = r0 + q * NGW; live[q] = row < T; const float* src = nullptr;
                if (live[q]) { if (row < ROWS_P) { const int b = row / LPP, p = row % LPP; if (p >= 64) src = a.in[0] + ((size_t)b * SEQ + (p - 64)) * DM; else if (p >= 48) src = a.in[5] + (size_t)(p - 48) * DM; }
                               else src = a.in[1] + (size_t)(row - ROWS_P) * DM; }
#pragma unroll
                for (int j = 0; j < 4; ++j) { v[q][j] = (f32x4){0.f, 0.f, 0.f, 0.f}; if (src) v[q][j] = __builtin_nontemporal_load((const f32x4*)(src + 512 * (j >> 1) + 8 * lane + 4 * (j & 1))); } }
#pragma unroll
            for (int q = 0; q < 2; ++q) if (live[q]) { const int row = r0 + q * NGW; float s = 0.f;
#pragma unroll
                for (int hf = 0; hf < 2; ++hf) { const f32x4 x0 = v[q][2 * hf], x1 = v[q][2 * hf + 1];
                    if (!RESID_BF16) { *(f32x4*)(H + (size_t)row * DM + 512 * hf + 8 * lane) = x0; *(f32x4*)(H + (size_t)row * DM + 512 * hf + 8 * lane + 4) = x1; }
                    u32x4 w; w.x = pk2(x0[0], x0[1]); w.y = pk2(x0[2], x0[3]); w.z = pk2(x1[0], x1[1]); w.w = pk2(x1[2], x1[3]); *(u32x4*)(HB + (size_t)row * DM + 512 * hf + 8 * lane) = w;
                    s += ((x0[0] * x0[0] + x0[1] * x0[1]) + (x0[2] * x0[2] + x0[3] * x0[3])) + ((x1[0] * x1[0] + x1[1] * x1[1]) + (x1[2] * x1[2] + x1[3] * x1[3])); }
                s = wave_sum(s); if (lane == 0) SS0[row] = s; }
        }
    }
}

__device__ __forceinline__ void phase_gla_a(const Args& a, unsigned char* const ws_, float* const out_, LAS unsigned char* lds, int G, int bx, int tid) {
    bf16_t* P = (bf16_t*)(ws_ + WS_BIG); float* DEC = (float*)(ws_ + WS_DEC);
    const float* wg = a.in[12]; const float* bg = a.in[13];
    LAS float* gl = (LAS float*)lds;
    const int wid = __builtin_amdgcn_readfirstlane(tid >> 6), lane = tid & 63, fr = lane & 15, fq = lane >> 4;
    bf16x8 bw[4]; float bb[4];
#pragma unroll
    for (int q = 0; q < 4; ++q) { const int col = 64 * wid + 16 * q + fr; float x[8];
#pragma unroll
        for (int j = 0; j < 8; ++j) x[j] = wg[(size_t)((8 * fq + j) & 15) * 512 + col];
        bf16x8 hi, lo; split8((f32x4){x[0], x[1], x[2], x[3]}, (f32x4){x[4], x[5], x[6], x[7]}, hi, lo);
        bw[q] = fq < 2 ? hi : lo; bb[q] = bg[col]; }
    for (int cg = bx; cg < 260 + SB; cg += G) {
        int row0, nrows, npad;
        if (cg < 260) { const int b = cg / NCH, c = cg % NCH; row0 = b * LPP + 64 * c; nrows = 64; npad = c == 0 ? 48 : 0; }
        else { row0 = ROWS_P + 32 * (cg - 260); nrows = 32; npad = 0; }
        __syncthreads();
        const int nchunk = nrows * 64;
        u32x4 qv[8], kv[8];
#pragma unroll
        for (int i = 0; i < 8; ++i) { const int ch = tid + 512 * i; qv[i] = (u32x4){0u, 0u, 0u, 0u}; kv[i] = qv[i];
            if (512 * i < nchunk) { const bf16_t* pr = P + (size_t)(row0 + (ch >> 6)) * GIN_LD + 8 * (ch & 63); qv[i] = *(const u32x4*)pr; kv[i] = *(const u32x4*)(pr + 512); } }
#pragma unroll
        for (int rb = 0; rb < 4; ++rb) {
            if (16 * rb < nrows) {
                const bf16x8 ga = *(const bf16x8*)(P + (size_t)(row0 + 16 * rb + fr) * GIN_LD + 3072 + 8 * (fq & 1));
#pragma unroll
                for (int q = 0; q < 4; ++q) { const f32x4 c = mfma16(ga, bw[q], (f32x4){bb[q], bb[q], bb[q], bb[q]});
#pragma unroll
                    for (int r = 0; r < 4; ++r) gl[(16 * rb + 4 * fq + r) * 512 + 64 * wid + 16 * q + fr] = c[r]; }
            }
        }
        __syncthreads();
        float gc = 0.f;
#pragma unroll 8
        for (int i = 0; i < nrows; ++i) {
            if (i >= npad) {
                const float g = gl[i * 512 + tid];
                const float ls = fminf(g, 0.f) - __logf(1.0f + __expf(-fabsf(g)));
                gc += ls * (1.0f / 16.0f);
            }
            gl[i * 512 + tid] = __expf(gc);
        }
        DEC[(size_t)cg * 512 + tid] = __expf(gc);
        __syncthreads();
#pragma unroll
        for (int i = 0; i < 8; ++i) { const int ch = tid + 512 * i;
            if (512 * i < nchunk) {
                const LAS float* ep = gl + (ch >> 6) * 512 + 8 * (ch & 63);
                const f32x4 e0 = *(const LAS f32x4*)ep, e1 = *(const LAS f32x4*)(ep + 4);
                const float sc = 0.08838834764831845f;
                u32x4 qo, ko;
                qo.x = pk2(bflo(qv[i].x) * sc * e0[0], bfhi(qv[i].x) * sc * e0[1]); qo.y = pk2(bflo(qv[i].y) * sc * e0[2], bfhi(qv[i].y) * sc * e0[3]);
                qo.z = pk2(bflo(qv[i].z) * sc * e1[0], bfhi(qv[i].z) * sc * e1[1]); qo.w = pk2(bflo(qv[i].w) * sc * e1[2], bfhi(qv[i].w) * sc * e1[3]);
                ko.x = pk2(bflo(kv[i].x) * frcp(e0[0]), bfhi(kv[i].x) * frcp(e0[1])); ko.y = pk2(bflo(kv[i].y) * frcp(e0[2]), bfhi(kv[i].y) * frcp(e0[3]));
                ko.z = pk2(bflo(kv[i].z) * frcp(e1[0]), bfhi(kv[i].z) * frcp(e1[1])); ko.w = pk2(bflo(kv[i].w) * frcp(e1[2]), bfhi(kv[i].w) * frcp(e1[3]));
                bf16_t* pr = P + (size_t)(row0 + (ch >> 6)) * GIN_LD + 8 * (ch & 63);
                *(u32x4*)pr = qo; *(u32x4*)(pr + 512) = ko;
            }
        }
    }
}
__device__ __forceinline__ bf16x8 col8(const bf16_t* p, int stride) {
    bf16x8 r;
#pragma unroll
    for (int j = 0; j < 8; ++j) r[j] = (short)p[(size_t)j * stride];
    return r;
}
__device__ __forceinline__ bf16x8 tr8(const LAS unsigned char* p) {
    const s16x4 lo = __builtin_bit_cast(s16x4, __builtin_amdgcn_ds_read_tr16_b64_v4i16((LAS s16x4*)p));
    const s16x4 hi = __builtin_bit_cast(s16x4, __builtin_amdgcn_ds_read_tr16_b64_v4i16((LAS s16x4*)(p + 128)));
    return (bf16x8){lo[0], lo[1], lo[2], lo[3], hi[0], hi[1], hi[2], hi[3]};
}
__device__ __forceinline__ void phase_gla_b(const Args& a, unsigned char* const ws_, float* const out_, LAS unsigned char* lds, int G, int vcu, int gw, int NGW, int wid, int lane) {
    const bf16_t* P = (const bf16_t*)(ws_ + WS_BIG); const float* DEC = (const float*)(ws_ + WS_DEC);
    bf16_t* SBP = (bf16_t*)((unsigned char*)out_ + OS_SBUFP); bf16_t* SBS = (bf16_t*)(ws_ + WS_SBUFS);
    const int fr = lane & 15, fq = lane >> 4, tid = wid * 64 + lane;
    LAS unsigned char* wl = lds + wid * 8192;
    const int troff = (8 * fq + (fr >> 2)) * 32 + (fr & 3) * 8;
    for (int item = vcu; item < 256; item += G) {
        const int seq = item >> 4, rect = item & 15, dkt = 2 * (rect >> 2) + (wid >> 2), dvs = 4 * (rect & 3) + (wid & 3), b = seq >> 2, h = seq & 3;
        const int krow = tid >> 2, kch = tid & 3, vrow_ = tid >> 3, vch = tid & 7;
        const bf16_t* kp = P + (size_t)(b * LPP + krow) * GIN_LD + 512 + h * 128 + 32 * (rect >> 2) + 8 * kch;
        const bf16_t* vp = P + (size_t)(b * LPP + vrow_) * GIN_LD + 1024 + h * 256 + 64 * (rect & 3) + 8 * vch;
        const int kdst = (kch >> 1) * 2048 + krow * 32 + (kch & 1) * 16, vdst = 8192 + (vch >> 1) * 2048 + vrow_ * 32 + (vch & 1) * 16;
        const int ksrc = (wid >> 2) * 2048 + troff, vsrc = 8192 + (wid & 3) * 2048 + troff;
        const float* dp = DEC + (size_t)(b * NCH) * 512 + h * 128 + 16 * dkt + 4 * fq;
        f32x4 S = (f32x4){0.f, 0.f, 0.f, 0.f};
        u32x4 rk[4], rv[4]; f32x4 rd[4];
#define GB_LOAD(c, I) do { const size_t o_ = (size_t)(64 * (c)) * GIN_LD; if (tid < 256) rk[I] = *(const u32x4*)(kp + o_); rv[I] = *(const u32x4*)(vp + o_); rd[I] = *(const f32x4*)(dp + (size_t)(c) * 512); } while (0)
#define GB_STEP(c, I) do { LAS unsigned char* bb_ = lds + (((c) & 1) ? 16384 : 0); const f32x4 dcur_ = rd[I]; \
            if (tid < 256) *(LAS u32x4*)(bb_ + kdst) = rk[I]; *(LAS u32x4*)(bb_ + vdst) = rv[I]; \
            if ((c) + 4 < NCH) GB_LOAD((c) + 4, I); \
            if ((c) >= 1) { u32x2 w_; w_.x = pk2(S[0], S[1]); w_.y = pk2(S[2], S[3]); \
                *(u32x2*)(SBP + (size_t)(seq * 64 + ((c) - 1)) * 32768 + (dvs * 8 + dkt) * 256 + fr * 16 + 4 * fq) = w_; } \
            __syncthreads(); \
            const bf16x8 ka0_ = tr8(bb_ + ksrc), ka1_ = tr8(bb_ + ksrc + 1024), va0_ = tr8(bb_ + vsrc), va1_ = tr8(bb_ + vsrc + 1024); \
            S = mfma16(ka0_, va0_, S); S = mfma16(ka1_, va1_, S); \
            S = S * dcur_; } while (0)
        __syncthreads();
        GB_LOAD(0, 0); GB_LOAD(1, 1); GB_LOAD(2, 2); GB_LOAD(3, 3);
        for (int c = 0; c + 3 < NCH; c += 4) { GB_STEP(c, 0); GB_STEP(c + 1, 1); GB_STEP(c + 2, 2); GB_STEP(c + 3, 3); }
        GB_STEP(NCH - 1, 0);
#undef GB_LOAD
#undef GB_STEP
        float* og = out_ + OUT_GP + ((size_t)seq * 128 + 16 * dkt + 4 * fq) * 256 + 16 * dvs + fr;
#pragma unroll
        for (int r = 0; r < 4; ++r) __builtin_nontemporal_store(S[r], og + (size_t)r * 256);
    }
    __syncthreads();
    for (int rep_ = 0; rep_ < (GB_P2 ? 2 : 1); ++rep_)
    for (int it = gw; it < 128 * 16; it += NGW) {
        const int seq = it >> 4, dkt = (it >> 1) & 7, dvh = it & 1, bs = seq >> 2, h = seq & 3;
        const int lrow = lane & 31;
        const bf16_t* kp = P + (size_t)(ROWS_P + 32 * bs + lrow) * GIN_LD + 512 + h * 128 + 16 * dkt;
        const bf16_t* vp = P + (size_t)(ROWS_P + 32 * bs + lrow) * GIN_LD + 1024 + h * 256 + 128 * dvh;
        { const u32x4 k0 = *(const u32x4*)kp, k1 = *(const u32x4*)(kp + 8);
          if (lane < 32) { *(LAS u32x4*)(wl + lane * 32) = k0; *(LAS u32x4*)(wl + lane * 32 + 16) = k1; } }
        const bf16x8 ka = tr8(wl + troff);
        const f32x4 d = *(const f32x4*)(DEC + (size_t)(260 + bs) * 512 + h * 128 + 16 * dkt + 4 * fq);
#pragma unroll 2
        for (int q = 0; q < 8; ++q) {
            const int dvs = 8 * dvh + q;
            { const u32x4 v0 = *(const u32x4*)(vp + 16 * q), v1 = *(const u32x4*)(vp + 16 * q + 8);
              if (lane < 32) { *(LAS u32x4*)(wl + 4096 + (q & 1) * 2048 + lane * 32) = v0; *(LAS u32x4*)(wl + 4096 + (q & 1) * 2048 + lane * 32 + 16) = v1; } }
            const size_t so = ((size_t)seq * 128 + 16 * dkt + 4 * fq) * 256 + 16 * dvs + fr;
            f32x4 S;
#pragma unroll
            for (int r = 0; r < 4; ++r) S[r] = a.in[2][so + (size_t)r * 256];
            { u32x2 w; w.x = pk2(S[0], S[1]); w.y = pk2(S[2], S[3]); *(u32x2*)(SBS + (size_t)seq * 32768 + (dvs * 8 + dkt) * 256 + fr * 16 + 4 * fq) = w; }
            S = mfma16(ka, tr8(wl + 4096 + (q & 1) * 2048 + troff), S);
            S = S * d;
            float* og = out_ + OUT_GS + so;
#pragma unroll
            for (int r = 0; r < 4; ++r) __builtin_nontemporal_store(S[r], og + (size_t)r * 256);
        }
    }
}
template <int NI>
__device__ __forceinline__ void gla_c_item(LAS unsigned char* abuf, LAS float* red, LAS unsigned char* vbuf, bf16_t* P, const bf16_t* ST, const float* hn, int row0, int h, int wid, int lane) {
    { int zz = 0; asm volatile("" : "+v"(zz)); lane = (int)__builtin_amdgcn_mbcnt_hi(~0u, __builtin_amdgcn_mbcnt_lo(~0u, 0u)) + zz; }
    const int fr = lane & 15, fq = lane >> 4;
    constexpr int ASTR = 144, VSTR = 544;
    u32x4 vx[NI];
#pragma unroll
    for (int i = 0; i < NI; ++i) { const int ch = wid * 64 + lane + 512 * i; vx[i] = *(const u32x4*)(P + (size_t)(row0 + (ch >> 5)) * GIN_LD + 1024 + h * 256 + (ch & 31) * 8); }
    const int dv0 = 32 * wid;
    bf16x8 qfr[NI][4], sf[2][4]; u32x4 rr[NI]; f32x4 hwv[2];
#pragma unroll
    for (int dt = 0; dt < 2; ++dt) hwv[dt] = *(const f32x4*)(hn + dv0 + 8 * fq + 4 * dt);
#pragma unroll
    for (int it = 0; it < NI; ++it)
#pragma unroll
        for (int s = 0; s < 4; ++s) qfr[it][s] = *(const bf16x8*)(P + (size_t)(row0 + 16 * it + fr) * GIN_LD + h * 128 + 32 * s + 8 * fq);
    if (ST) {
#pragma unroll
        for (int s = 0; s < 4; ++s) { const int to = (2 * wid + (fr >> 3)) * 2048 + (2 * s + (fq >> 1)) * 256 + (8 * ((fr >> 2) & 1) + (fr & 3)) * 16 + (fq & 1) * 8;
            sf[0][s] = __builtin_nontemporal_load((const bf16x8*)(ST + to)); sf[1][s] = __builtin_nontemporal_load((const bf16x8*)(ST + to + 4 * 16)); }
    }
#pragma unroll
    for (int it = 0; it < NI; ++it) rr[it] = *(const u32x4*)(P + (size_t)(row0 + 16 * it + fr) * GIN_LD + 2048 + h * 256 + dv0 + 8 * fq);
    constexpr int NTILE = NI * NI, PERW = NTILE >= 8 ? NTILE / 8 : 1;
#pragma unroll
    for (int q = 0; q < PERW; ++q) {
        const int idx = wid * PERW + q;
        if (idx < NTILE) {
            const int it = idx / NI, jt = idx % NI;
            const bf16_t* kq = P + (size_t)(row0 + 16 * jt + fr) * GIN_LD + 512 + h * 128 + 8 * fq;
            const bf16_t* qq = P + (size_t)(row0 + 16 * it + fr) * GIN_LD + h * 128 + 8 * fq;
            f32x4 d = (f32x4){0.f, 0.f, 0.f, 0.f};
#pragma unroll
            for (int s = 0; s < 4; ++s) d = mfma16(*(const bf16x8*)(kq + 32 * s), *(const bf16x8*)(qq + 32 * s), d);
            const int i = 16 * it + fr, j0 = 16 * jt + 4 * fq;
#pragma unroll
            for (int r = 0; r < 4; ++r) if (j0 + r > i) d[r] = 0.f;
            u32x2 w; w.x = pk2(d[0], d[1]); w.y = pk2(d[2], d[3]);
            *(LAS u32x2*)(abuf + i * ASTR + j0 * 2) = w;
        }
    }
#pragma unroll
    for (int i = 0; i < NI; ++i) { const int ch = wid * 64 + lane + 512 * i; *(LAS u32x4*)(vbuf + (ch >> 5) * VSTR + (ch & 31) * 16) = vx[i]; }
    __syncthreads();
    f32x4 o[2][NI];
#pragma unroll
    for (int dt = 0; dt < 2; ++dt)
#pragma unroll
        for (int it = 0; it < NI; ++it) o[dt][it] = (f32x4){0.f, 0.f, 0.f, 0.f};
    if (ST) {
#pragma unroll
        for (int s = 0; s < 4; ++s)
#pragma unroll
            for (int it = 0; it < NI; ++it) { o[0][it] = mfma16(sf[0][s], qfr[it][s], o[0][it]); o[1][it] = mfma16(sf[1][s], qfr[it][s], o[1][it]); }
    }
#pragma unroll
    for (int s = 0; s < NI / 2; ++s) {
        const LAS unsigned char* va = vbuf + (32 * s + 8 * fq + (fr >> 2)) * VSTR + dv0 * 2 + (fr & 3) * 16;
        const s16x4 a0 = __builtin_bit_cast(s16x4, __builtin_amdgcn_ds_read_tr16_b64_v4i16((LAS s16x4*)va)), a1 = __builtin_bit_cast(s16x4, __builtin_amdgcn_ds_read_tr16_b64_v4i16((LAS s16x4*)(va + 4 * VSTR)));
        const s16x4 b0 = __builtin_bit_cast(s16x4, __builtin_amdgcn_ds_read_tr16_b64_v4i16((LAS s16x4*)(va + 8))), b1 = __builtin_bit_cast(s16x4, __builtin_amdgcn_ds_read_tr16_b64_v4i16((LAS s16x4*)(va + 8 + 4 * VSTR)));
        const bf16x8 v0 = (bf16x8){a0[0], a0[1], a0[2], a0[3], a1[0], a1[1], a1[2], a1[3]}, v1 = (bf16x8){b0[0], b0[1], b0[2], b0[3], b1[0], b1[1], b1[2], b1[3]};
#pragma unroll
        for (int it = 2 * s; it < NI; ++it) { const bf16x8 af = *(const LAS bf16x8*)(abuf + (16 * it + fr) * ASTR + (32 * s + 8 * fq) * 2);
            o[0][it] = mfma16(v0, af, o[0][it]); o[1][it] = mfma16(v1, af, o[1][it]); }
    }
#pragma unroll
    for (int it = 0; it < NI; ++it) { float s = 0.f;
#pragma unroll
        for (int dt = 0; dt < 2; ++dt) s += (o[dt][it][0] * o[dt][it][0] + o[dt][it][1] * o[dt][it][1]) + (o[dt][it][2] * o[dt][it][2] + o[dt][it][3] * o[dt][it][3]);
        s += __shfl_xor(s, 16); s += __shfl_xor(s, 32);
        if (fq == 0) red[wid * 64 + 16 * it + fr] = s; }
    __syncthreads();
#pragma unroll
    for (int it = 0; it < NI; ++it) { float tot = 0.f;
#pragma unroll
        for (int w = 0; w < 8; ++w) tot += red[w * 64 + 16 * it + fr];
        const float rs = __builtin_amdgcn_rsqf(tot * (1.0f / 256.0f) + EPS);
        u32x4 w;
#pragma unroll
        for (int dt = 0; dt < 2; ++dt) { const f32x4 hw = hwv[dt]; const unsigned ra = dt ? rr[it].z : rr[it].x, rb = dt ? rr[it].w : rr[it].y;
            const float r0 = bflo(ra), r1 = bfhi(ra), r2 = bflo(rb), r3 = bfhi(rb);
            const unsigned wa_ = pk2(o[dt][it][0] * rs * hw[0] * silu_f(r0), o[dt][it][1] * rs * hw[1] * silu_f(r1)), wb_ = pk2(o[dt][it][2] * rs * hw[2] * silu_f(r2), o[dt][it][3] * rs * hw[3] * silu_f(r3));
            if (dt == 0) { w.x = wa_; w.y = wb_; } else { w.z = wa_; w.w = wb_; } }
        *(u32x4*)(P + (size_t)(row0 + 16 * it + fr) * GIN_LD + 2048 + h * 256 + dv0 + 8 * fq) = w;
    }
}
__device__ __forceinline__ void phase_gla_c(const Args& a, unsigned char* const ws_, float* const out_, LAS unsigned char* lds, int G, int bx, int wid, int lane) {
    bf16_t* P = (bf16_t*)(ws_ + WS_BIG);
    const bf16_t* SBP = (const bf16_t*)((unsigned char*)out_ + OS_SBUFP); const bf16_t* SBS = (const bf16_t*)(ws_ + WS_SBUFS);
    int par = 0;
    for (int it = bx; it < 1040 + 128; it += G, par ^= 1) {
        LAS unsigned char* abuf = lds + par * 16384; LAS float* red = (LAS float*)(lds + 32768 + par * 4096); LAS unsigned char* vbuf = lds + 49152 + par * 36864;
        if (it < 1040) { const int h = it & 3, c = (it >> 2) % NCH, b = it / 260, seq = b * 4 + h;
            gla_c_item<4>(abuf, red, vbuf, P, c >= 1 ? SBP + (size_t)(seq * 64 + (c - 1)) * 32768 : nullptr, a.in[14], b * LPP + 64 * c, h, wid, lane);
        } else { const int j = it - 1040, h = j & 3, bs = j >> 2;
            gla_c_item<2>(abuf, red, vbuf, P, SBS + (size_t)(bs * 4 + h) * 32768, a.in[14], ROWS_P + 32 * bs, h, wid, lane); }
    }
}

__device__ __forceinline__ void phase_mla_prep(const Args& a, unsigned char* const ws_, float* const out_, int gw, int NGW, int lane) {
    const bf16_t* DN = (const bf16_t*)((unsigned char*)out_ + OS_DN); bf16_t* KP = (bf16_t*)((unsigned char*)out_ + OS_KP);
    bf16_t* KS = (bf16_t*)(ws_ + WS_KS); bf16_t* CQB = (bf16_t*)(ws_ + WS_CQB); float* SSQ = (float*)(ws_ + WS_SS) + 7 * T;
    const f32x2* rt = (const f32x2*)(ws_ + WS_ROPE); const float* kvn = a.in[19];
    auto proc = [&](int row, unsigned q0, unsigned q1, unsigned q2, u32x2 kq, unsigned short krb) {
        const f32x2 c0 = {bflo(q0), bfhi(q0)}, c1 = {bflo(q1), bfhi(q1)}, c2 = {bflo(q2), bfhi(q2)};
        const f32x4 kv = {bflo(kq.x), bfhi(kq.x), bflo(kq.y), bfhi(kq.y)}; const float kr = bf2f(krb);
        float sq = (c0.x * c0.x + c0.y * c0.y) + (c1.x * c1.x + c1.y * c1.y) + (c2.x * c2.x + c2.y * c2.y);
        float sk = (kv[0] * kv[0] + kv[1] * kv[1]) + (kv[2] * kv[2] + kv[3] * kv[3]);
        sq = wave_sum(sq); sk = wave_sum(sk);
        if (lane == 0) SSQ[row] = sq;
        unsigned* cq = (unsigned*)(CQB + (size_t)row * 384 + 6 * lane); cq[0] = q0; cq[1] = q1; cq[2] = q2;
        const float rs = __builtin_amdgcn_rsqf(sk * (1.0f / 256.0f) + EPS); const f32x4 w = *(const f32x4*)(kvn + 4 * lane);
        const f32x4 lat = kv * rs * w;
        int pidx, valid; float* ol; float* orp; bf16_t* krow;
        if (row < ROWS_P) { const int b = row / LPP, p = row % LPP, t = p - 48; valid = p >= 48; pidx = valid ? t : 0;
            ol = out_ + OUT_LP + ((size_t)b * LP + pidx) * 256; orp = out_ + OUT_RP + ((size_t)b * LP + pidx) * 64; krow = KP + (size_t)row * KLD; }
        else { const int j = row - ROWS_P; valid = 1; pidx = LP + (j & 31); ol = out_ + OUT_LS + (size_t)j * 256; orp = out_ + OUT_RS + (size_t)j * 64; krow = KS + ((size_t)(j >> 5) * (PAST + SL) + PAST + (j & 31)) * KLD; }
        const float other = __shfl_xor(kr, 32); const f32x2 cs = rt[(size_t)pidx * 32 + (lane & 31)];
        const float ro = lane < 32 ? kr * cs.x - other * cs.y : kr * cs.x + other * cs.y;
        if (valid) { __builtin_nontemporal_store(lat, (f32x4*)(ol + 4 * lane)); __builtin_nontemporal_store(ro, orp + lane); }
        u32x2 lw; lw.x = pk2(lat[0], lat[1]); lw.y = pk2(lat[2], lat[3]); *(u32x2*)(krow + 4 * lane) = lw;
        krow[256 + lane] = (bf16_t)(pk2(ro, 0.f) & 0xffffu);
    };
    for (int r0 = gw; r0 < T; r0 += 4 * NGW) {
        unsigned q0[4], q1[4], q2[4]; u32x2 kq[4]; unsigned short krb[4];
#pragma unroll
        for (int q = 0; q < 4; ++q) { const int row = r0 + q * NGW; if (row < T) { const bf16_t* d = DN + (size_t)row * MDN_N;
            q0[q] = __builtin_nontemporal_load((const unsigned*)(d + 6 * lane)); q1[q] = __builtin_nontemporal_load((const unsigned*)(d + 6 * lane + 2)); q2[q] = __builtin_nontemporal_load((const unsigned*)(d + 6 * lane + 4));
            kq[q] = __builtin_nontemporal_load((const u32x2*)(d + 384 + 4 * lane)); krb[q] = __builtin_nontemporal_load(d + 640 + lane); } }
#pragma unroll
        for (int q = 0; q < 4; ++q) { const int row = r0 + q * NGW; if (row < T) proc(row, q0[q], q1[q], q2[q], kq[q], krb[q]); }
    }
    const float* clat = a.in[3]; const float* crope = a.in[4];
    constexpr int NR = SB * PAST;
    for (int r0 = gw * 8; r0 < NR; r0 += NGW * 8) {
        f32x4 v[8]; float rp[8];
#pragma unroll
        for (int i = 0; i < 8; ++i) { v[i] = __builtin_nontemporal_load((const f32x4*)(clat + (size_t)(r0 + i) * 256 + 4 * lane)); rp[i] = __builtin_nontemporal_load(crope + (size_t)(r0 + i) * 64 + lane); }
#pragma unroll
        for (int i = 0; i < 8; ++i) { const int r = r0 + i, bs = r >> 11, k = r & (PAST - 1); bf16_t* kd = KS + ((size_t)bs * (PAST + SL) + k) * KLD;
            u32x2 w; w.x = pk2(v[i][0], v[i][1]); w.y = pk2(v[i][2], v[i][3]); *(u32x2*)(kd + 4 * lane) = w; kd[256 + lane] = (bf16_t)(pk2(rp[i], 0.f) & 0xffffu); }
    }
    if (gw < 32) { unsigned zz; asm volatile("v_mov_b32 %0, 0" : "=v"(zz));
        bf16_t* kd = KS + ((size_t)SB * (PAST + SL) + gw) * KLD; *(u32x2*)(kd + 4 * lane) = (u32x2){zz, zz}; kd[256 + lane] = (bf16_t)zz; }
}

constexpr int KROW = 640, KSTAGE = 64 * KROW;
__device__ __forceinline__ void glds16_asm(const void* gsrc, unsigned lds_dst) { unsigned keep;
    asm volatile("s_mov_b32 %0, m0\n\ts_mov_b32 m0, %2\n\ts_nop 0\n\tglobal_load_lds_dwordx4 %1, off\n\ts_mov_b32 m0, %0" : "=&s"(keep) : "v"(gsrc), "s"(lds_dst) : "memory"); }
__device__ __forceinline__ float xred_max(float v) {
    auto a = __builtin_amdgcn_permlane16_swap(__float_as_uint(v), __float_as_uint(v), false, false); v = fmaxf(__uint_as_float(a[0]), __uint_as_float(a[1]));
    auto b = __builtin_amdgcn_permlane32_swap(__float_as_uint(v), __float_as_uint(v), false, false); return fmaxf(__uint_as_float(b[0]), __uint_as_float(b[1]));
}
__device__ __forceinline__ float xred_sum(float v) {
    auto a = __builtin_amdgcn_permlane16_swap(__float_as_uint(v), __float_as_uint(v), false, false); v = __uint_as_float(a[0]) + __uint_as_float(a[1]);
    auto b = __builtin_amdgcn_permlane32_swap(__float_as_uint(v), __float_as_uint(v), false, false); return __uint_as_float(b[0]) + __uint_as_float(b[1]);
}
__device__ __forceinline__ void attn_unit(LAS unsigned char* lds, const bf16_t* Qb, const bf16_t* Kb, const bf16_t* WuvT, const f32x2* rope, bf16_t* Ob, int qrow0, int NT, int klo0, int khiL, int wid) {
    int lane; { int zz = 0; asm volatile("" : "+v"(zz)); lane = (int)__builtin_amdgcn_mbcnt_hi(~0u, __builtin_amdgcn_mbcnt_lo(~0u, 0u)) + zz; }
    const int fr = lane & 15, fq = lane >> 4, h = wid;
    bf16x8 qf[10];
    { const bf16_t* qp = Qb + ((size_t)(qrow0 >> 4) * 80 + h * 10) * 512 + lane * 8;
#pragma unroll
      for (int s = 0; s < 10; ++s) qf[s] = __builtin_nontemporal_load((const bf16x8*)(qp + 512 * s));
      const int row = qrow0 + fr; int pidx;
      if (row < ROWS_P) { const int p = row % LPP; pidx = p >= 48 ? p - 48 : 0; } else pidx = LP + ((row - ROWS_P) & 31);
      const f32x2* cs = rope + (size_t)pidx * 32 + 8 * fq;
      float o1[8], o2[8];
#pragma unroll
      for (int j = 0; j < 8; ++j) { const f32x2 c = cs[j]; const float x1 = bf2f((unsigned short)qf[8][j]), x2 = bf2f((unsigned short)qf[9][j]); o1[j] = x1 * c.x - x2 * c.y; o2[j] = x2 * c.x + x1 * c.y; }
      u32x4 w1, w2; w1.x = pk2(o1[0], o1[1]); w1.y = pk2(o1[2], o1[3]); w1.z = pk2(o1[4], o1[5]); w1.w = pk2(o1[6], o1[7]);
      w2.x = pk2(o2[0], o2[1]); w2.y = pk2(o2[2], o2[3]); w2.z = pk2(o2[4], o2[5]); w2.w = pk2(o2[6], o2[7]);
      qf[8] = __builtin_bit_cast(bf16x8, w1); qf[9] = __builtin_bit_cast(bf16x8, w2); }
    f32x4 o[16];
#pragma unroll
    for (int d = 0; d < 16; ++d) o[d] = (f32x4){0.f, 0.f, 0.f, 0.f};
    float mrun = -INFINITY, lsum = 0.f;
    int crow[5], cdat[5];
#pragma unroll
    for (int i = 0; i < 5; ++i) { const int pos = (8 * i + wid) * 64 + lane; crow[i] = pos / 40; cdat[i] = (pos % 40) ^ (crow[i] & 6); }
#define ATT_DMA(t, stg) do { const unsigned sb_ = (unsigned)__builtin_amdgcn_readfirstlane((int)(unsigned)(unsigned long)((stg) + wid * 1024)); _Pragma("unroll") for (int i = 0; i < 5; ++i) \
        glds16_asm(Kb + ((size_t)(64 * (t) + crow[i]) * KLD + cdat[i] * 8), sb_ + i * 8192); } while (0)
    const int f6 = fr & 6;
    const int kbe = fr * KROW + ((fq ^ (f6 & 2)) * 16) + ((f6 & 4) ? 64 : 0), kbo = fr * KROW + ((fq ^ (f6 & 2)) * 16) - ((f6 & 4) ? 64 : 0);
    const int vrow = 4 * fq + (fr >> 2), g2 = (vrow & 6) >> 1;
    int vbs[4];
#pragma unroll
    for (int e = 0; e < 4; ++e) vbs[e] = vrow * KROW + 32 * (e ^ g2) + 16 * ((fr >> 1) & 1) + 8 * (fr & 1);
    bf16x8 pf[2] = {(bf16x8){0, 0, 0, 0, 0, 0, 0, 0}, (bf16x8){0, 0, 0, 0, 0, 0, 0, 0}};
    auto qk_sm = [&](LAS unsigned char* stg, int klo, int khi, bool masked, bool first) {
        const float base = first ? 0.f : mrun;
        f32x4 st[4];
#pragma unroll
        for (int Tt = 0; Tt < 4; ++Tt) st[Tt] = (f32x4){-base, -base, -base, -base};
        const LAS unsigned char* kE = stg + kbe; const LAS unsigned char* kO = stg + kbo;
        constexpr int KD = 2;
        bf16x8 kf[KD][4];
#define ATT_KLOAD(s) do { _Pragma("unroll") for (int Tt = 0; Tt < 4; ++Tt) kf[(s) % KD][Tt] = *(const LAS bf16x8*)((((s) & 1) ? kO : kE) + Tt * (16 * KROW) + (s) * 64); } while (0)
#pragma unroll
        for (int s = 0; s < KD - 1; ++s) ATT_KLOAD(s);
#pragma unroll
        for (int s = 0; s < 10; ++s) {
            if (s + KD - 1 < 10) ATT_KLOAD(s + KD - 1);
#pragma unroll
            for (int Tt = 0; Tt < 4; ++Tt) st[Tt] = mfma16(kf[s % KD][Tt], qf[s], st[Tt]);
            __builtin_amdgcn_sched_barrier(0);
        }
#undef ATT_KLOAD
        if (masked) {
#pragma unroll
            for (int Tt = 0; Tt < 4; ++Tt)
#pragma unroll
                for (int r = 0; r < 4; ++r) { const int kk = 16 * Tt + 4 * fq + r; if (kk < klo || kk >= khi) st[Tt][r] = -INFINITY; }
        }
        if (ATT_P1) {
            f32x4 s2[4];
#pragma unroll
            for (int Tt = 0; Tt < 4; ++Tt) { s2[Tt] = st[Tt]; asm volatile("" : "+v"(s2[Tt])); }
            float m2 = fmaxf(fmaxf(s2[0][0], s2[0][1]), fmaxf(s2[0][2], s2[0][3]));
#pragma unroll
            for (int Tt = 1; Tt < 4; ++Tt) m2 = fmaxf(m2, fmaxf(fmaxf(s2[Tt][0], s2[Tt][1]), fmaxf(s2[Tt][2], s2[Tt][3])));
            m2 = xred_max(m2); float p2 = 0.f;
#pragma unroll
            for (int Tt = 0; Tt < 4; ++Tt)
#pragma unroll
                for (int r = 0; r < 4; ++r) { s2[Tt][r] = fexp2(s2[Tt][r] - m2); p2 += s2[Tt][r]; }
            unsigned q2 = 0;
#pragma unroll
            for (int s = 0; s < 2; ++s) { q2 ^= pk2(s2[2 * s][0], s2[2 * s][1]) ^ pk2(s2[2 * s][2], s2[2 * s][3]) ^ pk2(s2[2 * s + 1][0], s2[2 * s + 1][1]) ^ pk2(s2[2 * s + 1][2], s2[2 * s + 1][3]); }
            asm volatile("" :: "v"(p2), "v"(q2));
        }
        float mx = fmaxf(fmaxf(st[0][0], st[0][1]), fmaxf(st[0][2], st[0][3]));
#pragma unroll
        for (int Tt = 1; Tt < 4; ++Tt) mx = fmaxf(mx, fmaxf(fmaxf(st[Tt][0], st[Tt][1]), fmaxf(st[Tt][2], st[Tt][3])));
        mx = xred_max(mx);
        if (first || __any(mx > 8.0f)) {
            const float dm = first ? mx : fmaxf(mx, 0.f), alpha = first ? 0.f : fexp2(-dm); mrun = base + dm;
            lsum *= alpha;
#pragma unroll
            for (int d = 0; d < 16; ++d) o[d] = o[d] * alpha;
#pragma unroll
            for (int Tt = 0; Tt < 4; ++Tt) st[Tt] = st[Tt] - dm;
        }
        float ps = 0.f;
#pragma unroll
        for (int Tt = 0; Tt < 4; ++Tt)
#pragma unroll
            for (int r = 0; r < 4; ++r) { st[Tt][r] = fexp2(st[Tt][r]); ps += st[Tt][r]; }
        lsum += ps;
#pragma unroll
        for (int s = 0; s < 2; ++s) { u32x4 w; w.x = pk2(st[2 * s][0], st[2 * s][1]); w.y = pk2(st[2 * s][2], st[2 * s][3]); w.z = pk2(st[2 * s + 1][0], st[2 * s + 1][1]); w.w = pk2(st[2 * s + 1][2], st[2 * s + 1][3]); pf[s] = __builtin_bit_cast(bf16x8, w); }
    };
    auto pv = [&](LAS unsigned char* stg) {
        constexpr int VD = 6;
        s16x4 vl[VD], vh[VD];
#define ATT_VLOAD(p) do { const int d_ = (p) >> 1, s_ = (p) & 1; \
            vl[(p) % VD] = __builtin_bit_cast(s16x4, __builtin_amdgcn_ds_read_tr16_b64_v4i16((LAS s16x4*)(stg + vbs[d_ & 3] + (32 * s_) * KROW + (d_ >> 2) * 128))); \
            vh[(p) % VD] = __builtin_bit_cast(s16x4, __builtin_amdgcn_ds_read_tr16_b64_v4i16((LAS s16x4*)(stg + vbs[d_ & 3] + (32 * s_ + 16) * KROW + (d_ >> 2) * 128))); } while (0)
#pragma unroll
        for (int p = 0; p < VD; ++p) ATT_VLOAD(p);
#pragma unroll
        for (int p = 0; p < 32; ++p) {
            const s16x4 lo = vl[p % VD], hi = vh[p % VD];
            const bf16x8 vf = (bf16x8){lo[0], lo[1], lo[2], lo[3], hi[0], hi[1], hi[2], hi[3]};
            o[p >> 1] = mfma16(vf, pf[p & 1], o[p >> 1]);
            if (p + VD < 32) ATT_VLOAD(p + VD);
            __builtin_amdgcn_sched_barrier(0);
        }
#undef ATT_VLOAD
    };
    ATT_DMA(0, lds);
    if (NT > 1) { ATT_DMA(1, lds + KSTAGE); asm volatile("s_waitcnt vmcnt(5)" ::: "memory"); } else asm volatile("s_waitcnt vmcnt(0)" ::: "memory");
    __syncthreads();
    int sc = 0;
    for (int t = 0; t < NT; ++t) {
        const int sn = sc == 2 ? 0 : sc + 1, sp = sc == 0 ? 2 : sc - 1;
        const bool more = t + 2 < NT;
        if (more) ATT_DMA(t + 2, lds + sp * KSTAGE);
        const bool msk = (t == 0 && klo0 > 0) || (t == NT - 1 && khiL < 64);
        const int klo = t == 0 ? klo0 : 0, khi = t == NT - 1 ? khiL : 64;
        qk_sm(lds + sc * KSTAGE, klo, khi, msk, t == 0);
        pv(lds + sc * KSTAGE);
        if (more) asm volatile("s_waitcnt vmcnt(5)" ::: "memory"); else asm volatile("s_waitcnt vmcnt(0)" ::: "memory");
        __syncthreads();
        sc = sn;
    }
#undef ATT_DMA
    lsum = xred_sum(lsum);
    const float inv = frcp(lsum);
    bf16x8 bfr[8];
#pragma unroll
    for (int s = 0; s < 8; ++s) { u32x4 w; w.x = pk2(o[2 * s][0] * inv, o[2 * s][1] * inv); w.y = pk2(o[2 * s][2] * inv, o[2 * s][3] * inv); w.z = pk2(o[2 * s + 1][0] * inv, o[2 * s + 1][1] * inv); w.w = pk2(o[2 * s + 1][2] * inv, o[2 * s + 1][3] * inv); bfr[s] = __builtin_bit_cast(bf16x8, w); }
    const bf16_t* wu = WuvT + (size_t)h * 32768 + lane * 8;
    bf16_t* op = Ob + (size_t)(qrow0 + fr) * DM + h * 128 + 8 * fq;
    bf16x8 wa[2][16];
#define EP_LOAD(g) do { _Pragma("unroll") for (int i = 0; i < 16; ++i) wa[(g) & 1][i] = *(const bf16x8*)(wu + ((g) * 16 + i) * 512); } while (0)
#define EP_COMP(g) do { u32x4 w; _Pragma("unroll") for (int vv = 0; vv < 2; ++vv) { f32x4 acc = (f32x4){0.f, 0.f, 0.f, 0.f}; \
        _Pragma("unroll") for (int s = 0; s < 8; ++s) acc = mfma16(wa[(g) & 1][vv * 8 + s], bfr[s], acc); \
        if (vv == 0) { w.x = pk2(acc[0], acc[1]); w.y = pk2(acc[2], acc[3]); } else { w.z = pk2(acc[0], acc[1]); w.w = pk2(acc[2], acc[3]); } } \
        *(u32x4*)(op + 32 * (g)) = w; } while (0)
    EP_LOAD(0); EP_LOAD(1); __builtin_amdgcn_sched_barrier(0);
    EP_COMP(0); __builtin_amdgcn_sched_barrier(0); EP_LOAD(2); __builtin_amdgcn_sched_barrier(0);
    EP_COMP(1); __builtin_amdgcn_sched_barrier(0); EP_LOAD(3); __builtin_amdgcn_sched_barrier(0);
    EP_COMP(2); __builtin_amdgcn_sched_barrier(0); EP_COMP(3);
#undef EP_LOAD
#undef EP_COMP
}
__device__ __forceinline__ void phase_attn(const Args& a, unsigned char* const ws_, float* const out_, LAS unsigned char* lds, int G, int bx, int tid, int wid, int lane) {
    const bf16_t* Qb = (const bf16_t*)(ws_ + WS_BIG); const bf16_t* KP = (const bf16_t*)((unsigned char*)out_ + OS_KP); const bf16_t* KS = (const bf16_t*)(ws_ + WS_KS);
    const bf16_t* WU = (const bf16_t*)(ws_ + WS_WUVT); bf16_t* Ob = (bf16_t*)((unsigned char*)out_ + OS_DN);
    for (int rd = 0;; ++rd) {
        const int j = (rd & 1) ? (rd + 1) * G - 1 - bx : rd * G + bx;
        if (rd * G >= 1092) break;
        if (j >= 1092) continue;
        const bf16_t* Kb; int qrow0, NT, klo0, khiL;
        if (j >= 512 && j < 576) { const int s = j - 512, bs = s >> 1, half = s & 1; Kb = KS + (size_t)bs * (PAST + SL) * KLD; qrow0 = ROWS_P + 32 * bs + 16 * half; NT = 33; klo0 = 0; khiL = 32; }
        else {
            int b, m, qt;
            if (j < 512) { m = 64 - (j >> 4); b = (j & 15) >> 2; qt = j & 3; }
            else if (j < 1088) { const int jj = j - 576; m = 32 - (jj >> 4); b = (jj & 15) >> 2; qt = jj & 3; }
            else { m = 0; b = j - 1088; qt = 3; }
            Kb = KP + (size_t)b * LPP * KLD; qrow0 = b * LPP + 64 * m + 16 * qt; NT = m + 1; klo0 = 48; khiL = 64;
        }
        attn_unit(lds, Qb, Kb, WU, (const f32x2*)(ws_ + WS_ROPE), Ob, qrow0, NT, klo0, khiL, wid);
    }
}

__device__ __forceinline__ void phase_final(const Args& a, unsigned char* const ws_, float* const out_, int gw, int NGW, int lane) {
    const float* SS = (const float*)(ws_ + WS_SS) + 6 * T; const float* fn = a.in[27]; const bf16_t* HBp = (const bf16_t*)(ws_ + WS_HB);
    f32x4 w[4];
#pragma unroll
    for (int j = 0; j < 4; ++j) w[j] = *(const f32x4*)(fn + 256 * j + 4 * lane);
    for (int r0 = gw; r0 < T; r0 += 4 * NGW) {
        u32x4 hv[4][2]; float ssv[4]; float* dst[4];
#pragma unroll
        for (int q = 0; q < 4; ++q) { const int row = r0 + q * NGW; dst[q] = nullptr;
            if (row < T) {
                if (row < ROWS_P) { const int b = row / LPP, p = row % LPP; if (p >= 64) dst[q] = out_ + OUT_YP + ((size_t)b * SEQ + (p - 64)) * DM; }
                else dst[q] = out_ + OUT_YS + (size_t)(row - ROWS_P) * DM;
            }
            if (dst[q]) { ssv[q] = SS[row]; hv[q][0] = __builtin_nontemporal_load((const u32x4*)(HBp + (size_t)row * DM + 8 * lane)); hv[q][1] = __builtin_nontemporal_load((const u32x4*)(HBp + (size_t)row * DM + 512 + 8 * lane)); } }
#pragma unroll
        for (int q = 0; q < 4; ++q) if (dst[q]) {
            const float rs = __builtin_amdgcn_rsqf(ssv[q] * (1.0f / DM) + EPS);
#pragma unroll
            for (int hf = 0; hf < 2; ++hf) { const u32x4 x = hv[q][hf]; const int c = 512 * hf + 8 * lane;
                const f32x4 wa = *(const f32x4*)(fn + c), wb = *(const f32x4*)(fn + c + 4);
                __builtin_nontemporal_store((f32x4){bflo(x.x), bfhi(x.x), bflo(x.y), bfhi(x.y)} * rs * wa, (f32x4*)(dst[q] + c));
                __builtin_nontemporal_store((f32x4){bflo(x.z), bfhi(x.z), bflo(x.w), bfhi(x.w)} * rs * wb, (f32x4*)(dst[q] + c + 4)); }
        }
    }
    (void)w;
}

__device__ __forceinline__ void resid_fix(const pg8::SplitOrder& S, float* H, bf16_t* HB, float* ssn, float scale, const unsigned char* part, int gw, int NGW, int lane) {
    if (S.S <= 1) return;
    const int nitem = S.rem * 128, fr = lane & 15, fq = lane >> 4;
    for (int it = gw; it < nitem; it += NGW) {
        const int j = it >> 7, q = it & 127, w = q >> 4, ai = (q >> 3) & 1, m = (q >> 1) & 3, bj = q & 1; int pm, pn; S.tile(S.full * S.G + j, pm, pn);
        const unsigned char* p = part + (size_t)(j * S.S) * 131072 + (size_t)q * 1024 + lane * 16;
        f32x4 a0 = {0.f, 0.f, 0.f, 0.f}, a1 = {0.f, 0.f, 0.f, 0.f};
#define RF_ACC(v) do { a0[0] += bflo(v.x); a0[1] += bfhi(v.x); a0[2] += bflo(v.y); a0[3] += bfhi(v.y); a1[0] += bflo(v.z); a1[1] += bfhi(v.z); a1[2] += bflo(v.w); a1[3] += bfhi(v.w); } while (0)
        int s = 0;
        for (; s + 4 <= S.S; s += 4) { const u32x4 x0 = *(const u32x4*)(p + (size_t)s * 131072), x1 = *(const u32x4*)(p + (size_t)(s + 1) * 131072), x2 = *(const u32x4*)(p + (size_t)(s + 2) * 131072), x3 = *(const u32x4*)(p + (size_t)(s + 3) * 131072);
            RF_ACC(x0); RF_ACC(x1); RF_ACC(x2); RF_ACC(x3); }
        for (; s < S.S; ++s) { const u32x4 x0 = *(const u32x4*)(p + (size_t)s * 131072); RF_ACC(x0); }
#undef RF_ACC
        const int row = pm * 256 + ai * 128 + (w >> 2) * 64 + m * 16 + fr;
        const size_t off = (size_t)row * DM + pn * 256 + bj * 128 + (w & 3) * 32 + 8 * fq;
        f32x4 v0, v1;
        if (RESID_BF16) { const u32x4 hv = *(const u32x4*)(HB + off);
            v0 = (f32x4){bflo(hv.x), bfhi(hv.x), bflo(hv.y), bfhi(hv.y)} + a0 * scale; v1 = (f32x4){bflo(hv.z), bfhi(hv.z), bflo(hv.w), bfhi(hv.w)} + a1 * scale; }
        else { v0 = *(const f32x4*)(H + off) + a0 * scale; v1 = *(const f32x4*)(H + off + 4) + a1 * scale; *(f32x4*)(H + off) = v0; *(f32x4*)(H + off + 4) = v1; }
        u32x4 wv; wv.x = pk2(v0[0], v0[1]); wv.y = pk2(v0[2], v0[3]); wv.z = pk2(v1[0], v1[1]); wv.w = pk2(v1[2], v1[3]); *(u32x4*)(HB + off) = wv;
        float sq = ((v0[0] * v0[0] + v0[1] * v0[1]) + (v0[2] * v0[2] + v0[3] * v0[3])) + ((v1[0] * v1[0] + v1[1] * v1[1]) + (v1[2] * v1[2] + v1[3] * v1[3]));
        sq += __shfl_xor(sq, 16); sq += __shfl_xor(sq, 32);
        if (fq == 0) atomicAdd(ssn + row, sq);
    }
}

constexpr int NPHASE = 20;
constexpr int LDS_BYTES = 147456;
__global__ void __launch_bounds__(512, 2) mk_fwd(Args args0) {
    __shared__ __attribute__((aligned(16))) unsigned char lds_raw[LDS_BYTES];
    LAS unsigned char* lds = (LAS unsigned char*)lds_raw;
    const int tid0 = threadIdx.x; const int wave0 = __builtin_amdgcn_readfirstlane(tid0 >> 6);
    const int G0 = gridDim.x, bx0 = blockIdx.x;
    unsigned char* ws0 = args0.ws;
    volatile LAS unsigned* MISC = (volatile LAS unsigned*)(lds + 131072 + 8192);
    if (tid0 < 16) MISC[tid0] = 0u;
    __syncthreads();
    XcdBarrier bar; bar.bar = (unsigned*)(ws0 + WS_CTL) + CW_BAR; bar.x = 0; bar.st = nullptr;
    const bool one_launch = (args0.ph_hi - args0.ph_lo) > 1;
    if (one_launch) bar = xcd_barrier_post((unsigned*)(ws0 + WS_CTL) + CW_BAR, MISC + 8);

    const int nsteps = (args0.ph_hi - args0.ph_lo) + (one_launch ? __builtin_popcount(DUP_MASK) : 0);
    for (int step = 0; step < nsteps; ++step) {
        int ph = args0.ph_lo + step;
        if (DUP_MASK != 0u && one_launch) { int p = 0, accn = 0; for (;;) { const int cnt = 1 + (int)((DUP_MASK >> p) & 1u); if (step < accn + cnt) break; accn += cnt; ++p; } ph = p; }
        long z = 0; int bx = bx0, G = G0;
        asm volatile("" : "+s"(z), "+s"(bx), "+s"(G));
        const int NGW = G * 8;
        unsigned char* ws = ws0 + z; float* outp = args0.out + z;
        int lane = (int)__builtin_amdgcn_mbcnt_hi(~0u, __builtin_amdgcn_mbcnt_lo(~0u, 0u)) + (int)z;
        const int wave = wave0, tid = wave * 64 + lane;
        const int vcu = (G % 8 == 0) ? (bx % 8) * (G / 8) + bx / 8 : bx, gw = vcu * 8 + wave;
        float* SS = (float*)(ws + WS_SS);
        float* H = (float*)(ws + WS_H); bf16_t* HB = (bf16_t*)(ws + WS_HB); bf16_t* BIG = (bf16_t*)(ws + WS_BIG);
        switch (ph) {
        case 0: phase_prep(args0, ws, outp, lds, gw, NGW, wave, lane); break;
        case 1: case 8: case 10: case 17: {
            const int fi = ph == 1 ? 0 : ph == 8 ? 1 : ph == 10 ? 2 : 3;
            const int ssi = ph == 1 ? 0 : ph == 8 ? 2 : ph == 10 ? 3 : 5;
            pg8::Gemm g{HB, (const bf16_t*)(ws + ws_wup(fi)), T, 5632, DM, DM};
            pg8::StaticOrder S; S.init(T, 5632, G, bx);
            pg8::EpiSwiglu E{BIG, SS + (size_t)ssi * T};
            pg8::gemm_phase<pg8::EpiSwiglu, pg8::StaticOrder, true>(lds, g, S, E, tid);
        } break;
        case 2: case 9: case 11: case 18: case 7: case 16: {
            const bf16_t* A; const bf16_t* Bt; int K, lda, sso; float scale;
            if (ph == 7) { A = BIG + 2048; lda = GIN_LD; K = DM; Bt = (const bf16_t*)(ws + WS_WGOUT); sso = 2; scale = 1.0f; }
            else if (ph == 16) { A = (const bf16_t*)((unsigned char*)outp + OS_DN); lda = DM; K = DM; Bt = (const bf16_t*)(ws + WS_WMOUT); sso = 5; scale = 1.0f; }
            else { const int fi = ph == 2 ? 0 : ph == 9 ? 1 : ph == 11 ? 2 : 3; A = BIG; lda = DFF; K = DFF; Bt = (const bf16_t*)(ws + ws_wdn(fi)); sso = ph == 2 ? 1 : ph == 9 ? 3 : ph == 11 ? 4 : 6; scale = 0.5f; }
            unsigned char* part = ph == 16 ? (unsigned char*)BIG : (unsigned char*)outp;
            pg8::Gemm g{A, Bt, T, DM, K, lda};
            pg8::SplitOrder S; S.init(T, DM, K, G, bx);
            unsigned* cnt = (unsigned*)(ws + WS_CTL) + CW_SPLIT + ph;
            pg8::EpiResid E{H, HB, SS + (size_t)sso * T, scale, part, cnt};
            pg8::gemm_phase<pg8::EpiResid, pg8::SplitOrder, true>(lds, g, S, E, tid);
            if (S.S > 1) {
                if (tid == 0) { const unsigned need = (unsigned)(S.rem * S.S); unsigned sp = 0;
                    while (__hip_atomic_load(cnt, __ATOMIC_RELAXED, __HIP_MEMORY_SCOPE_AGENT) < need) { __builtin_amdgcn_s_sleep(2); if (++sp > (1u << 22)) break; }
                    __builtin_amdgcn_fence(__ATOMIC_ACQUIRE, "agent"); }
                __syncthreads();
                resid_fix(S, H, HB, SS + (size_t)sso * T, scale, part, gw, NGW, lane);
            }
        } break;
        case 3: {
            pg8::Gemm g{HB, (const bf16_t*)(ws + WS_WGIN), T, GIN_N, DM, DM};
            pg8::StaticOrder S; S.init(T, GIN_N, G, bx);
            pg8::EpiScaleBf16 E{BIG, GIN_LD, SS + (size_t)1 * T};
            pg8::gemm_phase<pg8::EpiScaleBf16, pg8::StaticOrder, true>(lds, g, S, E, tid);
        } break;
        case 4: phase_gla_a(args0, ws, outp, lds, G, bx, tid); break;
        case 5: phase_gla_b(args0, ws, outp, lds, G, vcu, gw, NGW, wave, lane); break;
        case 6: phase_gla_c(args0, ws, outp, lds, G, bx, wave, lane); break;
        case 12: {
            pg8::Gemm g{HB, (const bf16_t*)(ws + WS_WMDN), T, MDN_N, DM, DM};
            pg8::StaticOrder S; S.init(T, MDN_N, G, bx);
            pg8::EpiScaleBf16 E{(bf16_t*)((unsigned char*)outp + OS_DN), MDN_N, SS + (size_t)4 * T};
            pg8::gemm_phase<pg8::EpiScaleBf16, pg8::StaticOrder, true>(lds, g, S, E, tid);
        } break;
        case 13: phase_mla_prep(args0, ws, outp, gw, NGW, lane); break;
        case 14: {
            pg8::Gemm g{(const bf16_t*)(ws + WS_CQB), (const bf16_t*)(ws + WS_WQ), T, QN, 384, 384};
            pg8::StaticOrder S; S.init(T, QN, G, bx);
            pg8::EpiQ E{BIG, SS + (size_t)7 * T, 0.07216878364870322f * LOG2E};
            pg8::gemm_phase<pg8::EpiQ, pg8::StaticOrder, true>(lds, g, S, E, tid);
        } break;
        case 15: phase_attn(args0, ws, outp, lds, G, bx, tid, wave, lane); break;
        case 19: phase_final(args0, ws, outp, gw, NGW, lane); break;
        default: break;
        }
        if (step + 1 < nsteps) xcd_barrier(bar);
    }
}

extern "C" void kernel_launch(void* const* d_in, const int* in_sizes, int n_in, void* d_out, int out_size, void* d_ws, size_t ws_size, hipStream_t stream) {
    static int grid = 0;
    if (grid == 0) {
        if (n_in != 28 || out_size != (int)OUT_END || ws_size < WS_END) { fprintf(stderr, "kernel_launch: unexpected sizes n_in %d out %d ws %zu (need %zu)\n", n_in, out_size, ws_size, (size_t)WS_END); grid = -1; return; }
        int dev = 0, cus = 0;
        if (hipGetDevice(&dev) != hipSuccess || hipDeviceGetAttribute(&cus, hipDeviceAttributeMultiprocessorCount, dev) != hipSuccess || cus < 8) { fprintf(stderr, "kernel_launch: device query failed\n"); grid = -1; return; }
        grid = cus;
    }
    if (grid < 0) return;
    (void)hipMemsetAsync((char*)d_ws + WS_CTL, 0, CTL_ZERO_BYTES, stream);
    Args a{};
    for (int i = 0; i < 28; ++i) a.in[i] = (const float*)d_in[i];
    a.out = (float*)d_out; a.ws = (unsigned char*)d_ws;
#if MK_N_LAUNCHES == 1
    a.ph_lo = 0; a.ph_hi = NPHASE;
    hipLaunchKernelGGL(mk_fwd, dim3(grid), dim3(512), 0, stream, a);
#else
    for (int p = 0; p < NPHASE; ++p) { a.ph_lo = p; a.ph_hi = p + 1; hipLaunchKernelGGL(mk_fwd, dim3(grid), dim3(512), 0, stream, a); }
#endif
}
```
